# Optimizing an MI355X kernel written in HIP

```python
import math
import jax, jax.numpy as jnp
from jax import lax
import numpy as np

D_MODEL = 2048
BATCH = 1
SEQ = 8192
DEPTH = 2

N_MIXERS = 2
N_HYENA_LAYERS = (DEPTH + 1) // 2
N_MLSTM_LAYERS = DEPTH // 2
SHORT_CONV = 3
HY_ORDER = 2
HY_IN_DIM = (HY_ORDER + 1) * D_MODEL
HY_BANDS = 16
HY_EMB = 1 + 2 * HY_BANDS
HY_FILTER_WIDTH = 64
HY_DECAY_TARGET = 1e-2
HY_FAST_DECAY = 0.3
HY_SLOW_DECAY = 1.5
ML_HEADS = 8
ML_QK_DIM = D_MODEL // 2
ML_V_DIM = D_MODEL
ML_DQK = ML_QK_DIM // ML_HEADS
ML_DV = ML_V_DIM // ML_HEADS
ML_CHUNK = 64
ML_IN_DIM = 2 * ML_QK_DIM + 2 * ML_V_DIM + 4 * ML_HEADS
N_EXPERTS = 64
TOP_K = 6
N_GROUPS = 8
TOPK_GROUPS = 4
EXPERT_FF = 512
SHARED_FF = 512
ROUTED_SCALE = 2.5
MOE_BLOCK = 128
EPS = 1e-6

kernel_name = "hybrid_hyena_mlstm_moe_encoder"


def rms_norm(x, g):
    xf = x.astype(jnp.float32)
    y = xf * lax.rsqrt(jnp.mean(xf * xf, axis=-1, keepdims=True) + EPS)
    return (y * g.astype(jnp.float32)).astype(x.dtype)


def short_conv3(u, w, b):
    up = jnp.pad(u, ((0, 0), (1, 1), (0, 0)))
    return up[:, :-2] * w[0] + up[:, 1:-1] * w[1] + up[:, 2:] * w[2] + b


def hyena_implicit_filter(L, w0, b0, w1, b1, w2, b2, freq, wout):
    f32 = jnp.float32
    w0, b0, w1, b1, w2, b2, freq, wout = [a.astype(f32) for a in (w0, b0, w1, b1, w2, b2, freq, wout)]
    t = jnp.linspace(0.0, 1.0, L, dtype=f32)[:, None]
    ang = 2.0 * math.pi * jnp.arange(L, dtype=f32)[:, None] / L
    bands = jnp.linspace(1e-4, HY_BANDS - 1, HY_BANDS, dtype=f32)
    z = jnp.concatenate([t, jnp.cos(ang * bands), -jnp.sin(ang * bands)], axis=-1)
    a = jnp.sin(freq * (z @ w0 + b0))
    a = jnp.sin(freq * (a @ w1 + b1))
    a = jnp.sin(freq * (a @ w2 + b2))
    k = a @ wout
    D = k.shape[-1] // 2
    deltas = jnp.abs(jnp.linspace(math.log(HY_DECAY_TARGET) / HY_FAST_DECAY,
                                  math.log(HY_DECAY_TARGET) / HY_SLOW_DECAY, D, dtype=f32))
    window = jnp.exp(-t * deltas)
    k_fwd = k[:, :D] * window
    k_bwd = k[:, D:] * window
    return jnp.concatenate([k_fwd, jnp.zeros((1, D), f32), k_bwd[1:][::-1]], axis=0)


def hyena_mixer(h, w_in, conv_w, conv_b, f_w0, f_b0, f_w1, f_b1, f_w2, f_b2, f_freq, f_wout, skip, w_out):
    B, L, D = h.shape
    u = short_conv3(h @ w_in, conv_w, conv_b)
    x0, x1, v = jnp.split(u, 3, axis=-1)
    filt = hyena_implicit_filter(L, f_w0, f_b0, f_w1, f_b1, f_w2, f_b2, f_freq, f_wout)
    vg = (v * x1).astype(jnp.float32)
    spec = jnp.fft.rfft(vg, n=2 * L, axis=1) * jnp.fft.rfft(filt, axis=0)[None]
    conv = jnp.fft.irfft(spec, n=2 * L, axis=1)[:, :L]
    y = (conv + vg * skip.astype(jnp.float32)).astype(h.dtype) * x0
    return y @ w_out


def mlstm_chunkwise(q, k, v, li, lf):
    B, H, L, dk = q.shape
    dv = v.shape[-1]
    nc = L // ML_CHUNK
    q = q.reshape(B, H, nc, ML_CHUNK, dk)
    k = k.reshape(B, H, nc, ML_CHUNK, dk)
    v = v.reshape(B, H, nc, ML_CHUNK, dv)
    li = li.reshape(B, H, nc, ML_CHUNK)
    lf = lf.reshape(B, H, nc, ML_CHUNK)
    b = jnp.cumsum(lf, axis=-1)
    g = b[..., -1]
    a = g[..., None] - b + li
    m_loc = jnp.max(a, axis=-1)
    wgt = jnp.exp(a - m_loc[..., None])
    C_loc = jnp.einsum('bhncd,bhnce->bhnde', k * wgt[..., None], v)
    n_loc = jnp.einsum('bhncd,bhnc->bhnd', k, wgt)

    def step(carry, inp):
        C, n, m = carry
        C_l, n_l, m_l, g_c = inp
        m_new = jnp.maximum(g_c + m, m_l)
        s_prev = jnp.exp(g_c + m - m_new)
        s_loc = jnp.exp(m_l - m_new)
        C_new = s_prev[..., None, None] * C + s_loc[..., None, None] * C_l
        n_new = s_prev[..., None] * n + s_loc[..., None] * n_l
        return (C_new, n_new, m_new), (C, n, m)

    init = (jnp.zeros((B, H, dk, dv), jnp.float32), jnp.zeros((B, H, dk), jnp.float32),
            jnp.zeros((B, H), jnp.float32))
    xs = (jnp.moveaxis(C_loc, 2, 0), jnp.moveaxis(n_loc, 2, 0), jnp.moveaxis(m_loc, 2, 0), jnp.moveaxis(g, 2, 0))
    _, (C_st, n_st, m_st) = lax.scan(step, init, xs)
    C_st = jnp.moveaxis(C_st, 0, 2)
    n_st = jnp.moveaxis(n_st, 0, 2)
    m_st = jnp.moveaxis(m_st, 0, 2)

    mask = jnp.tril(jnp.ones((ML_CHUNK, ML_CHUNK), bool))
    Dlog = jnp.where(mask, b[..., :, None] - b[..., None, :] + li[..., None, :], -jnp.inf)
    m_inter = b + m_st[..., None]
    m_t = jnp.maximum(m_inter, jnp.max(Dlog, axis=-1))
    P = jnp.exp(Dlog - m_t[..., None]) * jnp.einsum('bhntd,bhnsd->bhnts', q, k)
    s_inter = jnp.exp(m_inter - m_t)
    num = s_inter[..., None] * jnp.einsum('bhntd,bhnde->bhnte', q, C_st) + jnp.einsum('bhnts,bhnse->bhnte', P, v)
    den = s_inter * jnp.einsum('bhntd,bhnd->bhnt', q, n_st) + jnp.sum(P, axis=-1)
    hout = num / jnp.maximum(jnp.abs(den), jnp.exp(-m_t))[..., None]
    return hout.reshape(B, H, L, dv)


def mlstm_mixer(h, w_in, conv_w, conv_b, gate_b, head_g, w_out):
    B, L, D = h.shape
    f32 = jnp.float32
    p = h @ w_in
    qk = jax.nn.silu(short_conv3(p[..., :2 * ML_QK_DIM], conv_w, conv_b))
    v = p[..., 2 * ML_QK_DIM:2 * ML_QK_DIM + ML_V_DIM]
    o = p[..., 2 * ML_QK_DIM + ML_V_DIM:2 * ML_QK_DIM + 2 * ML_V_DIM]
    gt = (p[..., 2 * ML_QK_DIM + 2 * ML_V_DIM:] + gate_b).astype(f32).transpose(0, 2, 1)

    def heads(a, dh):
        return a.reshape(B, L, ML_HEADS, dh).transpose(0, 2, 1, 3).astype(f32)

    q = heads(qk[..., :ML_QK_DIM], ML_DQK)
    k = heads(qk[..., ML_QK_DIM:], ML_DQK) / math.sqrt(ML_DQK)
    vh = heads(v, ML_DV)
    i_f, f_f, i_b, f_b = jnp.split(gt, 4, axis=1)
    h_f = mlstm_chunkwise(q, k, vh, i_f, jax.nn.log_sigmoid(f_f))
    flip = lambda a: jnp.flip(a, axis=2)
    h_b = flip(mlstm_chunkwise(flip(q), flip(k), flip(vh), flip(i_b), flip(jax.nn.log_sigmoid(f_b))))
    hs = h_f + h_b
    hs = hs * lax.rsqrt(jnp.mean(hs * hs, axis=-1, keepdims=True) + EPS)
    hs = hs.transpose(0, 2, 1, 3).reshape(B, L, ML_V_DIM) * head_g.astype(f32)
    return (hs.astype(h.dtype) * jax.nn.sigmoid(o)) @ w_out


def moe_ffn(h, router_w, router_bias, w_gate, w_up, w_down, sh_gate, sh_up, sh_down):
    B, L, D = h.shape
    t = h.reshape(B * L, D)
    T = B * L
    scores = jax.nn.sigmoid(t.astype(jnp.float32) @ router_w.astype(jnp.float32))
    sel = scores + router_bias.astype(jnp.float32)
    grp_score = jnp.sum(lax.top_k(sel.reshape(T, N_GROUPS, N_EXPERTS // N_GROUPS), 2)[0], axis=-1)
    _, gidx = lax.top_k(grp_score, TOPK_GROUPS)
    gmask = jnp.any(gidx[..., None] == jnp.arange(N_GROUPS), axis=-2)
    sel = jnp.where(jnp.repeat(gmask, N_EXPERTS // N_GROUPS, axis=-1), sel, -jnp.inf)
    _, eidx = lax.top_k(sel, TOP_K)
    wk = jnp.take_along_axis(scores, eidx, axis=-1)
    wk = wk / jnp.sum(wk, axis=-1, keepdims=True) * ROUTED_SCALE

    A = T * TOP_K
    flat_e = eidx.reshape(A)
    flat_w = wk.reshape(A).astype(t.dtype)
    flat_tok = jnp.arange(A, dtype=jnp.int32) // TOP_K
    order = jnp.argsort(flat_e)
    e_sorted = flat_e[order]
    counts = jnp.zeros(N_EXPERTS, jnp.int32).at[flat_e].add(1)
    padded = (counts + MOE_BLOCK - 1) // MOE_BLOCK * MOE_BLOCK
    pad_end = jnp.cumsum(padded)
    pad_start = pad_end - padded
    start = jnp.cumsum(counts) - counts
    dest = pad_start[e_sorted] + jnp.arange(A, dtype=jnp.int32) - start[e_sorted]
    P = (A + N_EXPERTS * (MOE_BLOCK - 1) + MOE_BLOCK - 1) // MOE_BLOCK * MOE_BLOCK
    n_blk = P // MOE_BLOCK
    slot_tok = jnp.zeros(P, jnp.int32).at[dest].set(flat_tok[order])
    slot_w = jnp.zeros(P, t.dtype).at[dest].set(flat_w[order])
    blk_e = jnp.minimum(jnp.searchsorted(pad_end, jnp.arange(n_blk, dtype=jnp.int32) * MOE_BLOCK, side='right'),
                        N_EXPERTS - 1)
    xb = t[slot_tok].reshape(n_blk, MOE_BLOCK, D)

    def expert_block(args):
        xe, e = args
        return (jax.nn.silu(xe @ w_gate[e]) * (xe @ w_up[e])) @ w_down[e]

    yb = lax.map(expert_block, (xb, blk_e)).reshape(P, D) * slot_w[:, None]
    routed = jnp.zeros_like(t).at[slot_tok].add(yb)
    shared = (jax.nn.silu(t @ sh_gate) * (t @ sh_up)) @ sh_down
    return (routed + shared).reshape(B, L, D)


def setup_inputs(seed: int = 0) -> dict:
    key = jax.random.key(seed)
    ks = iter(jax.random.split(key, 48))
    nrm = lambda shape, std: jax.random.normal(next(ks), shape, jnp.float32) * std
    D = D_MODEL
    NHY = N_HYENA_LAYERS
    NML = N_MLSTM_LAYERS
    FW = HY_FILTER_WIDTH
    i_bias = nrm((NML, 2, ML_HEADS), 0.1)
    f_bias = jnp.linspace(3.0, 6.0, ML_HEADS, dtype=jnp.float32) + nrm((NML, 2, ML_HEADS), 0.1)
    gate_b = jnp.stack([i_bias, f_bias], axis=2).reshape(NML, 4 * ML_HEADS)
    return {
        "x": nrm((BATCH, SEQ, D), 1.0),
        "c": nrm((BATCH, D), 1.0),
        "ada_w": nrm((DEPTH, D, 6 * D), 0.5 * D ** -0.5),
        "ada_b": nrm((DEPTH, 6 * D), 0.02),
        "norm_mix_g": 1.0 + nrm((DEPTH, D), 0.02),
        "norm_ffn_g": 1.0 + nrm((DEPTH, D), 0.02),
        "hy_w_in": nrm((NHY, D, HY_IN_DIM), D ** -0.5),
        "hy_conv_w": nrm((NHY, SHORT_CONV, HY_IN_DIM), SHORT_CONV ** -0.5),
        "hy_conv_b": nrm((NHY, HY_IN_DIM), 0.02),
        "hy_f_w0": nrm((NHY, HY_EMB, FW), HY_EMB ** -0.5),
        "hy_f_b0": nrm((NHY, FW), 0.02),
        "hy_f_w1": nrm((NHY, FW, FW), FW ** -0.5),
        "hy_f_b1": nrm((NHY, FW), 0.02),
        "hy_f_w2": nrm((NHY, FW, FW), FW ** -0.5),
        "hy_f_b2": nrm((NHY, FW), 0.02),
        "hy_f_freq": 1.0 + nrm((NHY, FW), 0.01),
        "hy_f_wout": nrm((NHY, FW, 2 * D), (FW * SEQ) ** -0.5),
        "hy_skip": nrm((NHY, D), 1.0),
        "hy_w_out": nrm((NHY, D, D), D ** -0.5),
        "ml_w_in": nrm((NML, D, ML_IN_DIM), D ** -0.5),
        "ml_conv_w": nrm((NML, SHORT_CONV, 2 * ML_QK_DIM), SHORT_CONV ** -0.5),
        "ml_conv_b": nrm((NML, 2 * ML_QK_DIM), 0.02),
        "ml_gate_b": gate_b,
        "ml_head_g": 1.0 + nrm((NML, ML_V_DIM), 0.02),
        "ml_w_out": nrm((NML, ML_V_DIM, D), ML_V_DIM ** -0.5),
        "moe_router_w": nrm((DEPTH, D, N_EXPERTS), D ** -0.5),
        "moe_router_bias": nrm((DEPTH, N_EXPERTS), 0.01),
        "moe_w_gate": nrm((DEPTH, N_EXPERTS, D, EXPERT_FF), D ** -0.5),
        "moe_w_up": nrm((DEPTH, N_EXPERTS, D, EXPERT_FF), D ** -0.5),
        "moe_w_down": nrm((DEPTH, N_EXPERTS, EXPERT_FF, D), EXPERT_FF ** -0.5),
        "sh_w_gate": nrm((DEPTH, D, SHARED_FF), D ** -0.5),
        "sh_w_up": nrm((DEPTH, D, SHARED_FF), D ** -0.5),
        "sh_w_down": nrm((DEPTH, SHARED_FF, D), SHARED_FF ** -0.5),
        "final_g": 1.0 + nrm((D,), 0.02),
    }


def reference(x, c, ada_w, ada_b, norm_mix_g, norm_ffn_g,
              hy_w_in, hy_conv_w, hy_conv_b, hy_f_w0, hy_f_b0, hy_f_w1, hy_f_b1, hy_f_w2, hy_f_b2,
              hy_f_freq, hy_f_wout, hy_skip, hy_w_out,
              ml_w_in, ml_conv_w, ml_conv_b, ml_gate_b, ml_head_g, ml_w_out,
              moe_router_w, moe_router_bias, moe_w_gate, moe_w_up, moe_w_down,
              sh_w_gate, sh_w_up, sh_w_down, final_g):
    cs = jax.nn.silu(c)
    for layer in range(DEPTH):
        ada = (cs @ ada_w[layer] + ada_b[layer])[:, None, :]
        sh_m, sc_m, g_m, sh_f, sc_f, g_f = jnp.split(ada, 6, axis=-1)
        hm = rms_norm(x, norm_mix_g[layer]) * (1.0 + sc_m) + sh_m
        j = layer // N_MIXERS
        if layer % N_MIXERS == 0:
            y = hyena_mixer(hm, hy_w_in[j], hy_conv_w[j], hy_conv_b[j], hy_f_w0[j], hy_f_b0[j],
                            hy_f_w1[j], hy_f_b1[j], hy_f_w2[j], hy_f_b2[j], hy_f_freq[j],
                            hy_f_wout[j], hy_skip[j], hy_w_out[j])
        else:
            y = mlstm_mixer(hm, ml_w_in[j], ml_conv_w[j], ml_conv_b[j], ml_gate_b[j],
                            ml_head_g[j], ml_w_out[j])
        x = x + g_m * y
        hf = rms_norm(x, norm_ffn_g[layer]) * (1.0 + sc_f) + sh_f
        x = x + g_f * moe_ffn(hf, moe_router_w[layer], moe_router_bias[layer], moe_w_gate[layer],
                              moe_w_up[layer], moe_w_down[layer], sh_w_gate[layer], sh_w_up[layer],
                              sh_w_down[layer])
    return rms_norm(x, final_g)
```

```cpp
#include <hip/hip_runtime.h>
#include <stdint.h>
#include <stdio.h>

#define LAS __attribute__((address_space(3)))
typedef unsigned short bf16_t;
typedef short bf16x8 __attribute__((ext_vector_type(8)));
typedef float f32x4 __attribute__((ext_vector_type(4)));
typedef unsigned u32x4 __attribute__((ext_vector_type(4)));
typedef unsigned u32x2 __attribute__((ext_vector_type(2)));

constexpr int T = 8192, D = 2048, NE = 64, FF = 512, TOPK = 6;
constexpr int NTHR = 512;
constexpr float EPS = 1e-6f;
#define REP_GEMM 1
#define REP_CVT 1
#define REP_MLS 1
#define REP_HYF 1
#define REP_F1 1
#define REP_TAP 1
#define REP_COMB 1
#define REP_PRO 1
#define REP_HCT 1

#define XB_TMO      128
#define XB_XCNT(j)  (256  + 64 * (j))
#define XB_XSUB(j)  (1280 + 64 * (j))
#define XB_XGEN(j)  (2304 + 64 * (j))
#define XB_TOP      3328
#define XB_TOPGEN   3392
#define XCD_BAR_WORDS 3456
#define XB_SPIN_CAP (1u << 18)

__device__ __forceinline__ unsigned xb_ld(unsigned* p)              { return __hip_atomic_load(p, __ATOMIC_RELAXED, __HIP_MEMORY_SCOPE_AGENT); }
__device__ __forceinline__ unsigned xb_add(unsigned* p, unsigned v) { return __hip_atomic_fetch_add(p, v, __ATOMIC_RELAXED, __HIP_MEMORY_SCOPE_AGENT); }
__device__ __forceinline__ unsigned xb_xcc_id() { return (unsigned)__builtin_amdgcn_s_getreg((3 << 11) | 20) & 0xFu; }
#define XB_SPIN(cond, bar) do { unsigned _sp = 0; while (cond) { __builtin_amdgcn_s_sleep(1); \
    if ((++_sp & 255u) == 0u) { if (xb_ld(&(bar)[XB_TMO])) break; if (_sp > XB_SPIN_CAP) { atomicAdd(&(bar)[XB_TMO], 1u); break; } } } } while (0)

struct XcdBarrier { unsigned* bar; unsigned x; volatile LAS unsigned* st; };

__device__ __forceinline__ XcdBarrier xcd_barrier_post(unsigned* bar, volatile LAS unsigned* st) {
    XcdBarrier b; b.bar = bar; b.x = xb_xcc_id(); b.st = st;
    if (threadIdx.x == 0) (void)xb_add(&bar[XB_XCNT(b.x)], 1u);
    return b;
}
__device__ __forceinline__ void xcd_barrier_complete(unsigned* bar, unsigned x, unsigned& nloc, unsigned& nx) {
    const unsigned G = gridDim.x * gridDim.y * gridDim.z;
    unsigned sum, cnt, mine, sp = 0u;
    for (;;) {
        sum = 0u; cnt = 0u; mine = 0u;
#pragma unroll
        for (unsigned j = 0; j < 16; ++j) { const unsigned c = xb_ld(&bar[XB_XCNT(j)]); sum += c; cnt += (c > 0u) ? 1u : 0u; mine = (j == x) ? c : mine; }
        if (sum == G) break;
        __builtin_amdgcn_s_sleep(1);
        if ((++sp & 255u) == 0u) { if (xb_ld(&bar[XB_TMO])) break; if (sp > XB_SPIN_CAP) { atomicAdd(&bar[XB_TMO], 1u); break; } }
    }
    nloc = mine > 0u ? mine : 1u; nx = cnt > 0u ? cnt : 1u;
}
__device__ __forceinline__ void xcd_barrier(const XcdBarrier& b) {
    asm volatile("s_waitcnt vmcnt(0)" ::: "memory");
    __syncthreads();
    if (threadIdx.x == 0) {
        unsigned* bar = b.bar;
        __builtin_amdgcn_s_waitcnt(0);
        unsigned nloc = b.st[0], nx = b.st[1];
        if (nloc == 0u) { xcd_barrier_complete(bar, b.x, nloc, nx); b.st[0] = nloc; b.st[1] = nx; }
        const unsigned old = xb_add(&bar[XB_XSUB(b.x)], 1u);
        const unsigned gen = old / nloc;
        if (old + 1u == (gen + 1u) * nloc) {
            __builtin_amdgcn_fence(__ATOMIC_RELEASE, "agent");
            asm volatile("s_waitcnt vmcnt(0)" ::: "memory");
            const unsigned og = xb_add(&bar[XB_TOP], 1u);
            const unsigned tg = og / nx;
            if (og + 1u == (tg + 1u) * nx) xb_add(&bar[XB_TOPGEN], 1u);
            else XB_SPIN(xb_ld(&bar[XB_TOPGEN]) == tg, bar);
            __builtin_amdgcn_fence(__ATOMIC_ACQUIRE, "agent");
            xb_add(&bar[XB_XGEN(b.x)], 1u);
            asm volatile("s_waitcnt vmcnt(0)" ::: "memory");
        } else {
            XB_SPIN(xb_ld(&bar[XB_XGEN(b.x)]) == gen, bar);
            __builtin_amdgcn_fence(__ATOMIC_ACQUIRE, "agent");
            asm volatile("s_waitcnt vmcnt(0)" ::: "memory");
        }
    }
    __syncthreads();
}

constexpr size_t WS_CTL   = 0;
constexpr size_t CTL_BYTES = 65536;
constexpr size_t CTL_CNT  = 16384;
constexpr size_t WS_ADA   = WS_CTL + CTL_BYTES;
constexpr size_t WS_WHYIN = WS_ADA + 131072;
constexpr size_t WS_WHYOUT= WS_WHYIN + (size_t)6144 * 2048 * 2;
constexpr size_t WS_WMLIN = WS_WHYOUT + (size_t)2048 * 2048 * 2;
constexpr size_t WS_WMLOUT= WS_WMLIN + (size_t)6144 * 2048 * 2;
constexpr size_t WS_WGU   = WS_WMLOUT + (size_t)2048 * 2048 * 2;
constexpr size_t WGU_L    = (size_t)65 * 1024 * 2048;
constexpr size_t WS_WD    = WS_WGU + 2 * WGU_L * 2;
constexpr size_t WD_L     = (size_t)65 * 2048 * 512;
constexpr size_t WS_HBUF  = WS_WD + 2 * WD_L * 2;
constexpr size_t WS_XA    = WS_HBUF + (size_t)T * D * 2;
constexpr size_t WS_XB    = WS_XA + (size_t)T * D * 4;
constexpr size_t WS_LIST  = WS_XB + (size_t)T * D * 4;
constexpr size_t WS_REC   = WS_LIST + (size_t)NE * T * 4;
constexpr int    SLOT_SH  = 65280;
constexpr int    NSLOT    = SLOT_SH + T;
constexpr size_t WS_H     = WS_REC + (size_t)T * TOPK * 8;
constexpr size_t WS_BIG   = WS_H + (size_t)NSLOT * FF * 2;
constexpr size_t WS_END   = WS_BIG + (size_t)NSLOT * D * 2;

constexpr int LDS_STAGE = 131072;
constexpr int LDS_MISC  = 135168;
constexpr int LDS_TSTART = LDS_MISC + 64;
constexpr int LDS_TILEE  = LDS_TSTART + 72 * 4;
constexpr int LDS_CNT    = LDS_TILEE + 320 * 4;
constexpr int LDS_BYTES  = LDS_MISC + 8192;

struct Params { const float* in[34]; float* out; unsigned char* ws; };
typedef const Params __attribute__((address_space(4)))* KP;
__device__ __forceinline__ int tid_fresh() { int t = threadIdx.x; asm volatile("" : "+v"(t)); return t; }
__device__ __forceinline__ KP kparams() { KP q = (KP)__builtin_amdgcn_kernarg_segment_ptr(); asm volatile("" : "+s"(q)); return q; }

__device__ __forceinline__ unsigned cvt_pk_bf16(float lo, float hi) { unsigned r; asm volatile("v_cvt_pk_bf16_f32 %0, %1, %2" : "=v"(r) : "v"(lo), "v"(hi)); return r; }
__device__ __forceinline__ float bf_lo(unsigned w) { return __uint_as_float(w << 16); }
__device__ __forceinline__ float bf_hi(unsigned w) { return __uint_as_float(w & 0xffff0000u); }
__device__ __forceinline__ float wave_sum(float v) {
#pragma unroll
    for (int o = 32; o > 0; o >>= 1) v += __shfl_xor(v, o);
    return v;
}
__device__ __forceinline__ float siluf(float v) { return v / (1.f + expf(-v)); }

constexpr int BM = 256, BK = 64, HALF = 128, HTB = HALF * BK * 2, NXCD = 8, WGM = 8;
__device__ __forceinline__ int lds_byte(int r, int c) { const int st = (r >> 4) * 2 + (c >> 5), rr = r & 15, cc = c & 31, ob = rr * 64 + cc * 2; return st * 1024 + (ob ^ (((ob >> 9) & 1) << 5)); }
__device__ __forceinline__ void stage_rc(int b, int& R, int& C) { const int st = b / 1024, sb = b % 1024, swz = sb ^ (((sb >> 9) & 1) << 5); R = (st >> 1) * 16 + swz / 64; C = (st & 1) * 32 + (swz % 64) / 2; }
__device__ __forceinline__ int perm32(int rho) { const int n = rho >> 4, i = rho & 15; return 8 * (i >> 2) + 4 * n + (i & 3); }

struct Unit { int pm, pn, e, rbase; };

template <class Epi, class Sched>
__device__ __forceinline__ void gemm_phase(LAS unsigned char* lds, const int K, const Sched& S, const Epi& E) {
    const int tid = tid_fresh(), wid = __builtin_amdgcn_readfirstlane(tid >> 6), lane = tid & 63, wr = wid >> 2, wc = wid & 3, fr = lane & 15, fq = lane >> 4;
    const int nt = K / BK;
    int R0, C0, R1, C1; stage_rc(tid * 16, R0, C0); stage_rc(tid * 16 + 8192, R1, C1);
    const int Rb0 = Epi::PERM ? ((R0 & ~31) + perm32(R0 & 31)) : R0, Rb1 = Epi::PERM ? ((R1 & ~31) + perm32(R1 & 31)) : R1;
    const unsigned voffB0 = S.b_off(Rb0, C0), voffB1 = S.b_off(Rb1, C1);
    const size_t kstep = (size_t)(BK * 2);
    const size_t kstepB = S.b_kstep(), hstep = S.b_hstep();
    const unsigned ldsw = (unsigned)wid * 1024u;
    const int aoff = lds_byte(wr * 64 + fr, fq * 8), boff = lds_byte(wc * 32 + fr, fq * 8);
#define PG8_SA(b, h) (((b) * 2 + (h)) * HTB)
#define PG8_SB(b, h) ((4 + (b) * 2 + (h)) * HTB)
#define PG8_STAGE(bufoff, gbase, v0, v1) do { \
        __builtin_amdgcn_global_load_lds((const unsigned*)((const char*)(gbase) + (v0)), (LAS unsigned*)(lds + (bufoff) + ldsw), 16, 0, 0); \
        __builtin_amdgcn_global_load_lds((const unsigned*)((const char*)(gbase) + (v1)), (LAS unsigned*)(lds + (bufoff) + ldsw + 8192), 16, 0, 0); } while (0)
#define PG8_LDA(dst, b, h) do { _Pragma("unroll") for (int m = 0; m < 4; ++m) _Pragma("unroll") for (int k = 0; k < 2; ++k) dst[m][k] = *(const LAS bf16x8*)(lds + PG8_SA(b, h) + aoff + m * 2048 + k * 1024); } while (0)
#define PG8_LDB(dst, b, h) do { _Pragma("unroll") for (int n = 0; n < 2; ++n) _Pragma("unroll") for (int k = 0; k < 2; ++k) dst[n][k] = *(const LAS bf16x8*)(lds + PG8_SB(b, h) + boff + n * 2048 + k * 1024); } while (0)
#define PG8_MMA(ai, bj, At, Bt) do { __builtin_amdgcn_s_setprio(1); _Pragma("unroll") for (int m = 0; m < 4; ++m) _Pragma("unroll") for (int n = 0; n < 2; ++n) _Pragma("unroll") for (int k = 0; k < 2; ++k) \
        acc[ai][bj][m][n] = __builtin_amdgcn_mfma_f32_16x16x32_bf16(Bt[n][k], At[m][k], acc[ai][bj][m][n], 0, 0, 0); __builtin_amdgcn_s_setprio(0); } while (0)
#define PG8_WAIT_V(n) asm volatile("s_waitcnt vmcnt(" #n ")" ::: "memory")
#define PG8_WAIT_L(n) asm volatile("s_waitcnt lgkmcnt(" #n ")" ::: "memory")
#define PG8_BAR __builtin_amdgcn_s_barrier()
#define PG8_SCHED __builtin_amdgcn_sched_barrier(0)
#define PG8_AOFFS(u, o00, o01, o10, o11) do { S.a_off4(u, R0, R1, o00, o01, o10, o11); o00 += (unsigned)C0 * 2u; o01 += (unsigned)C1 * 2u; o10 += (unsigned)C0 * 2u; o11 += (unsigned)C1 * 2u; } while (0)
    Unit cur, nxt; int ui = 0;
    if (!S.next(0, cur)) return;
    f32x4 acc[2][2][4][2];
#pragma unroll
    for (int a = 0; a < 2; ++a)
#pragma unroll
        for (int b = 0; b < 2; ++b)
#pragma unroll
            for (int m = 0; m < 4; ++m)
#pragma unroll
                for (int n = 0; n < 2; ++n) acc[a][b][m][n] = (f32x4){0.f, 0.f, 0.f, 0.f};
    bf16x8 At[4][2], B0[2][2], B1[2][2];
    const char* const gA = S.a_base();
    unsigned c00, c01, c10, c11, n00, n01, n10, n11;
    PG8_AOFFS(cur, c00, c01, c10, c11);
    const char* cB = S.b_ptr(cur);
    PG8_STAGE(PG8_SB(0, 0), cB, voffB0, voffB1); PG8_STAGE(PG8_SA(0, 0), gA, c00, c01); PG8_STAGE(PG8_SB(0, 1), cB + hstep, voffB0, voffB1); PG8_STAGE(PG8_SA(0, 1), gA, c10, c11);
    if (wr == 1) PG8_BAR;
    PG8_WAIT_V(4); PG8_BAR;
    PG8_STAGE(PG8_SB(1, 0), cB + kstepB, voffB0, voffB1); PG8_STAGE(PG8_SA(1, 0), gA + kstep, c00, c01); PG8_STAGE(PG8_SB(1, 1), cB + hstep + kstepB, voffB0, voffB1);
    PG8_WAIT_V(6); PG8_BAR;
    for (;;) {
        const bool has_next = S.next(ui + 1, nxt);
        const char* nB = cB;
        if (has_next) { PG8_AOFFS(nxt, n00, n01, n10, n11); nB = S.b_ptr(nxt); } else { n00 = c00; n01 = c01; n10 = c10; n11 = c11; }
        for (int t = 0; t < nt; t += 2) {
            const bool last = (t == nt - 2);
            const char* a1 = gA + (size_t)(t + 1) * kstep;
            const char* a2 = last ? gA : gA + (size_t)(t + 2) * kstep; const char* b2 = last ? nB : cB + (size_t)(t + 2) * kstepB;
            const char* a3 = a2 + kstep; const char* b3 = b2 + kstepB;
            const unsigned x00 = last ? n00 : c00, x01 = last ? n01 : c01, x10 = last ? n10 : c10, x11 = last ? n11 : c11;
            PG8_LDB(B0, 0, 0); PG8_SCHED; PG8_LDA(At, 0, 0); PG8_STAGE(PG8_SA(1, 1), a1, c10, c11);
            PG8_WAIT_L(8); PG8_BAR; PG8_WAIT_L(0); PG8_MMA(0, 0, At, B0); PG8_BAR; PG8_SCHED;
            PG8_LDB(B1, 0, 1); PG8_STAGE(PG8_SB(0, 0), b2, voffB0, voffB1);
            PG8_BAR; PG8_WAIT_L(0); PG8_MMA(0, 1, At, B1); PG8_BAR;
            PG8_LDA(At, 0, 1); PG8_STAGE(PG8_SA(0, 0), a2, x00, x01);
            PG8_BAR; PG8_WAIT_L(0); PG8_MMA(1, 0, At, B0); PG8_BAR; PG8_SCHED;
            PG8_STAGE(PG8_SB(0, 1), b2 + hstep, voffB0, voffB1);
            PG8_WAIT_V(6); PG8_BAR; PG8_MMA(1, 1, At, B1); PG8_BAR;
            PG8_LDB(B0, 1, 0); PG8_SCHED; PG8_LDA(At, 1, 0); PG8_STAGE(PG8_SA(0, 1), a2, x10, x11);
            PG8_WAIT_L(8); PG8_BAR; PG8_WAIT_L(0); PG8_MMA(0, 0, At, B0); PG8_BAR; PG8_SCHED;
            PG8_LDB(B1, 1, 1); PG8_STAGE(PG8_SB(1, 0), b3, voffB0, voffB1);
            PG8_BAR; PG8_WAIT_L(0); PG8_MMA(0, 1, At, B1); PG8_BAR;
            PG8_LDA(At, 1, 1); PG8_STAGE(PG8_SA(1, 0), a3, x00, x01);
            PG8_BAR; PG8_WAIT_L(0); PG8_MMA(1, 0, At, B0); PG8_BAR; PG8_SCHED;
            PG8_STAGE(PG8_SB(1, 1), b3 + hstep, voffB0, voffB1);
            PG8_WAIT_V(6); PG8_BAR; PG8_MMA(1, 1, At, B1); PG8_BAR;
        }
        E(acc, cur, wr, wc, fr, fq);
        if (!has_next) break;
#pragma unroll
        for (int a = 0; a < 2; ++a)
#pragma unroll
            for (int b = 0; b < 2; ++b)
#pragma unroll
                for (int m = 0; m < 4; ++m)
#pragma unroll
                    for (int n = 0; n < 2; ++n) acc[a][b][m][n] = (f32x4){0.f, 0.f, 0.f, 0.f};
        cur = nxt; cB = nB; c00 = n00; c01 = n01; c10 = n10; c11 = n11; ++ui;
    }
    PG8_WAIT_V(0);
    if (wr == 0) PG8_BAR;
    PG8_BAR;
#undef PG8_SA
#undef PG8_SB
#undef PG8_STAGE
#undef PG8_LDA
#undef PG8_LDB
#undef PG8_MMA
#undef PG8_WAIT_V
#undef PG8_WAIT_L
#undef PG8_BAR
#undef PG8_SCHED
#undef PG8_AOFFS
}

struct DenseOrder {
    const bf16_t* A; const bf16_t* Bt; int K, nM, nN, nwg, G, c;
    __device__ __forceinline__ void init(const bf16_t* A_, const bf16_t* Bt_, int M, int N, int K_, int G_, int c_) { A = A_; Bt = Bt_; K = K_; nM = M / BM; nN = N / BM; nwg = nM * nN; G = G_; c = c_; }
    __device__ __forceinline__ bool next(int i, Unit& u) const {
        const long L = (long)i * G + c; if (L >= nwg) return false;
        int wgid = (int)L; { const int q = nwg / NXCD, r = nwg % NXCD, xcd = wgid % NXCD, off = wgid / NXCD; wgid = (xcd < r ? xcd * (q + 1) : r * (q + 1) + (xcd - r) * q) + off; }
        const int nig = WGM * nN, gid = wgid / nig, fm = gid * WGM, gsz = (nM - fm) < WGM ? (nM - fm) : WGM;
        u.pm = fm + ((wgid % nig) % gsz); u.pn = (wgid % nig) / gsz; u.e = 0; u.rbase = u.pm * BM; return true;
    }
    __device__ __forceinline__ const char* a_base() const { return (const char*)A; }
    __device__ __forceinline__ unsigned a_off(const Unit& u, int r) const { return (unsigned)((u.pm * BM + r) * K) * 2u; }
    __device__ __forceinline__ void a_off4(const Unit& u, int r0, int r1, unsigned& o00, unsigned& o01, unsigned& o10, unsigned& o11) const { o00 = a_off(u, r0); o01 = a_off(u, r1); o10 = a_off(u, HALF + r0); o11 = a_off(u, HALF + r1); }
    __device__ __forceinline__ const char* b_ptr(const Unit& u) const { return (const char*)(Bt + (size_t)u.pn * BM * K); }
    __device__ __forceinline__ unsigned b_off(int R, int C) const { return (unsigned)(R * K + C) * 2u; }
    __device__ __forceinline__ size_t b_kstep() const { return (size_t)(BK * 2); }
    __device__ __forceinline__ size_t b_hstep() const { return (size_t)HALF * K * 2; }
};
struct MoeGuOrder {
    const bf16_t* A; const bf16_t* W; const int* list; const LAS int* tstart; const LAS int* tile_e; const LAS int* cnt; int ntiles, G, c;
    __device__ __forceinline__ bool next(int i, Unit& u) const {
        const int L = i * G + c; if (L >= ntiles * 4) return false;
        const int rt = L >> 2; u.pn = L & 3; u.e = tile_e[rt]; u.pm = rt - tstart[u.e]; u.rbase = (u.e < NE) ? rt * BM : SLOT_SH + u.pm * BM; return true;
    }
    __device__ __forceinline__ const char* a_base() const { return (const char*)A; }
    __device__ __forceinline__ unsigned a_off(const Unit& u, int r) const {
        const int pos = u.pm * BM + r; int tok = pos;
        if (u.e < NE) { tok = 0; if (pos < cnt[u.e]) tok = list[u.e * T + pos]; }
        return (unsigned)tok * (unsigned)(D * 2);
    }
    __device__ __forceinline__ void a_off4(const Unit& u, int r0, int r1, unsigned& o00, unsigned& o01, unsigned& o10, unsigned& o11) const {
        const int p0 = u.pm * BM + r0, p1 = u.pm * BM + r1, p2 = p0 + HALF, p3 = p1 + HALF;
        if (u.e >= NE) { o00 = (unsigned)p0 * (unsigned)(D * 2); o01 = (unsigned)p1 * (unsigned)(D * 2); o10 = (unsigned)p2 * (unsigned)(D * 2); o11 = (unsigned)p3 * (unsigned)(D * 2); return; }
        const int* lp = list + u.e * T;
        int v0 = lp[p0], v1 = lp[p1], v2 = lp[p2], v3 = lp[p3];
        asm volatile("" : "+v"(v0), "+v"(v1), "+v"(v2), "+v"(v3));
        const int c = cnt[u.e];
        o00 = p0 < c ? (unsigned)v0 * (unsigned)(D * 2) : 0u; o01 = p1 < c ? (unsigned)v1 * (unsigned)(D * 2) : 0u;
        o10 = p2 < c ? (unsigned)v2 * (unsigned)(D * 2) : 0u; o11 = p3 < c ? (unsigned)v3 * (unsigned)(D * 2) : 0u;
    }
    __device__ __forceinline__ const char* b_ptr(const Unit& u) const { return (const char*)(W + (size_t)u.e * 1024 * D + (size_t)u.pn * BM * 8); }
    __device__ __forceinline__ unsigned b_off(int R, int C) const { return (unsigned)((C >> 3) * 1024 + R) * 16u; }
    __device__ __forceinline__ size_t b_kstep() const { return (size_t)8 * 1024 * 16; }
    __device__ __forceinline__ size_t b_hstep() const { return (size_t)HALF * 16; }
};
struct MoeDownOrder {
    const bf16_t* A; const bf16_t* W; const LAS int* tstart; const LAS int* tile_e; int ntiles, G, c;
    __device__ __forceinline__ bool next(int i, Unit& u) const {
        const int L = i * G + c; if (L >= ntiles * 8) return false;
        const int rt = L >> 3; u.pn = L & 7; u.e = tile_e[rt]; u.pm = rt - tstart[u.e]; u.rbase = (u.e < NE) ? rt * BM : SLOT_SH + u.pm * BM; return true;
    }
    __device__ __forceinline__ const char* a_base() const { return (const char*)A; }
    __device__ __forceinline__ unsigned a_off(const Unit& u, int r) const { return (unsigned)((u.rbase + r) * FF) * 2u; }
    __device__ __forceinline__ void a_off4(const Unit& u, int r0, int r1, unsigned& o00, unsigned& o01, unsigned& o10, unsigned& o11) const { o00 = a_off(u, r0); o01 = a_off(u, r1); o10 = a_off(u, HALF + r0); o11 = a_off(u, HALF + r1); }
    __device__ __forceinline__ const char* b_ptr(const Unit& u) const { return (const char*)(W + (size_t)u.e * D * FF + (size_t)u.pn * BM * 8); }
    __device__ __forceinline__ unsigned b_off(int R, int C) const { return (unsigned)((C >> 3) * D + R) * 16u; }
    __device__ __forceinline__ size_t b_kstep() const { return (size_t)8 * D * 16; }
    __device__ __forceinline__ size_t b_hstep() const { return (size_t)HALF * 16; }
};

struct EpiBf16 {
    static constexpr bool PERM = true;
    bf16_t* O; int ldc;
    __device__ __forceinline__ void operator()(const f32x4 (&acc)[2][2][4][2], const Unit& u, int wr, int wc, int fr, int fq) const {
        const int row0 = u.rbase + wr * 64 + fr, col0 = u.pn * BM + wc * 32 + 8 * fq;
#pragma unroll
        for (int ai = 0; ai < 2; ++ai)
#pragma unroll
            for (int m = 0; m < 4; ++m) { bf16_t* rowp = O + (size_t)(row0 + ai * HALF + m * 16) * ldc + col0;
#pragma unroll
                for (int bj = 0; bj < 2; ++bj) { const f32x4 v0 = acc[ai][bj][m][0], v1 = acc[ai][bj][m][1];
                    u32x4 w; w.x = cvt_pk_bf16(v0[0], v0[1]); w.y = cvt_pk_bf16(v0[2], v0[3]); w.z = cvt_pk_bf16(v1[0], v1[1]); w.w = cvt_pk_bf16(v1[2], v1[3]);
                    *(u32x4*)(rowp + bj * HALF) = w; } }
    }
};
__device__ __forceinline__ unsigned pk4_fp8(float a, float b, float c, float d) { int w = 0; w = __builtin_amdgcn_cvt_pk_fp8_f32(a, b, w, false); w = __builtin_amdgcn_cvt_pk_fp8_f32(c, d, w, true); return (unsigned)w; }
typedef float f32x2v __attribute__((ext_vector_type(2)));
constexpr float Y8_SCALE = 16.f, Y8_INV = 1.f / 16.f;
struct EpiF8 {
    static constexpr bool PERM = true;
    unsigned char* O; int ldc; float scale;
    __device__ __forceinline__ void operator()(const f32x4 (&acc)[2][2][4][2], const Unit& u, int wr, int wc, int fr, int fq) const {
        const int row0 = u.rbase + wr * 64 + fr, col0 = u.pn * BM + wc * 32 + 8 * fq;
#pragma unroll
        for (int ai = 0; ai < 2; ++ai)
#pragma unroll
            for (int m = 0; m < 4; ++m) { unsigned char* rowp = O + (size_t)(row0 + ai * HALF + m * 16) * ldc + col0;
#pragma unroll
                for (int bj = 0; bj < 2; ++bj) { const f32x4 v0 = acc[ai][bj][m][0] * scale, v1 = acc[ai][bj][m][1] * scale;
                    u32x2 w; w.x = pk4_fp8(v0[0], v0[1], v0[2], v0[3]); w.y = pk4_fp8(v1[0], v1[1], v1[2], v1[3]);
                    *(u32x2*)(rowp + bj * HALF) = w; } }
    }
};
struct EpiSwiglu {
    static constexpr bool PERM = true;
    bf16_t* O;
    __device__ __forceinline__ void operator()(const f32x4 (&acc)[2][2][4][2], const Unit& u, int wr, int wc, int fr, int fq) const {
        const int row0 = u.rbase + wr * 64 + fr, col0 = u.pn * HALF + wc * 32 + 8 * fq;
#pragma unroll
        for (int ai = 0; ai < 2; ++ai)
#pragma unroll
            for (int m = 0; m < 4; ++m) { bf16_t* rowp = O + (size_t)(row0 + ai * HALF + m * 16) * FF + col0;
                float h[8];
#pragma unroll
                for (int n = 0; n < 2; ++n)
#pragma unroll
                    for (int j = 0; j < 4; ++j) { const float g = acc[ai][0][m][n][j], up = acc[ai][1][m][n][j]; h[n * 4 + j] = g / (1.f + __expf(-g)) * up; }
                u32x4 w; w.x = cvt_pk_bf16(h[0], h[1]); w.y = cvt_pk_bf16(h[2], h[3]); w.z = cvt_pk_bf16(h[4], h[5]); w.w = cvt_pk_bf16(h[6], h[7]);
                *(u32x4*)rowp = w; }
    }
};
struct EpiResid {
    static constexpr bool PERM = false;
    const float* xin; float* out; const float* gate;
    __device__ __forceinline__ void operator()(const f32x4 (&acc)[2][2][4][2], const Unit& u, int wr, int wc, int fr, int fq) const {
        const int row0 = u.rbase + wr * 64 + fr, col0 = u.pn * BM + wc * 32 + 4 * fq;
        f32x4 gv[2][2];
#pragma unroll
        for (int bj = 0; bj < 2; ++bj)
#pragma unroll
            for (int n = 0; n < 2; ++n) gv[bj][n] = *(const f32x4*)(gate + col0 + bj * HALF + n * 16);
#pragma unroll
        for (int ai = 0; ai < 2; ++ai) {
            f32x4 xv[4][2][2];
#pragma unroll
            for (int m = 0; m < 4; ++m) { const size_t ro = (size_t)(row0 + ai * HALF + m * 16) * D + col0;
#pragma unroll
                for (int bj = 0; bj < 2; ++bj)
#pragma unroll
                    for (int n = 0; n < 2; ++n) xv[m][bj][n] = *(const f32x4*)(xin + ro + bj * HALF + n * 16); }
#pragma unroll
            for (int m = 0; m < 4; ++m) { const size_t ro = (size_t)(row0 + ai * HALF + m * 16) * D + col0;
#pragma unroll
                for (int bj = 0; bj < 2; ++bj)
#pragma unroll
                    for (int n = 0; n < 2; ++n) *(f32x4*)(out + ro + bj * HALF + n * 16) = xv[m][bj][n] + gv[bj][n] * acc[ai][bj][m][n]; }
        }
    }
};

__device__ __forceinline__ void cvt_group(LAS float* tile, int bid, int G, const float* src, size_t sbs, int ldS, int K, int N, bf16_t* dst, size_t dbs, int mode, int nbatch, int nrimg = 0) {
    const int tid = tid_fresh();
    const int tk = K / 64, tn = N / 256, per = tk * tn, total = per * nbatch;
    const int kr = tid >> 6, c4 = tid & 63;
    for (int j = bid; j < total; j += G) {
        const int b = j / per, r = j - b * per, kt = r / tn, ntile = r - kt * tn;
        const float* s = src + (size_t)b * sbs + (size_t)(kt * 64) * ldS + ntile * 256;
        float4 v[8];
#pragma unroll
        for (int q = 0; q < 8; ++q) v[q] = *(const float4*)(s + (size_t)(kr + 8 * q) * ldS + c4 * 4);
        __syncthreads();
#pragma unroll
        for (int q = 0; q < 8; ++q) { LAS float* tp = tile + (kr + 8 * q) * 257 + c4 * 4; tp[0] = v[q].x; tp[1] = v[q].y; tp[2] = v[q].z; tp[3] = v[q].w; }
        __syncthreads();
        bf16_t* dmat = dst + (size_t)b * dbs;
#pragma unroll
        for (int q = 0; q < 4; ++q) {
            const int id = tid + NTHR * q, nr = id >> 3, kc = id & 7;
            const int n = ntile * 256 + nr;
            const int drow = (mode == 0) ? n : ((n >> 7) * 256 + (mode == 2 ? 128 : 0) + (n & 127));
            const LAS float* tp = tile + (kc * 8) * 257 + nr;
            u32x4 w; w.x = cvt_pk_bf16(tp[0], tp[257]); w.y = cvt_pk_bf16(tp[2 * 257], tp[3 * 257]); w.z = cvt_pk_bf16(tp[4 * 257], tp[5 * 257]); w.w = cvt_pk_bf16(tp[6 * 257], tp[7 * 257]);
            if (nrimg) *(u32x4*)(dmat + ((size_t)(kt * 8 + kc) * nrimg + drow) * 8) = w;
            else *(u32x4*)(dmat + (size_t)drow * K + kt * 64 + kc * 8) = w;
        }
    }
    __syncthreads();
}

__device__ __forceinline__ void ada_phase(LAS float* sm, int bid, int G, const float* c, const float* ada_w, const float* ada_b, float* ada) {
    const int tid = tid_fresh();
    LAS float* cs = sm; LAS float* red = sm + 2048;
    for (int i = tid; i < D; i += NTHR) cs[i] = siluf(c[i]);
    __syncthreads();
    const int kg = tid >> 5, c4 = tid & 31;
    for (int j = bid; j < 192; j += G) {
        const int l = j / 96, cb = j - l * 96;
        const float* w = ada_w + (size_t)l * D * 12288 + (size_t)(kg * 128) * 12288 + cb * 128 + c4 * 4;
        float4 a = make_float4(0.f, 0.f, 0.f, 0.f);
#pragma unroll 8
        for (int k = 0; k < 128; ++k) { const float4 wv = *(const float4*)(w + (size_t)k * 12288); const float s = cs[kg * 128 + k]; a.x += s * wv.x; a.y += s * wv.y; a.z += s * wv.z; a.w += s * wv.w; }
        __syncthreads();
        LAS float* rp = red + kg * 128 + c4 * 4; rp[0] = a.x; rp[1] = a.y; rp[2] = a.z; rp[3] = a.w;
        __syncthreads();
        if (tid < 128) { float s = 0.f;
#pragma unroll
            for (int q = 0; q < 16; ++q) s += red[q * 128 + tid];
            ada[l * 12288 + cb * 128 + tid] = s + ada_b[l * 12288 + cb * 128 + tid]; }
    }
    __syncthreads();
}

__device__ __forceinline__ void row_norm_mod(float4 (&v)[8], int lane, const float* g, const float* sc, const float* sh) {
    float4 ga[8], s1a[8], s0a[8];
#pragma unroll
    for (int i = 0; i < 8; ++i) { const int c = (lane + 64 * i) * 4; ga[i] = *(const float4*)(g + c); s1a[i] = *(const float4*)(sc + c); s0a[i] = *(const float4*)(sh + c); }
    float ss = 0.f;
#pragma unroll
    for (int i = 0; i < 8; ++i) ss += v[i].x * v[i].x + v[i].y * v[i].y + v[i].z * v[i].z + v[i].w * v[i].w;
    ss = wave_sum(ss);
    const float r = rsqrtf(ss * (1.f / D) + EPS);
#pragma unroll
    for (int i = 0; i < 8; ++i) { const float4 gg = ga[i], s1 = s1a[i], s0 = s0a[i];
        v[i].x = v[i].x * r * gg.x * (1.f + s1.x) + s0.x; v[i].y = v[i].y * r * gg.y * (1.f + s1.y) + s0.y; v[i].z = v[i].z * r * gg.z * (1.f + s1.z) + s0.z; v[i].w = v[i].w * r * gg.w * (1.f + s1.w) + s0.w; }
}

__device__ __forceinline__ void row_norm_mod2(float4 (&v0)[8], float4 (&v1)[8], int lane, const float* g, const float* sc, const float* sh) {
    float4 ga[8], s1a[8];
#pragma unroll
    for (int i = 0; i < 8; ++i) { const int c = (lane + 64 * i) * 4; ga[i] = *(const float4*)(g + c); s1a[i] = *(const float4*)(sc + c); }
    float ssa = 0.f, ssb = 0.f;
#pragma unroll
    for (int i = 0; i < 8; ++i) { ssa += v0[i].x * v0[i].x + v0[i].y * v0[i].y + v0[i].z * v0[i].z + v0[i].w * v0[i].w; ssb += v1[i].x * v1[i].x + v1[i].y * v1[i].y + v1[i].z * v1[i].z + v1[i].w * v1[i].w; }
    ssa = wave_sum(ssa); ssb = wave_sum(ssb);
    const float ra = rsqrtf(ssa * (1.f / D) + EPS), rb = rsqrtf(ssb * (1.f / D) + EPS);
#pragma unroll
    for (int i = 0; i < 8; ++i) { const int c = (lane + 64 * i) * 4; const float4 gg = ga[i], s1 = s1a[i], s0 = *(const float4*)(sh + c);
        v0[i].x = v0[i].x * ra * gg.x * (1.f + s1.x) + s0.x; v0[i].y = v0[i].y * ra * gg.y * (1.f + s1.y) + s0.y; v0[i].z = v0[i].z * ra * gg.z * (1.f + s1.z) + s0.z; v0[i].w = v0[i].w * ra * gg.w * (1.f + s1.w) + s0.w;
        v1[i].x = v1[i].x * rb * gg.x * (1.f + s1.x) + s0.x; v1[i].y = v1[i].y * rb * gg.y * (1.f + s1.y) + s0.y; v1[i].z = v1[i].z * rb * gg.z * (1.f + s1.z) + s0.z; v1[i].w = v1[i].w * rb * gg.w * (1.f + s1.w) + s0.w; }
}

constexpr int HFS_LD = 2050;
template <int NT>
__device__ __forceinline__ void rows16_matmul(const LAS float* hfs, const float* W, int ldw, int col0, int wave, int lane, f32x4 (&acc)[NT]) {
#pragma unroll
    for (int jt = 0; jt < NT; ++jt) acc[jt] = (f32x4){0.f, 0.f, 0.f, 0.f};
    const LAS float* ap = hfs + (lane & 15) * HFS_LD + wave * 256 + (lane >> 4);
    const float* bp = W + (size_t)(wave * 256 + (lane >> 4)) * ldw + col0 + (lane & 15);
#pragma unroll 8
    for (int s4 = 0; s4 < 64; ++s4) {
        const float a = ap[s4 * 4];
        float b[NT];
#pragma unroll
        for (int jt = 0; jt < NT; ++jt) b[jt] = bp[(size_t)(s4 * 4) * ldw + jt * 16];
#pragma unroll
        for (int jt = 0; jt < NT; ++jt) acc[jt] = __builtin_amdgcn_mfma_f32_16x16x4f32(a, b[jt], acc[jt], 0, 0, 0);
    }
}

__device__ __forceinline__ void route_phase(LAS unsigned char* lds, int bid, int G, const float* x, const float* g, const float* sc, const float* sh,
                                            const float* rw, const float* rbias, bf16_t* hbuf, int* cnt, int* list, u32x2* rec) {
    LAS float* hfs = (LAS float*)lds;
    LAS float* part = (LAS float*)lds;
    for (int r0 = bid * 16; r0 < T; r0 += G * 16) {
        const int tid = tid_fresh();
        const int lane = tid & 63, wave = tid >> 6;
        __syncthreads();
        {   const int row = r0 + wave * 2;
            float4 va[8], vb[8];
#pragma unroll
            for (int i = 0; i < 8; ++i) { va[i] = *(const float4*)(x + (size_t)row * D + (lane + 64 * i) * 4); vb[i] = *(const float4*)(x + (size_t)(row + 1) * D + (lane + 64 * i) * 4); }
            row_norm_mod2(va, vb, lane, g, sc, sh);
#pragma unroll
            for (int i = 0; i < 8; ++i) { const int c = (lane + 64 * i) * 4;
                u32x2 w; w.x = cvt_pk_bf16(va[i].x, va[i].y); w.y = cvt_pk_bf16(va[i].z, va[i].w); *(u32x2*)(hbuf + (size_t)row * D + c) = w;
                u32x2 w2; w2.x = cvt_pk_bf16(vb[i].x, vb[i].y); w2.y = cvt_pk_bf16(vb[i].z, vb[i].w); *(u32x2*)(hbuf + (size_t)(row + 1) * D + c) = w2;
                LAS float* hp = hfs + (wave * 2) * HFS_LD + c; hp[0] = va[i].x; hp[1] = va[i].y; hp[2] = va[i].z; hp[3] = va[i].w;
                hp[HFS_LD] = vb[i].x; hp[HFS_LD + 1] = vb[i].y; hp[HFS_LD + 2] = vb[i].z; hp[HFS_LD + 3] = vb[i].w; }
        }
        __syncthreads();
        f32x4 acc[4];
        rows16_matmul<4>(hfs, rw, NE, 0, wave, lane, acc);
        __syncthreads();
#pragma unroll
        for (int jt = 0; jt < 4; ++jt)
#pragma unroll
            for (int r = 0; r < 4; ++r) part[(wave * 16 + (lane >> 4) * 4 + r) * 64 + jt * 16 + (lane & 15)] = acc[jt][r];
        __syncthreads();
#pragma unroll 1
        for (int rr = 0; rr < 2; ++rr) {
            const int rl = wave * 2 + rr, row = r0 + rl;
            float logit = 0.f;
#pragma unroll
            for (int w = 0; w < 8; ++w) logit += part[(w * 16 + rl) * 64 + lane];
            const float score = 1.f / (1.f + expf(-logit));
            const float sel = score + rbias[lane];
            float m1 = sel; m1 = fmaxf(m1, __shfl_xor(m1, 1)); m1 = fmaxf(m1, __shfl_xor(m1, 2)); m1 = fmaxf(m1, __shfl_xor(m1, 4));
            const unsigned long long bal = __ballot(sel == m1);
            const unsigned gbits = (unsigned)(bal >> (lane & ~7)) & 0xffu;
            const int idx1 = (lane & ~7) + __ffs(gbits) - 1;
            float m2 = (lane == idx1) ? -INFINITY : sel; m2 = fmaxf(m2, __shfl_xor(m2, 1)); m2 = fmaxf(m2, __shfl_xor(m2, 2)); m2 = fmaxf(m2, __shfl_xor(m2, 4));
            const float gs = m1 + m2;
            const int grp = lane >> 3; int grank = 0;
#pragma unroll
            for (int gp = 0; gp < 8; ++gp) { const float o = __shfl(gs, gp * 8); grank += ((o > gs) || (o == gs && gp < grp)) ? 1 : 0; }
            const bool elig = grank < 4;
            const float sm = elig ? sel : -INFINITY;
            int rank = 0;
            for (int j = 0; j < 64; ++j) { const float o = __shfl(sm, j); rank += ((o > sm) || (o == sm && j < lane)) ? 1 : 0; }
            const bool chosen = elig && rank < TOPK;
            const float wsum = wave_sum(chosen ? score : 0.f);
            const float wgt = score / wsum * 2.5f;
            const unsigned long long cb = __ballot(chosen);
            if (chosen) {
                const int pos = atomicAdd(&cnt[lane], 1);
                list[lane * T + pos] = row;
                const int j = __popcll(cb & ((1ull << lane) - 1ull));
                u32x2 rr2; rr2.x = (unsigned)(lane * T + pos); rr2.y = __float_as_uint(wgt);
                rec[row * TOPK + j] = rr2;
            }
        }
    }
    __syncthreads();
}

__device__ __forceinline__ int moe_tables(LAS unsigned char* ldsb, int* cnt_g) {
    const int tid = tid_fresh();
    LAS int* tstart = (LAS int*)(ldsb + LDS_TSTART); LAS int* tile_e = (LAS int*)(ldsb + LDS_TILEE); LAS int* cl = (LAS int*)(ldsb + LDS_CNT);
    __syncthreads();
    if (tid < NE) cl[tid] = (int)__hip_atomic_load((unsigned*)cnt_g + tid, __ATOMIC_RELAXED, __HIP_MEMORY_SCOPE_AGENT);
    __syncthreads();
    if (tid == 0) { int s = 0; for (int e = 0; e < NE; ++e) { tstart[e] = s; s += (cl[e] + BM - 1) / BM; } tstart[NE] = s; tstart[NE + 1] = s + T / BM; }
    __syncthreads();
    const int ntiles = tstart[NE + 1];
    for (int i = tid; i < ntiles; i += NTHR) { int e = 0; while (e < NE && i >= tstart[e + 1]) ++e; tile_e[i] = e; }
    __syncthreads();
    return ntiles;
}

template <int MODE>
__device__ __forceinline__ void combine_phase(LAS unsigned char* ldsb, int bid, int G, const float* x, const float* gf, const bf16_t* Y, const u32x2* rec,
                                              float* xout, const float* ng, const float* sc, const float* sh, bf16_t* hbuf) {
    const LAS int* tstart = (const LAS int*)(ldsb + LDS_TSTART);
    const int wave0 = tid_fresh() >> 6;
    for (int rowi = bid * 16 + wave0 * 2; rowi < T; rowi += ((rowi & 1) ? (G * 16 - 1) : 1)) {
        const int row = rowi;
        const int lane = tid_fresh() & 63;
        float a[4][8];
#pragma unroll
        for (int i = 0; i < 4; ++i)
#pragma unroll
            for (int q = 0; q < 8; ++q) a[i][q] = 0.f;
        u32x2 rr[TOPK];
#pragma unroll
        for (int j = 0; j < TOPK; ++j) rr[j] = rec[row * TOPK + j];
        float4 xr[4][2];
#pragma unroll
        for (int i = 0; i < 4; ++i) { const int c = lane * 8 + i * 512; xr[i][0] = *(const float4*)(x + (size_t)row * D + c); xr[i][1] = *(const float4*)(x + (size_t)row * D + c + 4); }
#pragma unroll
        for (int jb = 0; jb <= TOPK; jb += 8) {
            u32x2 yv[7][4]; float wj[7];
#pragma unroll
            for (int jj = 0; jj < 7; ++jj) { const int j = jb + jj; if (j > TOPK) break;
                size_t slot = (size_t)SLOT_SH + row; wj[jj] = Y8_INV;
                if (j < TOPK) { const int e = (int)(rr[j].x >> 13), pos = (int)(rr[j].x & 8191u); wj[jj] = __uint_as_float(rr[j].y) * Y8_INV; slot = (size_t)tstart[e] * BM + pos; }
                const unsigned char* yp = (const unsigned char*)Y + slot * D + lane * 8;
#pragma unroll
                for (int i = 0; i < 4; ++i) yv[jj][i] = *(const u32x2*)(yp + i * 512);
            }
#pragma unroll
            for (int jj = 0; jj < 7; ++jj) { const int j = jb + jj; if (j > TOPK) break; const float w = wj[jj];
#pragma unroll
                for (int i = 0; i < 4; ++i) { const u32x2 y2 = yv[jj][i];
                    const f32x2v p0 = __builtin_amdgcn_cvt_pk_f32_fp8((int)y2.x, false), p1 = __builtin_amdgcn_cvt_pk_f32_fp8((int)y2.x, true), p2 = __builtin_amdgcn_cvt_pk_f32_fp8((int)y2.y, false), p3 = __builtin_amdgcn_cvt_pk_f32_fp8((int)y2.y, true);
                    a[i][0] += w * p0.x; a[i][1] += w * p0.y; a[i][2] += w * p1.x; a[i][3] += w * p1.y;
                    a[i][4] += w * p2.x; a[i][5] += w * p2.y; a[i][6] += w * p3.x; a[i][7] += w * p3.y; }
            }
            asm volatile("" ::: "memory");
        }
        float ss = 0.f;
#pragma unroll
        for (int i = 0; i < 4; ++i) { const int c = lane * 8 + i * 512;
#pragma unroll
            for (int h = 0; h < 2; ++h) { const float4 xv = xr[i][h], gv = *(const float4*)(gf + c + h * 4);
                a[i][h * 4 + 0] = xv.x + gv.x * a[i][h * 4 + 0]; a[i][h * 4 + 1] = xv.y + gv.y * a[i][h * 4 + 1]; a[i][h * 4 + 2] = xv.z + gv.z * a[i][h * 4 + 2]; a[i][h * 4 + 3] = xv.w + gv.w * a[i][h * 4 + 3]; }
#pragma unroll
            for (int q = 0; q < 8; ++q) ss += a[i][q] * a[i][q]; }
        if (MODE == 0 || MODE == 2) {
#pragma unroll
            for (int i = 0; i < 4; ++i) { float* op = xout + (size_t)row * D + lane * 8 + i * 512; *(float4*)op = make_float4(a[i][0], a[i][1], a[i][2], a[i][3]); *(float4*)(op + 4) = make_float4(a[i][4], a[i][5], a[i][6], a[i][7]); }
        }
        if (MODE == 1 || MODE == 2) {
            ss = wave_sum(ss);
            const float r = rsqrtf(ss * (1.f / D) + EPS);
            asm volatile("" ::: "memory");
            float4 g4[4][2];
#pragma unroll
            for (int i = 0; i < 4; ++i) { const int c = lane * 8 + i * 512; g4[i][0] = *(const float4*)(ng + c); g4[i][1] = *(const float4*)(ng + c + 4); }
#pragma unroll
            for (int i = 0; i < 4; ++i) { const int c = lane * 8 + i * 512; float o[8];
                const float gq[8] = {g4[i][0].x, g4[i][0].y, g4[i][0].z, g4[i][0].w, g4[i][1].x, g4[i][1].y, g4[i][1].z, g4[i][1].w};
#pragma unroll
                for (int q = 0; q < 8; ++q) { o[q] = a[i][q] * r * gq[q]; if (MODE == 2) o[q] = o[q] * (1.f + sc[c + q]) + sh[c + q]; }
                if (MODE == 1) { float* op = xout + (size_t)row * D + c; *(float4*)op = make_float4(o[0], o[1], o[2], o[3]); *(float4*)(op + 4) = make_float4(o[4], o[5], o[6], o[7]); }
                else { u32x4 w; w.x = cvt_pk_bf16(o[0], o[1]); w.y = cvt_pk_bf16(o[2], o[3]); w.z = cvt_pk_bf16(o[4], o[5]); w.w = cvt_pk_bf16(o[6], o[7]); *(u32x4*)(hbuf + (size_t)row * D + c) = w; } }
        }
    }
}

constexpr int BG_STEPS = 2 * 3 * 4096 * 8;
struct BgState { float r[64]; bf16_t* dst[2]; int o2[2]; int st; };
__device__ __forceinline__ bool bg_decode(int st, int wg, int NW, int lane, KP kp, const float*& src, int& ldS, bf16_t*& dst, int& o2) {
    const int g = st * NW + wg;
    if (g >= BG_STEPS) { src = kp->in[27] + lane; ldS = 0; dst = nullptr; o2 = 0; return false; }
    const int l = g / 98304, r = g - l * 98304;
    unsigned char* ws = kp->ws;
    if (r < 65536) {
        const int e = r >> 10, kc = (r >> 2) & 255, kind = (r >> 1) & 1, cc = r & 1, n = cc * 256 + lane;
        ldS = FF; o2 = 256 * 8;
        src = kp->in[27 + kind] + ((size_t)(l * NE + e) * D + kc * 8) * FF + n;
        const int drow = (n >> 7) * 256 + kind * 128 + (n & 127);
        dst = (bf16_t*)(ws + WS_WGU) + l * WGU_L + (size_t)e * 1024 * D + ((size_t)kc * 1024 + drow) * 8;
    } else {
        const int r2 = r - 65536, e = r2 >> 9, kc = (r2 >> 3) & 63, cc = r2 & 7, n = cc * 256 + lane;
        ldS = D; o2 = 128 * 8;
        src = kp->in[29] + ((size_t)(l * NE + e) * FF + kc * 8) * D + n;
        dst = (bf16_t*)(ws + WS_WD) + l * WD_L + (size_t)e * D * FF + ((size_t)kc * D + n) * 8;
    }
    return true;
}
template <int NS> __device__ __forceinline__ void bg_issue(BgState& b, int wg, int NW, int lane) {
    KP kp = kparams();
#pragma unroll
    for (int s = 0; s < NS; ++s) { const float* src; int ldS; bf16_t* dst; int o2;
        bg_decode(b.st + s, wg, NW, lane, kp, src, ldS, dst, o2);
        b.dst[s] = dst; b.o2[s] = o2;
#pragma unroll
        for (int i = 0; i < 8; ++i) { const float* p = src + (size_t)i * ldS;
            asm volatile("global_load_dword %0, %4, off\n\tglobal_load_dword %1, %4, off offset:256\n\tglobal_load_dword %2, %4, off offset:512\n\tglobal_load_dword %3, %4, off offset:768"
                         : "=&v"(b.r[(s * 8 + i) * 4 + 0]), "=&v"(b.r[(s * 8 + i) * 4 + 1]), "=&v"(b.r[(s * 8 + i) * 4 + 2]), "=&v"(b.r[(s * 8 + i) * 4 + 3]) : "v"(p) : "memory"); }
    }
}
#define BG_TIE16(o) "+v"(b.r[o + 0]), "+v"(b.r[o + 1]), "+v"(b.r[o + 2]), "+v"(b.r[o + 3]), "+v"(b.r[o + 4]), "+v"(b.r[o + 5]), "+v"(b.r[o + 6]), "+v"(b.r[o + 7]), "+v"(b.r[o + 8]), "+v"(b.r[o + 9]), "+v"(b.r[o + 10]), "+v"(b.r[o + 11]), "+v"(b.r[o + 12]), "+v"(b.r[o + 13]), "+v"(b.r[o + 14]), "+v"(b.r[o + 15])
template <int NS> __device__ __forceinline__ void bg_finish(BgState& b, int wg, int NW, int lane) {
    asm volatile("s_waitcnt vmcnt(0)" ::: "memory");
    asm volatile("" : BG_TIE16(0) :: "memory");
    asm volatile("" : BG_TIE16(16) :: "memory");
    if (NS == 2) { asm volatile("" : BG_TIE16(32) :: "memory"); asm volatile("" : BG_TIE16(48) :: "memory"); }
#pragma unroll
    for (int s = 0; s < NS; ++s) { bf16_t* dst = b.dst[s];
        if (dst != nullptr) {
#pragma unroll
            for (int c = 0; c < 4; ++c) { u32x4 w;
                w.x = cvt_pk_bf16(b.r[(s * 8 + 0) * 4 + c], b.r[(s * 8 + 1) * 4 + c]); w.y = cvt_pk_bf16(b.r[(s * 8 + 2) * 4 + c], b.r[(s * 8 + 3) * 4 + c]);
                w.z = cvt_pk_bf16(b.r[(s * 8 + 4) * 4 + c], b.r[(s * 8 + 5) * 4 + c]); w.w = cvt_pk_bf16(b.r[(s * 8 + 6) * 4 + c], b.r[(s * 8 + 7) * 4 + c]);
                bf16_t* dp = dst + (c & 1) * 512 + (c >> 1) * b.o2[s];
                asm volatile("global_store_dwordx4 %0, %1, off\n\ts_nop 1" :: "v"(dp), "v"(w) : "memory"); }
        } }
    b.st += NS;
}
template <int BANK> __device__ __forceinline__ void bg_issue1(BgState& b, int wg, int NW, int lane) {
    KP kp = kparams();
    const float* src; int ldS; bf16_t* dst; int o2;
    bg_decode(b.st, wg, NW, lane, kp, src, ldS, dst, o2);
    b.dst[BANK] = dst; b.o2[BANK] = o2;
    asm volatile("s_nop 6" ::: "memory");
#pragma unroll
    for (int i = 0; i < 8; ++i) { const float* p = src + (size_t)i * ldS;
        asm volatile("global_load_dword %0, %4, off\n\tglobal_load_dword %1, %4, off offset:256\n\tglobal_load_dword %2, %4, off offset:512\n\tglobal_load_dword %3, %4, off offset:768"
                     : "=&v"(b.r[(BANK * 8 + i) * 4 + 0]), "=&v"(b.r[(BANK * 8 + i) * 4 + 1]), "=&v"(b.r[(BANK * 8 + i) * 4 + 2]), "=&v"(b.r[(BANK * 8 + i) * 4 + 3]) : "v"(p) : "memory"); }
    b.st += 1;
}
template <int BANK, int WAITN> __device__ __forceinline__ void bg_finish1(BgState& b) {
    if (WAITN == 32) asm volatile("s_waitcnt vmcnt(32)" ::: "memory"); else asm volatile("s_waitcnt vmcnt(0)" ::: "memory");
    asm volatile("" : BG_TIE16(BANK * 32) :: "memory");
    asm volatile("" : BG_TIE16(BANK * 32 + 16) :: "memory");
    bf16_t* dst = b.dst[BANK];
    if (dst != nullptr) {
#pragma unroll
        for (int c = 0; c < 4; ++c) { u32x4 w;
            w.x = cvt_pk_bf16(b.r[(BANK * 8 + 0) * 4 + c], b.r[(BANK * 8 + 1) * 4 + c]); w.y = cvt_pk_bf16(b.r[(BANK * 8 + 2) * 4 + c], b.r[(BANK * 8 + 3) * 4 + c]);
            w.z = cvt_pk_bf16(b.r[(BANK * 8 + 4) * 4 + c], b.r[(BANK * 8 + 5) * 4 + c]); w.w = cvt_pk_bf16(b.r[(BANK * 8 + 6) * 4 + c], b.r[(BANK * 8 + 7) * 4 + c]);
            bf16_t* dp = dst + (c & 1) * 512 + (c >> 1) * b.o2[BANK];
            asm volatile("global_store_dwordx4 %0, %1, off\n\ts_nop 1" :: "v"(dp), "v"(w) : "memory"); }
    }
}
#undef BG_TIE16

constexpr size_t BIG_U    = 0;
constexpr size_t BIG_X0C  = (size_t)104857600;
constexpr size_t BIG_VGT  = (size_t)146800640;
constexpr size_t BIG_A3   = (size_t)220200960;
constexpr size_t BIG_GSPEC = (size_t)230686720;
#define FFT_HD __device__ __forceinline__
typedef float cf2 __attribute__((ext_vector_type(2)));
FFT_HD cf2 mk2(float x, float y) { return (cf2){x, y}; }
FFT_HD void fft_sincos(float frac, float& s, float& c) { s = __builtin_amdgcn_sinf(frac); c = __builtin_amdgcn_cosf(frac); }
constexpr int FN = 16384;
#define PADI(n) ((n) + (((n) >> 6) << 1))
constexpr int FN_PAD = FN + (FN >> 6) * 2;
FFT_HD cf2 cmul(cf2 a, cf2 b) { return mk2(a.x * b.x - a.y * b.y, a.x * b.y + a.y * b.x); }
FFT_HD cf2 cmulc(cf2 a, cf2 b) { return mk2(a.x * b.x + a.y * b.y, a.y * b.x - a.x * b.y); }
FFT_HD cf2 cadd(cf2 a, cf2 b) { return mk2(a.x + b.x, a.y + b.y); }
FFT_HD cf2 csub(cf2 a, cf2 b) { return mk2(a.x - b.x, a.y - b.y); }
template <bool INV> FFT_HD void dft4(cf2& a, cf2& b, cf2& c, cf2& d) {
    const cf2 s0 = cadd(a, c), s1 = csub(a, c), s2 = cadd(b, d), s3 = csub(b, d);
    a = cadd(s0, s2); c = csub(s0, s2);
    const cf2 r = INV ? mk2(-s3.y, s3.x) : mk2(s3.y, -s3.x);
    b = cadd(s1, r); d = csub(s1, r);
}
template <bool INV> FFT_HD void dft16(cf2 (&x)[16]) {
    const float C1 = 0.9238795325112867f, S1 = 0.3826834323650898f, H = 0.7071067811865476f;
#pragma unroll
    for (int b = 0; b < 4; ++b) dft4<INV>(x[b], x[4 + b], x[8 + b], x[12 + b]);
    const float s = INV ? -1.f : 1.f;
    x[4 + 1] = cmul(x[4 + 1], mk2(C1, -s * S1)); x[8 + 1] = cmul(x[8 + 1], mk2(H, -s * H));   x[12 + 1] = cmul(x[12 + 1], mk2(S1, -s * C1));
    x[4 + 2] = cmul(x[4 + 2], mk2(H, -s * H));   x[8 + 2] = cmul(x[8 + 2], mk2(0.f, -s));     x[12 + 2] = cmul(x[12 + 2], mk2(-H, -s * H));
    x[4 + 3] = cmul(x[4 + 3], mk2(S1, -s * C1)); x[8 + 3] = cmul(x[8 + 3], mk2(-H, -s * H));  x[12 + 3] = cmul(x[12 + 3], mk2(-C1, s * S1));
#pragma unroll
    for (int c = 0; c < 4; ++c) dft4<INV>(x[4 * c], x[4 * c + 1], x[4 * c + 2], x[4 * c + 3]);
#pragma unroll
    for (int c = 0; c < 4; ++c)
#pragma unroll
        for (int d = c + 1; d < 4; ++d) { const cf2 t = x[4 * c + d]; x[4 * c + d] = x[4 * d + c]; x[4 * d + c] = t; }
}
FFT_HD void fft_gen_tw(float frac, cf2 (&tw)[16]) {
    float sn, cs; fft_sincos(frac, sn, cs);
    tw[1] = mk2(cs, -sn);
    tw[2] = cmul(tw[1], tw[1]); tw[3] = cmul(tw[2], tw[1]); tw[4] = cmul(tw[2], tw[2]); tw[5] = cmul(tw[4], tw[1]); tw[6] = cmul(tw[4], tw[2]); tw[7] = cmul(tw[4], tw[3]);
    tw[8] = cmul(tw[4], tw[4]);
#pragma unroll
    for (int j = 9; j < 16; ++j) tw[j] = cmul(tw[8], tw[j - 8]);
}
template <bool INV, int lS, class ZP> FFT_HD void fft_r16_pass(ZP z, int tid) {
    constexpr int S = 1 << lS, STEP = (S >= 64) ? S + S / 32 : S;
    constexpr float inv = 1.0f / (float)(16 * S);
    cf2 tw[16];
    if (lS != 10) {
        fft_gen_tw((float)(tid & (S - 1)) * inv, tw);
        const int w0 = tid, w1 = tid + 512;
        const int pb0 = PADI(((w0 >> lS) << (lS + 4)) + (w0 & (S - 1))), pb1 = PADI(((w1 >> lS) << (lS + 4)) + (w1 & (S - 1)));
        cf2 x[16], y[16];
#pragma unroll
        for (int j = 0; j < 16; ++j) x[j] = z[pb0 + j * STEP];
#pragma unroll
        for (int j = 0; j < 16; ++j) y[j] = z[pb1 + j * STEP];
        if (INV) {
#pragma unroll
            for (int j = 1; j < 16; ++j) x[j] = cmulc(x[j], tw[j]);
        }
        dft16<INV>(x);
        if (!INV) {
#pragma unroll
            for (int j = 1; j < 16; ++j) x[j] = cmul(x[j], tw[j]);
        }
#pragma unroll
        for (int j = 0; j < 16; ++j) z[pb0 + j * STEP] = x[j];
        if (INV) {
#pragma unroll
            for (int j = 1; j < 16; ++j) y[j] = cmulc(y[j], tw[j]);
        }
        dft16<INV>(y);
        if (!INV) {
#pragma unroll
            for (int j = 1; j < 16; ++j) y[j] = cmul(y[j], tw[j]);
        }
#pragma unroll
        for (int j = 0; j < 16; ++j) z[pb1 + j * STEP] = y[j];
    } else {
#pragma unroll 1
        for (int it = 0; it < 2; ++it) {
            const int w = tid + 512 * it;
            const int blk = w >> lS, p = w & (S - 1), pb = PADI((blk << (lS + 4)) + p);
            fft_gen_tw((float)p * inv, tw);
            cf2 x[16];
#pragma unroll
            for (int j = 0; j < 16; ++j) x[j] = z[pb + j * STEP];
            if (INV) {
#pragma unroll
                for (int j = 1; j < 16; ++j) x[j] = cmulc(x[j], tw[j]);
            }
            dft16<INV>(x);
            if (!INV) {
#pragma unroll
                for (int j = 1; j < 16; ++j) x[j] = cmul(x[j], tw[j]);
            }
#pragma unroll
            for (int j = 0; j < 16; ++j) z[pb + j * STEP] = x[j];
        }
    }
}
template <bool INV, class ZP> FFT_HD void fft_r4_pass(ZP z, int tid, int nthr) {
    for (int w = tid; w < FN / 4; w += nthr) {
        const int base = PADI(4 * w);
        cf2 a = z[base], b = z[base + 1], c = z[base + 2], d = z[base + 3];
        dft4<INV>(a, b, c, d);
        z[base] = a; z[base + 1] = b; z[base + 2] = c; z[base + 3] = d;
    }
}
FFT_HD int fpos(int k) { return ((k & 15) << 10) + (((k >> 4) & 15) << 6) + (((k >> 8) & 15) << 2) + (k >> 12); }

__device__ __forceinline__ void hy_filter_mlp(LAS float* sm, int bid, int G, const float* w0, const float* b0, const float* w1, const float* b1, const float* w2, const float* b2, const float* freq, float* a3) {
    const int tid = tid_fresh(), lane = tid & 63, wave = tid >> 6;
    LAS float* w0s = sm; LAS float* w1s = sm + 33 * 64; LAS float* w2s = w1s + 4096;
    __syncthreads();
    for (int i = tid; i < 33 * 64; i += NTHR) w0s[i] = w0[i];
    for (int i = tid; i < 4096; i += NTHR) { w1s[i] = w1[i]; w2s[i] = w2[i]; }
    __syncthreads();
    const float fr = freq[lane], bb0 = b0[lane], bb1 = b1[lane], bb2 = b2[lane];
    for (int row = bid * 8 + wave; row < T; row += G * 8) {
        const float tn = (float)row / (float)(T - 1);
        const float ang = 6.283185307179586f * (float)row / (float)T;
        float zi = 0.f;
        if (lane == 0) zi = tn;
        else if (lane <= 16) { const float band = 1e-4f + (float)(lane - 1) * ((15.f - 1e-4f) / 15.f); zi = cosf(ang * band); }
        else if (lane <= 32) { const float band = 1e-4f + (float)(lane - 17) * ((15.f - 1e-4f) / 15.f); zi = -sinf(ang * band); }
        float acc = bb0;
#pragma unroll 1
        for (int i = 0; i < 33; ++i) acc += __shfl(zi, i) * w0s[i * 64 + lane];
        float a = sinf(fr * acc);
        acc = bb1;
#pragma unroll 4
        for (int i = 0; i < 64; ++i) acc += __shfl(a, i) * w1s[i * 64 + lane];
        a = sinf(fr * acc);
        acc = bb2;
#pragma unroll 4
        for (int i = 0; i < 64; ++i) acc += __shfl(a, i) * w2s[i * 64 + lane];
        a = sinf(fr * acc);
        a3[(size_t)row * 64 + lane] = a;
    }
    __syncthreads();
}

__device__ __forceinline__ void hy_conv_phase(LAS unsigned char* lds, int bid, int G, const bf16_t* u, const float* cw, const float* cb, bf16_t* x0c, bf16_t* vgT) {
    LAS float* sm = (LAS float*)lds;
    const int tid = tid_fresh();
#define HC_LOAD(tile_, v_) do { const int t0_ = ((tile_) >> 5) * 64, c0_ = ((tile_) & 31) * 64; \
        _Pragma("unroll") for (int it = 0; it < 4; ++it) { const int id0 = tid + NTHR * it, id = id0 < 3 * 66 * 8 ? id0 : 3 * 66 * 8 - 1; \
            const int g = id / 528, r = id - g * 528, row = r >> 3, ch = r & 7, t1 = t0_ - 1 + row, t = t1 < 0 ? 0 : (t1 > T - 1 ? T - 1 : t1); \
            v_[it] = *(const u32x4*)(u + (size_t)t * 6144 + g * 2048 + c0_ + ch * 8); } } while (0)
    u32x4 pv[4];
    if (bid < 4096) HC_LOAD(bid, pv);
    float wa[8], wb[8], wc_[8], wd[8]; float p0 = 0.f, p1 = 0.f, p2 = 0.f, pb = 0.f, q0 = 0.f, q1 = 0.f, q2 = 0.f, qb = 0.f; int cwc0 = -1;
    for (int tile = bid; tile < 4096; tile += G) {
        const int t0 = (tile >> 5) * 64, c0 = (tile & 31) * 64;
        if (c0 != cwc0) { cwc0 = c0;
#pragma unroll
            for (int q = 0; q < 8; ++q) { const int cc = c0 + (tid & 7) * 8 + q; wa[q] = cw[cc]; wb[q] = cw[6144 + cc]; wc_[q] = cw[12288 + cc]; wd[q] = cb[cc]; }
            const int c1 = 2048 + c0 + (tid >> 3), c2 = 4096 + c0 + (tid >> 3);
            p0 = cw[c1]; p1 = cw[6144 + c1]; p2 = cw[12288 + c1]; pb = cb[c1]; q0 = cw[c2]; q1 = cw[6144 + c2]; q2 = cw[12288 + c2]; qb = cb[c2]; }
        __syncthreads();
#pragma unroll
        for (int it = 0; it < 4; ++it) { const int id = tid + NTHR * it;
            if (id < 3 * 66 * 8) { const int g = id / 528, r = id - g * 528, row = r >> 3, ch = r & 7; const u32x4 v = pv[it];
                const int tr = t0 - 1 + row; const float mk = (tr >= 0 && tr < T) ? 1.f : 0.f;
                LAS float* dp = sm + (g * 66 + row) * 65 + ch * 8;
                dp[0] = bf_lo(v.x) * mk; dp[1] = bf_hi(v.x) * mk; dp[2] = bf_lo(v.y) * mk; dp[3] = bf_hi(v.y) * mk; dp[4] = bf_lo(v.z) * mk; dp[5] = bf_hi(v.z) * mk; dp[6] = bf_lo(v.w) * mk; dp[7] = bf_hi(v.w) * mk; } }
        if (tile + G < 4096) HC_LOAD(tile + G, pv);
        __syncthreads();
        {   const int t = tid >> 3, ch = tid & 7; float o[8];
#pragma unroll
            for (int q = 0; q < 8; ++q) { const int c = ch * 8 + q;
                o[q] = sm[t * 65 + c] * wa[q] + sm[(t + 1) * 65 + c] * wb[q] + sm[(t + 2) * 65 + c] * wc_[q] + wd[q]; }
            u32x4 w; w.x = cvt_pk_bf16(o[0], o[1]); w.y = cvt_pk_bf16(o[2], o[3]); w.z = cvt_pk_bf16(o[4], o[5]); w.w = cvt_pk_bf16(o[6], o[7]);
            *(u32x4*)(x0c + (size_t)(t0 + t) * D + c0 + ch * 8) = w; }
        {   const int c = tid >> 3, tc = tid & 7;
            float o[8];
#pragma unroll
            for (int q = 0; q < 8; ++q) { const int t = tc * 8 + q;
                const float x1 = sm[(66 + t) * 65 + c] * p0 + sm[(66 + t + 1) * 65 + c] * p1 + sm[(66 + t + 2) * 65 + c] * p2 + pb;
                const float vv = sm[(132 + t) * 65 + c] * q0 + sm[(132 + t + 1) * 65 + c] * q1 + sm[(132 + t + 2) * 65 + c] * q2 + qb;
                o[q] = x1 * vv; }
            u32x4 w; w.x = cvt_pk_bf16(o[0], o[1]); w.y = cvt_pk_bf16(o[2], o[3]); w.z = cvt_pk_bf16(o[4], o[5]); w.w = cvt_pk_bf16(o[6], o[7]);
            *(u32x4*)(vgT + (size_t)(c0 + c) * T + t0 + tc * 8) = w; }
    }
#undef HC_LOAD
    __syncthreads();
}

#define SEG_LD32(dst, off, base) asm volatile("global_load_dword %0, %1, %2" : "=v"(dst) : "v"(off), "s"(base) : "memory")
#define SEG_LD64(dst, off, base) asm volatile("global_load_dwordx2 %0, %1, %2" : "=v"(dst) : "v"(off), "s"(base) : "memory")
#define SEG_WAIT() asm volatile("s_waitcnt vmcnt(32)\n\ts_nop 7" ::: "memory")
#define SEG_TIE8(a, o) "+v"(a[o + 0]), "+v"(a[o + 1]), "+v"(a[o + 2]), "+v"(a[o + 3]), "+v"(a[o + 4]), "+v"(a[o + 5]), "+v"(a[o + 6]), "+v"(a[o + 7])
constexpr int GS_LD = 8256;
__device__ __forceinline__ void hy_fft_phase(LAS unsigned char* lds, int bid, int G, const bf16_t* vgT, bf16_t* zT, const float* a3, const float* wout, const float* skip, float* filt, float4* gspec) {
    LAS cf2* z = (LAS cf2*)lds;
    bf16_t* F = (bf16_t*)filt + (size_t)bid * 8 * FN;
    u32x2* GS = (u32x2*)gspec + (size_t)bid * GS_LD;
    BgState bg; bg.st = 0; const int bgNW = G * 8; int bgwg, bglane;
    { const int t0_ = tid_fresh(); bgwg = __builtin_amdgcn_readfirstlane(bid * 8 + (t0_ >> 6)); bglane = t0_ & 63; }
#define BG_BEGIN(ns) bg_issue<ns>(bg, bgwg, bgNW, bglane)
#define BG_END(ns) bg_finish<ns>(bg, bgwg, bgNW, bglane)
#define BG_I(x) bg_issue1<x>(bg, bgwg, bgNW, bglane)
#define BG_F(y) bg_finish1<y, 32>(bg)
    const int nch = (D - bid + G - 1) / G;
    for (int g0 = 0; g0 < nch; g0 += 8) {
#pragma unroll 1
        for (int rept_ = 0; rept_ < REP_TAP; ++rept_)
        {
            const int tid = tid_fresh(), lane = tid & 63, wave = tid >> 6, col = lane & 15, kc = lane >> 4;
            const int ci = g0 + (col >> 1), c = bid + G * ci; const bool cok = ci < nch;
            bf16x8 bw[2];
#pragma unroll
            for (int ks = 0; ks < 2; ++ks) { float wv[8];
#pragma unroll
                for (int q = 0; q < 8; ++q) wv[q] = wout[(size_t)(ks * 32 + kc * 8 + q) * 4096 + (col & 1) * D + (cok ? c : bid)] * (cok ? 1.f : 0.f);
                u32x4 w; w.x = cvt_pk_bf16(wv[0], wv[1]); w.y = cvt_pk_bf16(wv[2], wv[3]); w.z = cvt_pk_bf16(wv[4], wv[5]); w.w = cvt_pk_bf16(wv[6], wv[7]);
                bw[ks] = __builtin_bit_cast(bf16x8, w); }
            const float dlo = -15.350567286626973f, dhi = -3.0701134573253946f;
            const float delta = fabsf(dlo + (float)c * ((dhi - dlo) / (float)(D - 1)));
            __syncthreads();
            auto tap_load = [&](int blk, float4 (&av)[4]) {
                const float* ap = a3 + (size_t)(blk * 16 + col) * 64 + kc * 8;
                av[0] = *(const float4*)(ap); av[1] = *(const float4*)(ap + 4); av[2] = *(const float4*)(ap + 32); av[3] = *(const float4*)(ap + 36);
            };
            auto tap_blk = [&](int blk, const float4 (&av)[4]) {
                f32x4 acc = (f32x4){0.f, 0.f, 0.f, 0.f};
#pragma unroll
                for (int ks = 0; ks < 2; ++ks) { const float4 a0 = av[ks * 2], a1 = av[ks * 2 + 1];
                    u32x4 w; w.x = cvt_pk_bf16(a0.x, a0.y); w.y = cvt_pk_bf16(a0.z, a0.w); w.z = cvt_pk_bf16(a1.x, a1.y); w.w = cvt_pk_bf16(a1.z, a1.w);
                    acc = __builtin_amdgcn_mfma_f32_16x16x32_bf16(__builtin_bit_cast(bf16x8, w), bw[ks], acc, 0, 0, 0); }
                const int tb = blk * 16 + kc * 4;
                float4 o;
                o.x = acc[0] * expf(-((float)(tb + 0) / (float)(T - 1)) * delta); o.y = acc[1] * expf(-((float)(tb + 1) / (float)(T - 1)) * delta);
                o.z = acc[2] * expf(-((float)(tb + 2) / (float)(T - 1)) * delta); o.w = acc[3] * expf(-((float)(tb + 3) / (float)(T - 1)) * delta);
                bf16_t* Arow = F + (size_t)(col >> 1) * FN;
                if ((col & 1) == 0) { u32x2 w; w.x = cvt_pk_bf16(o.x, o.y); w.y = cvt_pk_bf16(o.z, o.w); *(u32x2*)(Arow + tb) = w; }
                else {
                    Arow[FN - tb - 3] = (bf16_t)(cvt_pk_bf16(o.w, 0.f) & 0xffffu);
                    *(unsigned*)(Arow + FN - tb - 2) = cvt_pk_bf16(o.z, o.y);
                    if (tb > 0) Arow[FN - tb] = (bf16_t)(cvt_pk_bf16(o.x, 0.f) & 0xffffu); else Arow[T] = (bf16_t)0;
                }
            };
            BG_I(0);
#pragma unroll 1
            for (int ob = 0; ob < 8; ob += 2) {
                BG_I(1);
#define TAP_GROUP(b0) do { float4 av_[4][4]; \
                    _Pragma("unroll") for (int bi = 0; bi < 4; ++bi) tap_load(wave + 8 * ((b0) + bi), av_[bi]); \
                    _Pragma("unroll") for (int bi = 0; bi < 4; ++bi) tap_blk(wave + 8 * ((b0) + bi), av_[bi]); } while (0)
                TAP_GROUP(ob * 8); TAP_GROUP(ob * 8 + 4);
                BG_F(0);
                BG_I(0);
                TAP_GROUP((ob + 1) * 8); TAP_GROUP((ob + 1) * 8 + 4);
#undef TAP_GROUP
                BG_F(1);
            }
            __syncthreads();
        }
        int tid = tid_fresh();
#define FFT_FWD_ALL() do { tid = tid_fresh(); BG_I(0); fft_r16_pass<false, 10>(z, tid); __syncthreads(); BG_F(1); BG_I(1); fft_r16_pass<false, 6>(z, tid); __syncthreads(); BG_F(0); BG_I(0); fft_r16_pass<false, 2>(z, tid); __syncthreads(); BG_F(1); BG_I(1); fft_r4_pass<false>(z, tid, NTHR); __syncthreads(); BG_F(0); } while (0)
        for (int ci = g0; ci < g0 + 8 && ci < nch; ci += 2) {
            const bool has2 = (ci + 1 < nch);
            const int c1 = bid + G * ci, c2 = has2 ? bid + G * (ci + 1) : c1;
            const bf16_t* A1 = F + (size_t)(ci - g0) * FN; const bf16_t* A2 = has2 ? A1 + FN : A1;
            const bf16_t* v1 = vgT + (size_t)c1 * T; const bf16_t* v2 = vgT + (size_t)c2 * T;
            __syncthreads();
#pragma unroll 1
            for (int rep_ = 0; rep_ < REP_F1; ++rep_) {
            tid = tid_fresh();
            {   unsigned pa[16], pb[16]; float sk[2];
                const float* skp = skip; asm volatile("" : "+s"(skp));
#pragma unroll
                for (int i = 0; i < 16; ++i) { const unsigned off = 4u * tid + 2048u * i; SEG_LD32(pa[i], off, A1); SEG_LD32(pb[i], off, A2); }
                { const unsigned o1 = 4u * c1, o2 = 4u * c2; SEG_LD32(sk[0], o1, skp); SEG_LD32(sk[1], o2, skp); }
                BG_I(1);
                SEG_WAIT(); asm volatile("" : SEG_TIE8(pa, 0), SEG_TIE8(pa, 8), SEG_TIE8(pb, 0) :: "memory");
                asm volatile("" : SEG_TIE8(pb, 8), "+v"(sk[0]), "+v"(sk[1]) :: "memory");
                const float sk1 = (tid == 0) ? sk[0] : 0.f, sk2 = (tid == 0 && has2) ? sk[1] : 0.f;
#pragma unroll
                for (int i = 0; i < 16; ++i) { const int n = 2 * tid + 2 * NTHR * i;
                    f32x4 fv = (f32x4){bf_lo(pa[i]), has2 ? bf_lo(pb[i]) : 0.f, bf_hi(pa[i]), has2 ? bf_hi(pb[i]) : 0.f};
                    if (i == 0) { fv[0] += sk1; fv[1] += sk2; }
                    *(LAS f32x4*)&z[PADI(n)] = fv; }
                BG_F(0);
            }
            __syncthreads();
            FFT_FWD_ALL();
            tid = tid_fresh();
            BG_I(0);
#pragma unroll 4
            for (int k = tid; k <= FN / 2; k += NTHR) {
                const cf2 zk = z[PADI(fpos(k))], zm = z[PADI(fpos((FN - k) & (FN - 1)))];
                u32x2 g; g.x = cvt_pk_bf16(0.5f * (zk.x + zm.x), 0.5f * (zk.y - zm.y)); g.y = cvt_pk_bf16(0.5f * (zk.y + zm.y), -0.5f * (zk.x - zm.x)); GS[k] = g;
            }
            BG_F(1);
            __syncthreads();
            }
            tid = tid_fresh();
            {   unsigned pa[8], pb[8];
#pragma unroll
                for (int i = 0; i < 8; ++i) { const unsigned off = 4u * tid + 2048u * i; SEG_LD32(pa[i], off, v1); SEG_LD32(pb[i], off, v2); }
                BG_I(1);
                SEG_WAIT(); asm volatile("" : SEG_TIE8(pa, 0), SEG_TIE8(pb, 0) :: "memory");
#pragma unroll
                for (int i = 0; i < 8; ++i) { const int n = 2 * tid + 2 * NTHR * i;
                    *(LAS f32x4*)&z[PADI(n)] = (f32x4){bf_lo(pa[i]), has2 ? bf_lo(pb[i]) : 0.f, bf_hi(pa[i]), has2 ? bf_hi(pb[i]) : 0.f};
                    *(LAS f32x4*)&z[PADI(T + n)] = (f32x4){0.f, 0.f, 0.f, 0.f}; }
                BG_F(0);
            }
            __syncthreads();
            FFT_FWD_ALL();
            tid = tid_fresh();
            {   u32x2 gq[16], gh;
#pragma unroll
                for (int i = 0; i < 16; ++i) { const unsigned off = 8u * tid + 4096u * i; SEG_LD64(gq[i], off, GS); }
                { const unsigned off = 8u * (FN / 2); SEG_LD64(gh, off, GS); }
                BG_I(0);
                SEG_WAIT(); asm volatile("" : SEG_TIE8(gq, 0), SEG_TIE8(gq, 8), "+v"(gh) :: "memory");
#pragma unroll
                for (int i = 0; i < 16; ++i) { const int k = tid + NTHR * i;
                    const int p1 = PADI(fpos(k)), p2 = PADI(fpos((FN - k) & (FN - 1)));
                    const cf2 zk = z[p1], zm = z[p2];
                    const cf2 V1 = mk2(0.5f * (zk.x + zm.x), 0.5f * (zk.y - zm.y)), V2 = mk2(0.5f * (zk.y + zm.y), -0.5f * (zk.x - zm.x));
                    const cf2 Y1 = cmul(V1, mk2(bf_lo(gq[i].x), bf_hi(gq[i].x))), Y2 = cmul(V2, mk2(bf_lo(gq[i].y), bf_hi(gq[i].y)));
                    z[p1] = mk2(Y1.x - Y2.y, Y1.y + Y2.x); z[p2] = mk2(Y1.x + Y2.y, Y2.x - Y1.y); }
                if (tid == 0) { const int k = FN / 2, p1 = PADI(fpos(k)); const cf2 zk = z[p1]; const float4 g1 = make_float4(bf_lo(gh.x), bf_hi(gh.x), bf_lo(gh.y), bf_hi(gh.y));
                    z[p1] = mk2(zk.x * g1.x, zk.y * g1.z); }
                BG_F(1);
            }
            __syncthreads();
            tid = tid_fresh();
            BG_I(1); fft_r4_pass<true>(z, tid, NTHR); __syncthreads(); BG_F(0);
            BG_I(0); fft_r16_pass<true, 2>(z, tid); __syncthreads(); BG_F(1); BG_I(1); fft_r16_pass<true, 6>(z, tid); __syncthreads(); BG_F(0); BG_I(0); fft_r16_pass<true, 10>(z, tid); __syncthreads(); BG_F(1);
            tid = tid_fresh();
            bf16_t* o1 = zT + (size_t)c1 * T; bf16_t* o2 = zT + (size_t)c2 * T;

            {
#pragma unroll
                for (int i = 0; i < 8; ++i) { const int n = 2 * tid + 2 * NTHR * i; const f32x4 y = *(const LAS f32x4*)&z[PADI(n)];
                    *(unsigned*)(o1 + n) = cvt_pk_bf16(y[0] * (1.f / (float)FN), y[2] * (1.f / (float)FN));
                    if (has2) *(unsigned*)(o2 + n) = cvt_pk_bf16(y[1] * (1.f / (float)FN), y[3] * (1.f / (float)FN)); }
            }

        }
        bg_finish1<0, 0>(bg);
#undef FFT_FWD_ALL
    }
    { const int nst = (BG_STEPS + bgNW - 1) / bgNW;
#pragma unroll 1
      while (bg.st < nst) { BG_BEGIN(2); BG_END(2); } }
#undef BG_BEGIN
#undef BG_END
#undef BG_I
#undef BG_F
    __syncthreads();
}

__device__ __forceinline__ void hy_tr_phase(LAS unsigned char* lds, int bid, int G, const bf16_t* zT, const bf16_t* x0c, bf16_t* yA) {
    LAS float* sm = (LAS float*)lds;
    const int tid = tid_fresh();
    const int c = tid >> 3, tc = tid & 7, t = tid >> 3, ch = tid & 7;
#define HT_LOAD(tile_) do { const int t0_ = ((tile_) >> 5) * 64, c0_ = ((tile_) & 31) * 64; pz = *(const u32x4*)(zT + (size_t)(c0_ + c) * T + t0_ + tc * 8); px = *(const u32x4*)(x0c + (size_t)(t0_ + t) * D + c0_ + ch * 8); } while (0)
    u32x4 pz = (u32x4){0u, 0u, 0u, 0u}, px = (u32x4){0u, 0u, 0u, 0u};
    if (bid < 4096) HT_LOAD(bid);
    for (int tile = bid; tile < 4096; tile += G) {
        const int t0 = (tile >> 5) * 64, c0 = (tile & 31) * 64;
        __syncthreads();
        {   LAS float* dp = sm + c * 65 + tc * 8; dp[0] = bf_lo(pz.x); dp[1] = bf_hi(pz.x); dp[2] = bf_lo(pz.y); dp[3] = bf_hi(pz.y); dp[4] = bf_lo(pz.z); dp[5] = bf_hi(pz.z); dp[6] = bf_lo(pz.w); dp[7] = bf_hi(pz.w); }
        const u32x4 xv = px;
        if (tile + G < 4096) HT_LOAD(tile + G);
        __syncthreads();
        {   const size_t off = (size_t)(t0 + t) * D + c0 + ch * 8;
            const LAS float* sp = sm + (ch * 8) * 65 + t;
            u32x4 w; w.x = cvt_pk_bf16(sp[0] * bf_lo(xv.x), sp[65] * bf_hi(xv.x)); w.y = cvt_pk_bf16(sp[130] * bf_lo(xv.y), sp[195] * bf_hi(xv.y));
            w.z = cvt_pk_bf16(sp[260] * bf_lo(xv.z), sp[325] * bf_hi(xv.z)); w.w = cvt_pk_bf16(sp[390] * bf_lo(xv.w), sp[455] * bf_hi(xv.w));
            *(u32x4*)(yA + off) = w; }
    }
#undef HT_LOAD
    __syncthreads();
}

constexpr size_t BIG_GATES = (size_t)283115520;
constexpr size_t BIG_SLOC  = BIG_VGT;
constexpr size_t BIG_ZLOC  = BIG_SLOC + (size_t)2 * 8 * 32 * 256 * 128 * 4;
constexpr size_t BIG_GTOT  = BIG_ZLOC + (size_t)2 * 8 * 32 * 128 * 4;
constexpr int MLC = 256, MLNC = T / MLC;
typedef float f32x4v __attribute__((ext_vector_type(4)));

__device__ __forceinline__ float logsigf(float x) { return fminf(x, 0.f) - log1pf(expf(-fabsf(x))); }

__device__ __forceinline__ void ml_norm_gates_phase(LAS unsigned char* lds, int bid, int G, const float* x, const float* g, const float* sc, const float* sh,
                                                    const float* w_in, const float* gate_b, bf16_t* hbuf, float* gates) {
    LAS float* hfs = (LAS float*)lds;
    LAS float* part = (LAS float*)lds;
    const int tid = tid_fresh();
    const int lane = tid & 63, wave = tid >> 6;
    for (int r0 = bid * 16; r0 < T; r0 += G * 16) {
        __syncthreads();
#pragma unroll 1
        for (int rr = 0; rr < 2; ++rr) {
            const int row = r0 + wave * 2 + rr;
            float4 v[8];
#pragma unroll
            for (int i = 0; i < 8; ++i) v[i] = *(const float4*)(x + (size_t)row * D + (lane + 64 * i) * 4);
            row_norm_mod(v, lane, g, sc, sh);
#pragma unroll
            for (int i = 0; i < 8; ++i) { const int c = (lane + 64 * i) * 4;
                u32x2 w; w.x = cvt_pk_bf16(v[i].x, v[i].y); w.y = cvt_pk_bf16(v[i].z, v[i].w); *(u32x2*)(hbuf + (size_t)row * D + c) = w;
                LAS float* hp = hfs + (wave * 2 + rr) * HFS_LD + c; hp[0] = v[i].x; hp[1] = v[i].y; hp[2] = v[i].z; hp[3] = v[i].w; }
        }
        __syncthreads();
        f32x4 acc[2];
        rows16_matmul<2>(hfs, w_in, 6176, 6144, wave, lane, acc);
        __syncthreads();
#pragma unroll
        for (int jt = 0; jt < 2; ++jt)
#pragma unroll
            for (int r = 0; r < 4; ++r) part[(wave * 16 + (lane >> 4) * 4 + r) * 32 + jt * 16 + (lane & 15)] = acc[jt][r];
        __syncthreads();
        {   const int rl = wave * 2 + (lane >> 5), col = lane & 31;
            float sacc = gate_b[col];
#pragma unroll
            for (int w = 0; w < 8; ++w) sacc += part[(w * 16 + rl) * 32 + col];
            gates[(size_t)(r0 + rl) * 32 + col] = sacc; }
    }
    __syncthreads();
}

__device__ __forceinline__ void ml_conv8(const bf16_t* P, int t, int col, const float* cw, const float* cb, int cch, float scale, float (&o)[8]) {
    const u32x4 z4 = (u32x4){0u, 0u, 0u, 0u};
    const u32x4 v0 = *(const u32x4*)(P + (size_t)t * 6144 + col);
    const u32x4 vm = (t > 0) ? *(const u32x4*)(P + (size_t)(t - 1) * 6144 + col) : z4;
    const u32x4 vp = (t < T - 1) ? *(const u32x4*)(P + (size_t)(t + 1) * 6144 + col) : z4;
    const float m[8] = {bf_lo(vm.x), bf_hi(vm.x), bf_lo(vm.y), bf_hi(vm.y), bf_lo(vm.z), bf_hi(vm.z), bf_lo(vm.w), bf_hi(vm.w)};
    const float c[8] = {bf_lo(v0.x), bf_hi(v0.x), bf_lo(v0.y), bf_hi(v0.y), bf_lo(v0.z), bf_hi(v0.z), bf_lo(v0.w), bf_hi(v0.w)};
    const float p[8] = {bf_lo(vp.x), bf_hi(vp.x), bf_lo(vp.y), bf_hi(vp.y), bf_lo(vp.z), bf_hi(vp.z), bf_lo(vp.w), bf_hi(vp.w)};
#pragma unroll
    for (int q = 0; q < 8; ++q) { const float xv = cw[cch + q] * m[q] + cw[2048 + cch + q] * c[q] + cw[4096 + cch + q] * p[q] + cb[cch + q]; o[q] = xv / (1.f + __expf(-xv)) * scale; }
}

struct Row3 { u32x4 vm, v0, vp; float fm, fp; };
__device__ __forceinline__ Row3 ml_load3(const bf16_t* P, int t, int col) {
    Row3 r;
    const int tm = t > 0 ? t - 1 : 0, tp = t < T - 1 ? t + 1 : T - 1;
    r.v0 = *(const u32x4*)(P + (size_t)t * 6144 + col);
    r.vm = *(const u32x4*)(P + (size_t)tm * 6144 + col);
    r.vp = *(const u32x4*)(P + (size_t)tp * 6144 + col);
    r.fm = t > 0 ? 1.f : 0.f; r.fp = t < T - 1 ? 1.f : 0.f;
    return r;
}
struct Cw8 { float4 a[8]; };
__device__ __forceinline__ Cw8 ml_cw_load(const float* cw, const float* cb, int cch) {
    Cw8 w;
#pragma unroll
    for (int k = 0; k < 3; ++k) { w.a[2 * k] = *(const float4*)(cw + k * 2048 + cch); w.a[2 * k + 1] = *(const float4*)(cw + k * 2048 + cch + 4); }
    w.a[6] = *(const float4*)(cb + cch); w.a[7] = *(const float4*)(cb + cch + 4);
    return w;
}
__device__ __forceinline__ void ml_conv8c(const Row3& r, const Cw8& w, float scale, float (&o)[8]) {
    const float m[8] = {bf_lo(r.vm.x), bf_hi(r.vm.x), bf_lo(r.vm.y), bf_hi(r.vm.y), bf_lo(r.vm.z), bf_hi(r.vm.z), bf_lo(r.vm.w), bf_hi(r.vm.w)};
    const float c[8] = {bf_lo(r.v0.x), bf_hi(r.v0.x), bf_lo(r.v0.y), bf_hi(r.v0.y), bf_lo(r.v0.z), bf_hi(r.v0.z), bf_lo(r.v0.w), bf_hi(r.v0.w)};
    const float p[8] = {bf_lo(r.vp.x), bf_hi(r.vp.x), bf_lo(r.vp.y), bf_hi(r.vp.y), bf_lo(r.vp.z), bf_hi(r.vp.z), bf_lo(r.vp.w), bf_hi(r.vp.w)};
    const float w0[8] = {w.a[0].x, w.a[0].y, w.a[0].z, w.a[0].w, w.a[1].x, w.a[1].y, w.a[1].z, w.a[1].w};
    const float w1[8] = {w.a[2].x, w.a[2].y, w.a[2].z, w.a[2].w, w.a[3].x, w.a[3].y, w.a[3].z, w.a[3].w};
    const float w2[8] = {w.a[4].x, w.a[4].y, w.a[4].z, w.a[4].w, w.a[5].x, w.a[5].y, w.a[5].z, w.a[5].w};
    const float wb[8] = {w.a[6].x, w.a[6].y, w.a[6].z, w.a[6].w, w.a[7].x, w.a[7].y, w.a[7].z, w.a[7].w};
#pragma unroll
    for (int q = 0; q < 8; ++q) { const float xv = (w0[q] * r.fm) * m[q] + w1[q] * c[q] + (w2[q] * r.fp) * p[q] + wb[q]; o[q] = xv / (1.f + __expf(-xv)) * scale; }
}

__device__ __forceinline__ void ml_chunk_gates(int tid, const float* gates, int h, int t0, LAS float* bf, LAS float* cbs, LAS float* gif, LAS float* gib, LAS float* tmpf, LAS float* tmpb) {
    const int lane = tid & 63, wave = tid >> 6;
    float p = 0.f, q = 0.f;
    if (tid < MLC) { const float* gp = gates + (size_t)(t0 + tid) * 32; gif[tid] = gp[h]; gib[tid] = gp[16 + h]; p = logsigf(gp[8 + h]); q = logsigf(gp[24 + h]);
#pragma unroll
        for (int o = 1; o < 64; o <<= 1) { const float v = __shfl_up(p, o); const float w = __shfl_down(q, o); if (lane >= o) p += v; if (lane + o < 64) q += w; }
        if (lane == 63) tmpf[wave] = p;
        if (lane == 0) tmpb[wave] = q; }
    __syncthreads();
    if (tid < MLC) { float ap = 0.f, aq = 0.f;
#pragma unroll
        for (int w = 0; w < 4; ++w) { if (w < wave) ap += tmpf[w]; if (w > wave) aq += tmpb[w]; }
        bf[tid] = p + ap; cbs[tid] = q + aq; }
    __syncthreads();
}

__device__ __forceinline__ void ml_state_phase(LAS unsigned char* lds, int bid, int G, const bf16_t* P, const float* gates, const float* cw, const float* cb, bf16_t* Sloc, float* zloc, float* Gtot) {
    LAS bf16_t* kw = (LAS bf16_t*)lds;
    LAS bf16_t* vT = (LAS bf16_t*)(lds + 36864);
    LAS float* bf = (LAS float*)(lds + 73728); LAS float* cbs = bf + 256; LAS float* gif = bf + 512; LAS float* gib = bf + 768; LAS float* wf = bf + 1024; LAS float* wb = bf + 1280;
    for (int u = bid; u < 8 * MLNC; u += G) {
        const int h = u / MLNC, n = u - h * MLNC, t0 = n * MLC;
        int tid = tid_fresh();
        __syncthreads();
        ml_chunk_gates(tid, gates, h, t0, bf, cbs, gif, gib, wf, wb);
        float Gf = bf[MLC - 1], Gb = cbs[0];
        __syncthreads();
        if (tid < MLC) { wf[tid] = expf(Gf - bf[tid] + gif[tid]); wb[tid] = expf(Gb - cbs[tid] + gib[tid]); }
        if (tid == 0) { Gtot[(0 * 8 + h) * MLNC + n] = Gf; Gtot[(1 * 8 + h) * MLNC + n] = Gb; }
        f32x4v acc[8][4];
#pragma unroll
        for (int m = 0; m < 8; ++m)
#pragma unroll
            for (int q = 0; q < 4; ++q) acc[m][q] = (f32x4v){0.f, 0.f, 0.f, 0.f};
        float zacc = 0.f;
#pragma unroll 1
        for (int sb = 0; sb < 4; ++sb) {
            __syncthreads();
            tid = tid_fresh();
            {
                Row3 rk[2]; u32x4 vv[4]; Cw8 cwk[2];
#pragma unroll
                for (int it = 0; it < 2; ++it) { const int item = tid + NTHR * it, sl = (item >> 2) & 63, dc = (item & 3) + 4 * (item >> 8);
                    cwk[it] = ml_cw_load(cw, cb, 1024 + h * 128 + dc * 8); rk[it] = ml_load3(P, t0 + sb * 64 + sl, 1024 + h * 128 + dc * 8); }
#pragma unroll
                for (int it = 0; it < 4; ++it) { const int item = tid + NTHR * it, sl = (item >> 2) & 63, ec = (item & 3) + 4 * (item >> 8);
                    vv[it] = *(const u32x4*)(P + (size_t)(t0 + sb * 64 + sl) * 6144 + 2048 + h * 256 + ec * 8); }
#pragma unroll
                for (int it = 0; it < 2; ++it) { const int item = tid + NTHR * it, sl = (item >> 2) & 63, dc = (item & 3) + 4 * (item >> 8), sc_ = sb * 64 + sl;
                    float o[8]; ml_conv8c(rk[it], cwk[it], 0.08838834764831845f, o);
                    const float w0 = wf[sc_], w1 = wb[sc_];
#pragma unroll
                    for (int q = 0; q < 8; ++q) { kw[(dc * 8 + q) * 72 + sl] = (bf16_t)(cvt_pk_bf16(o[q] * w0, 0.f) & 0xffffu); kw[(128 + dc * 8 + q) * 72 + sl] = (bf16_t)(cvt_pk_bf16(o[q] * w1, 0.f) & 0xffffu); } }
#pragma unroll
                for (int it = 0; it < 4; ++it) { const int item = tid + NTHR * it, sl = (item >> 2) & 63, ec = (item & 3) + 4 * (item >> 8); const u32x4 v4 = vv[it];
                    LAS bf16_t* vp = vT + (ec * 8) * 72 + sl;
                    vp[0] = (bf16_t)(v4.x & 0xffffu); vp[72] = (bf16_t)(v4.x >> 16); vp[144] = (bf16_t)(v4.y & 0xffffu); vp[216] = (bf16_t)(v4.y >> 16);
                    vp[288] = (bf16_t)(v4.z & 0xffffu); vp[360] = (bf16_t)(v4.z >> 16); vp[432] = (bf16_t)(v4.w & 0xffffu); vp[504] = (bf16_t)(v4.w >> 16); }
            }
            __syncthreads();
            tid = tid_fresh();
            const int lane = tid & 63, wave = __builtin_amdgcn_readfirstlane(tid >> 6), wr = wave >> 2, wc = wave & 3, fr = lane & 15, fq = lane >> 4;
            if (tid < 256) { const LAS bf16_t* kp = kw + tid * 72; float s = 0.f;
#pragma unroll 8
                for (int q = 0; q < 64; ++q) s += __uint_as_float((unsigned)kp[q] << 16);
                zacc += s; }
            __builtin_amdgcn_sched_barrier(0);
#pragma unroll
            for (int ks = 0; ks < 2; ++ks) {
                bf16x8 bfr[4];
#pragma unroll
                for (int q = 0; q < 4; ++q) bfr[q] = *(const LAS bf16x8*)(kw + (wc * 64 + q * 16 + fr) * 72 + ks * 32 + fq * 8);
#pragma unroll
                for (int m = 0; m < 8; ++m) { const bf16x8 afr = *(const LAS bf16x8*)(vT + (wr * 128 + m * 16 + fr) * 72 + ks * 32 + fq * 8);
#pragma unroll
                    for (int q = 0; q < 4; ++q) acc[m][q] = __builtin_amdgcn_mfma_f32_16x16x32_bf16(bfr[q], afr, acc[m][q], 0, 0, 0);
                    if (m & 1) __builtin_amdgcn_sched_barrier(0); }
            }
        }
        tid = tid_fresh();
        const int lane = tid & 63, wave = __builtin_amdgcn_readfirstlane(tid >> 6), wr = wave >> 2, wc = wave & 3, fr = lane & 15, fq = lane >> 4;
#pragma unroll
        for (int m = 0; m < 8; ++m)
#pragma unroll
            for (int q = 0; q < 4; ++q) { const int c = wc * 64 + q * 16 + fq * 4, dir = c >> 7, d = c & 127, e = wr * 128 + m * 16 + fr;
                u32x2 w; w.x = cvt_pk_bf16(acc[m][q][0], acc[m][q][1]); w.y = cvt_pk_bf16(acc[m][q][2], acc[m][q][3]);
                *(u32x2*)(Sloc + ((((size_t)dir * 8 + h) * MLNC + n) * 256 + e) * 128 + d) = w;
                __builtin_amdgcn_sched_barrier(0); }
        if (tid < 256) zloc[(((size_t)(tid >> 7) * 8 + h) * MLNC + n) * 128 + (tid & 127)] = zacc;
    }
    __syncthreads();
}

__device__ __forceinline__ void ml_scan_phase(int bid, int G, bf16_t* Sloc, float* zloc, const float* Gtot) {
    const int tid = tid_fresh();
    for (int item = bid * NTHR + tid; item < 16 * 8192; item += G * NTHR) {
        const int dh = __builtin_amdgcn_readfirstlane(item >> 13), r = item & 8191, dir = dh >> 3;
        const float* gp = Gtot + dh * MLNC;
        bf16_t* base = Sloc + (size_t)dh * MLNC * 32768 + (size_t)r * 4;
        u32x2 loc[MLNC];
#pragma unroll
        for (int step = 0; step < MLNC; ++step) { const int n = dir ? (MLNC - 1 - step) : step; loc[step] = *(const u32x2*)(base + (size_t)n * 32768); }
        float dcy[MLNC];
#pragma unroll
        for (int step = 0; step < MLNC; ++step) { const int n = dir ? (MLNC - 1 - step) : step; dcy[step] = gp[n]; }
        float s0 = 0.f, s1 = 0.f, s2 = 0.f, s3 = 0.f;
#pragma unroll
        for (int step = 0; step < MLNC; ++step) { const int n = dir ? (MLNC - 1 - step) : step;
            u32x2 w; w.x = cvt_pk_bf16(s0, s1); w.y = cvt_pk_bf16(s2, s3); *(u32x2*)(base + (size_t)n * 32768) = w;
            const float dec = expf(dcy[step]);
            s0 = dec * s0 + bf_lo(loc[step].x); s1 = dec * s1 + bf_hi(loc[step].x); s2 = dec * s2 + bf_lo(loc[step].y); s3 = dec * s3 + bf_hi(loc[step].y); }
    }
    for (int item = bid * NTHR + tid; item < 16 * 128; item += G * NTHR) {
        const int dh = __builtin_amdgcn_readfirstlane(item >> 7), r = item & 127, dir = dh >> 3;
        const float* gp = Gtot + dh * MLNC;
        float* base = zloc + (size_t)dh * MLNC * 128 + r;
        float loc[MLNC];
#pragma unroll
        for (int step = 0; step < MLNC; ++step) { const int n = dir ? (MLNC - 1 - step) : step; loc[step] = base[(size_t)n * 128]; }
        float dcy[MLNC];
#pragma unroll
        for (int step = 0; step < MLNC; ++step) { const int n = dir ? (MLNC - 1 - step) : step; dcy[step] = gp[n]; }
        float st = 0.f;
#pragma unroll
        for (int step = 0; step < MLNC; ++step) { const int n = dir ? (MLNC - 1 - step) : step; base[(size_t)n * 128] = st; st = expf(dcy[step]) * st + loc[step]; }
    }
}

__device__ __forceinline__ void ml_out_phase(LAS unsigned char* lds, int bid, int G, const bf16_t* P, const float* gates, const float* cw, const float* cb,
                                             const bf16_t* Sst, const float* zst, const float* head_g, bf16_t* hs) {
    LAS bf16_t* Q  = (LAS bf16_t*)lds;
    LAS bf16_t* ST = (LAS bf16_t*)(lds + 34816);
    LAS bf16_t* Kb = (LAS bf16_t*)(lds + 34816);
    LAS bf16_t* VT = (LAS bf16_t*)(lds + 34816 + 17408);
    LAS bf16_t* PW = (LAS bf16_t*)(lds + 104448);
    LAS float* bf = (LAS float*)(lds + 122880); LAS float* cbs = bf + 256; LAS float* gif = bf + 512; LAS float* gib = bf + 768;
    LAS float* zs = bf + 1024;
    LAS float* tmp = bf + 1280;
#define ML_IDS() tid = tid_fresh(); const int lane = tid & 63, wave = __builtin_amdgcn_readfirstlane(tid >> 6), fr = lane & 15, fq = lane >> 4; const int trel = half * 128 + wave * 16 + fr; LAS bf16_t* pw = PW + wave * 16 * 72; (void)pw; (void)fq; (void)trel
    for (int u = bid; u < 8 * MLNC * 2; u += G) {
        const int half = u & 1, hn = u >> 1, h = hn / MLNC, n = hn - h * MLNC, t0 = n * MLC;
        int tid = tid_fresh();
        __syncthreads();
        ml_chunk_gates(tid, gates, h, t0, bf, cbs, gif, gib, tmp, tmp + 256);
        {   const int dc = tid & 15, tlb = tid >> 4;
            const Cw8 cwq = ml_cw_load(cw, cb, h * 128 + dc * 8);
            Row3 rq[4];
#pragma unroll
            for (int it = 0; it < 4; ++it) rq[it] = ml_load3(P, t0 + half * 128 + tlb + 32 * it, h * 128 + dc * 8);
#pragma unroll
            for (int it = 0; it < 4; ++it) { float o[8]; ml_conv8c(rq[it], cwq, 1.f, o);
                u32x4 w; w.x = cvt_pk_bf16(o[0], o[1]); w.y = cvt_pk_bf16(o[2], o[3]); w.z = cvt_pk_bf16(o[4], o[5]); w.w = cvt_pk_bf16(o[6], o[7]);
                *(LAS u32x4*)(Q + (tlb + 32 * it) * 136 + dc * 8) = w; }
        }
        f32x4v accf[16], accb[16];
#pragma unroll
        for (int q = 0; q < 16; ++q) { accf[q] = (f32x4v){0.f, 0.f, 0.f, 0.f}; accb[q] = (f32x4v){0.f, 0.f, 0.f, 0.f}; }
        Row3 rk[2]; u32x4 vv[4];
#define ML_LOADKV(sbx) do { const int t_ = tid_fresh(); const int dc_ = t_ & 15, slb_ = t_ >> 4; \
            _Pragma("unroll") for (int it = 0; it < 2; ++it) rk[it] = ml_load3(P, t0 + (sbx) * 64 + slb_ + 32 * it, 1024 + h * 128 + dc_ * 8); \
            _Pragma("unroll") for (int it = 0; it < 4; ++it) { const int item = t_ + NTHR * it, sl = (item >> 2) & 63, ec = (item & 3) + 4 * (item >> 8); \
                vv[it] = *(const u32x4*)(P + (size_t)(t0 + (sbx) * 64 + sl) * 6144 + 2048 + h * 256 + ec * 8); } } while (0)
        u32x4 sv[8];
#define ML_LOADS(dirx) do { const int t_ = tid_fresh(); const bf16_t* Sp = Sst + (((size_t)(dirx) * 8 + h) * MLNC + n) * 32768; \
            _Pragma("unroll") for (int it = 0; it < 8; ++it) { const int item = t_ + NTHR * it, e = item >> 4, dc_ = item & 15; sv[it] = *(const u32x4*)(Sp + (size_t)e * 128 + dc_ * 8); } } while (0)
        ML_LOADS(0);
#pragma unroll
        for (int dir = 0; dir < 2; ++dir) {
            __syncthreads();
            tid = tid_fresh();
#pragma unroll
            for (int it = 0; it < 8; ++it) { const int item = tid + NTHR * it, e = item >> 4, dc = item & 15; *(LAS u32x4*)(ST + e * 136 + dc * 8) = sv[it]; }
            if (tid < 128) zs[dir * 128 + tid] = zst[(((size_t)dir * 8 + h) * MLNC + n) * 128 + tid];
            __syncthreads();
            if (dir == 0) ML_LOADS(1); else ML_LOADKV(0);
            ML_IDS();
#pragma unroll 1
            for (int ks = 0; ks < 4; ++ks) {
                const bf16x8 qf = *(const LAS bf16x8*)(Q + (wave * 16 + fr) * 136 + ks * 32 + fq * 8);
#pragma unroll
                for (int q = 0; q < 16; ++q) { const bf16x8 sf = *(const LAS bf16x8*)(ST + (q * 16 + fr) * 136 + ks * 32 + fq * 8);
                    if (dir == 0) accf[q] = __builtin_amdgcn_mfma_f32_16x16x32_bf16(sf, qf, accf[q], 0, 0, 0);
                    else accb[q] = __builtin_amdgcn_mfma_f32_16x16x32_bf16(sf, qf, accb[q], 0, 0, 0);
                    if ((q & 3) == 3) __builtin_amdgcn_sched_barrier(0); }
            }
        }
        float denf, denb;
        {   ML_IDS();
            const float ebf = expf(bf[trel]), ebb = expf(cbs[trel]);
#pragma unroll
            for (int q = 0; q < 16; ++q) { accf[q] *= ebf; accb[q] *= ebb; }
            float pf = 0.f, pb = 0.f; const LAS bf16_t* qp = Q + (wave * 16 + fr) * 136 + fq * 32;
#pragma unroll 8
            for (int d = 0; d < 32; ++d) { const float qv = __uint_as_float((unsigned)qp[d] << 16); pf += qv * zs[fq * 32 + d]; pb += qv * zs[128 + fq * 32 + d]; }
            pf += __shfl_xor(pf, 16); pf += __shfl_xor(pf, 32); pb += __shfl_xor(pb, 16); pb += __shfl_xor(pb, 32);
            denf = ebf * pf; denb = ebb * pb; }
        float sumf = 0.f, sumb = 0.f;
#pragma unroll 1
        for (int sb = 0; sb < 4; ++sb) {
            const bool need_f = (sb * 64 <= half * 128 + 127), need_b = (sb * 64 + 63 >= half * 128);
            __syncthreads();
            tid = tid_fresh();
            {   const int dc = tid & 15, slb = tid >> 4;
                const Cw8 cwk = ml_cw_load(cw, cb, 1024 + h * 128 + dc * 8);
#pragma unroll
                for (int it = 0; it < 2; ++it) { float o[8]; ml_conv8c(rk[it], cwk, 0.08838834764831845f, o);
                    u32x4 w; w.x = cvt_pk_bf16(o[0], o[1]); w.y = cvt_pk_bf16(o[2], o[3]); w.z = cvt_pk_bf16(o[4], o[5]); w.w = cvt_pk_bf16(o[6], o[7]);
                    *(LAS u32x4*)(Kb + (slb + 32 * it) * 136 + dc * 8) = w; }
#pragma unroll
                for (int it = 0; it < 4; ++it) { const int item = tid + NTHR * it, sl = (item >> 2) & 63, ec = (item & 3) + 4 * (item >> 8); const u32x4 v4 = vv[it];
                    LAS bf16_t* vp = VT + (ec * 8) * 72 + sl;
                    vp[0] = (bf16_t)(v4.x & 0xffffu); vp[72] = (bf16_t)(v4.x >> 16); vp[144] = (bf16_t)(v4.y & 0xffffu); vp[216] = (bf16_t)(v4.y >> 16);
                    vp[288] = (bf16_t)(v4.z & 0xffffu); vp[360] = (bf16_t)(v4.z >> 16); vp[432] = (bf16_t)(v4.w & 0xffffu); vp[504] = (bf16_t)(v4.w >> 16); }
            }
            __syncthreads();
            if (sb < 3) ML_LOADKV(sb + 1);
            ML_IDS();
            f32x4v sc[4];
#pragma unroll
            for (int st = 0; st < 4; ++st) sc[st] = (f32x4v){0.f, 0.f, 0.f, 0.f};
#pragma unroll
            for (int ks = 0; ks < 4; ++ks) {
                const bf16x8 qf = *(const LAS bf16x8*)(Q + (wave * 16 + fr) * 136 + ks * 32 + fq * 8);
#pragma unroll
                for (int st = 0; st < 4; ++st) { const bf16x8 kf = *(const LAS bf16x8*)(Kb + (st * 16 + fr) * 136 + ks * 32 + fq * 8);
                    sc[st] = __builtin_amdgcn_mfma_f32_16x16x32_bf16(kf, qf, sc[st], 0, 0, 0); }
            }
#pragma unroll
            for (int dir = 0; dir < 2; ++dir) {
                if (dir == 0 ? !need_f : !need_b) continue;
                const float bt = dir == 0 ? bf[trel] : cbs[trel];
#pragma unroll
                for (int st = 0; st < 4; ++st) { float pv[4];
#pragma unroll
                    for (int r = 0; r < 4; ++r) { const int srel = sb * 64 + st * 16 + fq * 4 + r;
                        const float bs = dir == 0 ? bf[srel] : cbs[srel], gi = dir == 0 ? gif[srel] : gib[srel];
                        const bool ok = dir == 0 ? (srel <= trel) : (srel >= trel);
                        pv[r] = ok ? __expf(bt - bs + gi) * sc[st][r] : 0.f;
                        if (dir == 0) sumf += pv[r]; else sumb += pv[r]; }
                    u32x2 w; w.x = cvt_pk_bf16(pv[0], pv[1]); w.y = cvt_pk_bf16(pv[2], pv[3]);
                    *(LAS u32x2*)(pw + fr * 72 + st * 16 + fq * 4) = w; }
#pragma unroll 1
                for (int ks = 0; ks < 2; ++ks) {
                    const bf16x8 pf = *(const LAS bf16x8*)(pw + fr * 72 + ks * 32 + fq * 8);
#pragma unroll
                    for (int q = 0; q < 16; ++q) { const bf16x8 vf = *(const LAS bf16x8*)(VT + (q * 16 + fr) * 72 + ks * 32 + fq * 8);
                        if (dir == 0) accf[q] = __builtin_amdgcn_mfma_f32_16x16x32_bf16(vf, pf, accf[q], 0, 0, 0);
                        else accb[q] = __builtin_amdgcn_mfma_f32_16x16x32_bf16(vf, pf, accb[q], 0, 0, 0);
                        if ((q & 3) == 3) __builtin_amdgcn_sched_barrier(0); }
                }
            }
        }
        ML_IDS();
        sumf += __shfl_xor(sumf, 16); sumf += __shfl_xor(sumf, 32); sumb += __shfl_xor(sumb, 16); sumb += __shfl_xor(sumb, 32);
        const float invf = 1.f / fmaxf(fabsf(denf + sumf), 1.f), invb = 1.f / fmaxf(fabsf(denb + sumb), 1.f);
        float ss = 0.f;
#pragma unroll
        for (int q = 0; q < 16; ++q) { accf[q] = accf[q] * invf + accb[q] * invb; ss += accf[q][0] * accf[q][0] + accf[q][1] * accf[q][1] + accf[q][2] * accf[q][2] + accf[q][3] * accf[q][3]; }
        ss += __shfl_xor(ss, 16); ss += __shfl_xor(ss, 32);
        const float rn = rsqrtf(ss * (1.f / 256.f) + EPS);
        const size_t tabs = (size_t)t0 + trel;
#pragma unroll
        for (int qb = 0; qb < 16; qb += 8) {
            u32x2 ovv[8]; float4 hgv[8];
#pragma unroll
            for (int qq = 0; qq < 8; ++qq) { const int e = (qb + qq) * 16 + fq * 4; ovv[qq] = *(const u32x2*)(P + tabs * 6144 + 4096 + h * 256 + e); hgv[qq] = *(const float4*)(head_g + h * 256 + e); }
#pragma unroll
            for (int qq = 0; qq < 8; ++qq) { const int q = qb + qq, e = q * 16 + fq * 4; const u32x2 ov = ovv[qq]; const float4 hg = hgv[qq];
                const float o0 = bf_lo(ov.x), o1 = bf_hi(ov.x), o2 = bf_lo(ov.y), o3 = bf_hi(ov.y);
                const float r0 = accf[q][0] * rn * hg.x / (1.f + __expf(-o0)), r1 = accf[q][1] * rn * hg.y / (1.f + __expf(-o1)), r2 = accf[q][2] * rn * hg.z / (1.f + __expf(-o2)), r3 = accf[q][3] * rn * hg.w / (1.f + __expf(-o3));
                u32x2 w; w.x = cvt_pk_bf16(r0, r1); w.y = cvt_pk_bf16(r2, r3);
                *(u32x2*)(hs + tabs * D + h * 256 + e) = w; }
            __builtin_amdgcn_sched_barrier(0); }
    }
    __syncthreads();
#undef ML_IDS
}

__device__ __forceinline__ void norm_phase(int bid, int G, const float* x, const float* g, const float* sc, const float* sh, bf16_t* hbuf) {
    const int tid = tid_fresh(), lane = tid & 63, wave = tid >> 6;
    for (int row = bid * 8 + wave; row < T; row += G * 8) {
        float4 v[8];
#pragma unroll
        for (int i = 0; i < 8; ++i) v[i] = *(const float4*)(x + (size_t)row * D + (lane + 64 * i) * 4);
        row_norm_mod(v, lane, g, sc, sh);
#pragma unroll
        for (int i = 0; i < 8; ++i) { u32x2 w; w.x = cvt_pk_bf16(v[i].x, v[i].y); w.y = cvt_pk_bf16(v[i].z, v[i].w); *(u32x2*)(hbuf + (size_t)row * D + (lane + 64 * i) * 4) = w; }
    }
}

template <int L>
__device__ __forceinline__ void moe_layer(LAS unsigned char* lds, const XcdBarrier& bar, int bid, int G, int vcu, const float* xcur, float* xout) {
    {
        KP kp = kparams(); unsigned char* ws = kp->ws; const float* adl = (const float*)(ws + WS_ADA) + L * 12288;
        route_phase(lds, bid, G, xcur, kp->in[5] + L * D, adl + 4 * D, adl + 3 * D, kp->in[25] + (size_t)L * D * NE, kp->in[26] + L * NE,
                    (bf16_t*)(ws + WS_HBUF), (int*)(ws + WS_CTL + CTL_CNT) + L * 64, (int*)(ws + WS_LIST), (u32x2*)(ws + WS_REC));
    }
    xcd_barrier(bar);
    int ntiles;
    { KP kp = kparams(); ntiles = moe_tables(lds, (int*)(kp->ws + WS_CTL + CTL_CNT) + L * 64); }
    {
        KP kp = kparams(); unsigned char* ws = kp->ws;
        MoeGuOrder S{(const bf16_t*)(ws + WS_HBUF), (const bf16_t*)(ws + WS_WGU) + L * WGU_L, (const int*)(ws + WS_LIST), (const LAS int*)(lds + LDS_TSTART), (const LAS int*)(lds + LDS_TILEE), (const LAS int*)(lds + LDS_CNT), ntiles, G, vcu};
        EpiSwiglu E{(bf16_t*)(ws + WS_H)};
        _Pragma("unroll 1") for (int rep_ = 0; rep_ < REP_GEMM; ++rep_) gemm_phase<EpiSwiglu, MoeGuOrder>(lds, D, S, E);
    }
    xcd_barrier(bar);
    {
        KP kp = kparams(); unsigned char* ws = kp->ws;
        MoeDownOrder S{(const bf16_t*)(ws + WS_H), (const bf16_t*)(ws + WS_WD) + L * WD_L, (const LAS int*)(lds + LDS_TSTART), (const LAS int*)(lds + LDS_TILEE), ntiles, G, vcu};
        EpiF8 E{(unsigned char*)(ws + WS_BIG), D, Y8_SCALE};
        _Pragma("unroll 1") for (int rep_ = 0; rep_ < REP_GEMM; ++rep_) gemm_phase<EpiF8, MoeDownOrder>(lds, FF, S, E);
    }
    xcd_barrier(bar);
    {
        KP kp = kparams(); unsigned char* ws = kp->ws; const float* adl = (const float*)(ws + WS_ADA) + L * 12288;
#pragma unroll 1
        for (int rep_ = 0; rep_ < REP_COMB; ++rep_)
        if (L == 0) combine_phase<0>(lds, bid, G, xcur, adl + 5 * D, (const bf16_t*)(ws + WS_BIG), (const u32x2*)(ws + WS_REC), xout, nullptr, nullptr, nullptr, nullptr);
        else combine_phase<1>(lds, bid, G, xcur, adl + 5 * D, (const bf16_t*)(ws + WS_BIG), (const u32x2*)(ws + WS_REC), kp->out, kp->in[33], nullptr, nullptr, nullptr);
    }
}

__device__ __forceinline__ void hyena_layer(LAS unsigned char* lds, const XcdBarrier& bar, int bid, int G, int vcu) {
    { KP kp = kparams(); unsigned char* ws = kp->ws; const float* adl = (const float*)(ws + WS_ADA);
      for (int rep_ = 0; rep_ < REP_HCT; ++rep_) norm_phase(bid, G, kp->in[0], kp->in[4], adl + 1 * D, adl + 0 * D, (bf16_t*)(ws + WS_HBUF)); }
    xcd_barrier(bar);
    { KP kp = kparams(); unsigned char* ws = kp->ws;
      DenseOrder S; S.init((const bf16_t*)(ws + WS_HBUF), (const bf16_t*)(ws + WS_WHYIN), T, 6144, D, G, vcu);
      EpiBf16 E{(bf16_t*)(ws + WS_BIG + BIG_U), 6144};
      _Pragma("unroll 1") for (int rep_ = 0; rep_ < REP_GEMM; ++rep_) gemm_phase<EpiBf16, DenseOrder>(lds, D, S, E); }
    xcd_barrier(bar);
    { KP kp = kparams(); unsigned char* ws = kp->ws;
      for (int rep_ = 0; rep_ < REP_HCT; ++rep_) hy_conv_phase(lds, bid, G, (const bf16_t*)(ws + WS_BIG + BIG_U), kp->in[7], kp->in[8], (bf16_t*)(ws + WS_BIG + BIG_X0C), (bf16_t*)(ws + WS_BIG + BIG_VGT)); }
    xcd_barrier(bar);
#pragma unroll 1
    for (int rep_ = 0; rep_ < REP_HYF; ++rep_)
    { KP kp = kparams(); unsigned char* ws = kp->ws;
      hy_fft_phase(lds, bid, G, (const bf16_t*)(ws + WS_BIG + BIG_VGT), (bf16_t*)(ws + WS_BIG + BIG_U), (const float*)(ws + WS_BIG + BIG_A3), kp->in[16], kp->in[17], (float*)(ws + WS_XB), (float4*)(ws + WS_BIG + BIG_GSPEC)); }
    xcd_barrier(bar);
    { KP kp = kparams(); unsigned char* ws = kp->ws;
      for (int rep_ = 0; rep_ < REP_HCT; ++rep_) hy_tr_phase(lds, bid, G, (const bf16_t*)(ws + WS_BIG + BIG_U), (const bf16_t*)(ws + WS_BIG + BIG_X0C), (bf16_t*)(ws + WS_HBUF)); }
    xcd_barrier(bar);
    { KP kp = kparams(); unsigned char* ws = kp->ws; const float* adl = (const float*)(ws + WS_ADA);
      DenseOrder S; S.init((const bf16_t*)(ws + WS_HBUF), (const bf16_t*)(ws + WS_WHYOUT), T, D, D, G, vcu);
      EpiResid E{kp->in[0], (float*)(ws + WS_XA), adl + 2 * D};
      _Pragma("unroll 1") for (int rep_ = 0; rep_ < REP_GEMM; ++rep_) gemm_phase<EpiResid, DenseOrder>(lds, D, S, E); }
    xcd_barrier(bar);
}

__device__ __forceinline__ void mlstm_layer(LAS unsigned char* lds, const XcdBarrier& bar, int bid, int G, int vcu) {
    { KP kp = kparams(); unsigned char* ws = kp->ws; const float* adl = (const float*)(ws + WS_ADA) + 12288;
      ml_norm_gates_phase(lds, bid, G, (const float*)(ws + WS_XB), kp->in[4] + D, adl + 1 * D, adl + 0 * D, kp->in[19], kp->in[22], (bf16_t*)(ws + WS_HBUF), (float*)(ws + WS_BIG + BIG_GATES)); }
    xcd_barrier(bar);
    { KP kp = kparams(); unsigned char* ws = kp->ws;
      DenseOrder S; S.init((const bf16_t*)(ws + WS_HBUF), (const bf16_t*)(ws + WS_WMLIN), T, 6144, D, G, vcu);
      EpiBf16 E{(bf16_t*)(ws + WS_BIG + BIG_U), 6144};
      _Pragma("unroll 1") for (int rep_ = 0; rep_ < REP_GEMM; ++rep_) gemm_phase<EpiBf16, DenseOrder>(lds, D, S, E); }
    xcd_barrier(bar);
#pragma unroll 1
    for (int rep_ = 0; rep_ < REP_MLS; ++rep_) {
    { KP kp = kparams(); unsigned char* ws = kp->ws;
      ml_state_phase(lds, bid, G, (const bf16_t*)(ws + WS_BIG + BIG_U), (const float*)(ws + WS_BIG + BIG_GATES), kp->in[20], kp->in[21],
                     (bf16_t*)(ws + WS_BIG + BIG_SLOC), (float*)(ws + WS_BIG + BIG_ZLOC), (float*)(ws + WS_BIG + BIG_GTOT)); }
    xcd_barrier(bar);
    { KP kp = kparams(); unsigned char* ws = kp->ws;
      ml_scan_phase(bid, G, (bf16_t*)(ws + WS_BIG + BIG_SLOC), (float*)(ws + WS_BIG + BIG_ZLOC), (const float*)(ws + WS_BIG + BIG_GTOT)); }
    xcd_barrier(bar);
    { KP kp = kparams(); unsigned char* ws = kp->ws;
      ml_out_phase(lds, bid, G, (const bf16_t*)(ws + WS_BIG + BIG_U), (const float*)(ws + WS_BIG + BIG_GATES), kp->in[20], kp->in[21],
                   (const bf16_t*)(ws + WS_BIG + BIG_SLOC), (const float*)(ws + WS_BIG + BIG_ZLOC), kp->in[23], (bf16_t*)(ws + WS_HBUF)); }
    xcd_barrier(bar);
    }
    { KP kp = kparams(); unsigned char* ws = kp->ws; const float* adl = (const float*)(ws + WS_ADA) + 12288;
      DenseOrder S; S.init((const bf16_t*)(ws + WS_HBUF), (const bf16_t*)(ws + WS_WMLOUT), T, D, D, G, vcu);
      EpiResid E{(const float*)(ws + WS_XB), (float*)(ws + WS_XA), adl + 2 * D};
      _Pragma("unroll 1") for (int rep_ = 0; rep_ < REP_GEMM; ++rep_) gemm_phase<EpiResid, DenseOrder>(lds, D, S, E); }
    xcd_barrier(bar);
}

__global__ void __launch_bounds__(NTHR, 2) fwd(Params p_unused) {
    extern __shared__ __attribute__((aligned(16))) unsigned char lds_raw[];
    LAS unsigned char* lds = (LAS unsigned char*)lds_raw;
    const int G = gridDim.x, bid = blockIdx.x;
    const int vcu = (G % 8 == 0) ? (bid % 8) * (G / 8) + bid / 8 : bid;
    if (threadIdx.x < 4) ((LAS unsigned*)(lds + LDS_MISC))[threadIdx.x] = 0u;
    __syncthreads();
    XcdBarrier bar;
    { KP kp = kparams(); bar = xcd_barrier_post((unsigned*)(kp->ws + WS_CTL), (volatile LAS unsigned*)(lds + LDS_MISC)); }

#pragma unroll 1
    for (int repp_ = 0; repp_ < REP_PRO; ++repp_) {
    { KP kp = kparams(); ada_phase((LAS float*)lds, bid, G, kp->in[1], kp->in[2], kp->in[3], (float*)(kp->ws + WS_ADA)); }
    { KP kp = kparams(); hy_filter_mlp((LAS float*)lds, bid, G, kp->in[9], kp->in[10], kp->in[11], kp->in[12], kp->in[13], kp->in[14], kp->in[15], (float*)(kp->ws + WS_BIG + BIG_A3)); }
    {
        LAS float* tile = (LAS float*)lds;
        { KP kp = kparams(); cvt_group(tile, bid, G, kp->in[6], 0, 6144, D, 6144, (bf16_t*)(kp->ws + WS_WHYIN), 0, 0, 1); }
        { KP kp = kparams(); cvt_group(tile, bid, G, kp->in[18], 0, D, D, D, (bf16_t*)(kp->ws + WS_WHYOUT), 0, 0, 1); }
        { KP kp = kparams(); cvt_group(tile, bid, G, kp->in[19], 0, 6176, D, 6144, (bf16_t*)(kp->ws + WS_WMLIN), 0, 0, 1); }
        { KP kp = kparams(); cvt_group(tile, bid, G, kp->in[24], 0, D, D, D, (bf16_t*)(kp->ws + WS_WMLOUT), 0, 0, 1); }
#pragma unroll 1
        for (int l2 = 0; l2 < 2 * REP_CVT; ++l2) { const int l = l2 & 1;
            KP kp = kparams(); bf16_t* Wgu = (bf16_t*)(kp->ws + WS_WGU) + l * WGU_L; bf16_t* Wd = (bf16_t*)(kp->ws + WS_WD) + l * WD_L;
            cvt_group(tile, bid, G, kp->in[30] + (size_t)l * D * FF, 0, FF, D, FF, Wgu + (size_t)NE * 1024 * D, 0, 1, 1, 1024);
            cvt_group(tile, bid, G, kp->in[31] + (size_t)l * D * FF, 0, FF, D, FF, Wgu + (size_t)NE * 1024 * D, 0, 2, 1, 1024);
            cvt_group(tile, bid, G, kp->in[32] + (size_t)l * FF * D, 0, D, FF, D, Wd + (size_t)NE * D * FF, 0, 0, 1, D);
        }
    }
    }
    xcd_barrier(bar);

    hyena_layer(lds, bar, bid, G, vcu);
    { KP kp = kparams(); moe_layer<0>(lds, bar, bid, G, vcu, (const float*)(kp->ws + WS_XA), (float*)(kp->ws + WS_XB)); }
    asm volatile("s_waitcnt vmcnt(0)" ::: "memory"); __syncthreads();
    mlstm_layer(lds, bar, bid, G, vcu);
    { KP kp = kparams(); moe_layer<1>(lds, bar, bid, G, vcu, (const float*)(kp->ws + WS_XA), nullptr); }
}

extern "C" void kernel_launch(void* const* d_in, const int* in_sizes, int n_in, void* d_out, int out_size, void* d_ws, size_t ws_size, hipStream_t stream) {
    static int grid = 0;
    if (grid == 0) {
        if (n_in != 34 || ws_size < WS_END) { fprintf(stderr, "kernel_launch: n_in %d ws %zu need %zu\n", n_in, ws_size, (size_t)WS_END); grid = -1; return; }
        int dev = 0, cus = 0, per_cu = 0;
        hipGetDevice(&dev); hipDeviceGetAttribute(&cus, hipDeviceAttributeMultiprocessorCount, dev);
        hipFuncSetAttribute((const void*)fwd, hipFuncAttributeMaxDynamicSharedMemorySize, LDS_BYTES);
        hipOccupancyMaxActiveBlocksPerMultiprocessor(&per_cu, (const void*)fwd, NTHR, LDS_BYTES);
        (void)hipGetLastError();
        grid = (per_cu >= 1) ? (cus < 256 ? cus : 256) : -1;
        if (grid < 0) fprintf(stderr, "kernel_launch: occupancy query says 0 blocks per CU\n");
    }
    if (grid < 0) return;
    hipMemsetAsync((char*)d_ws + WS_CTL, 0, CTL_BYTES, stream);
    Params p{};
    for (int i = 0; i < 34; ++i) p.in[i] = (const float*)d_in[i];
    p.out = (float*)d_out; p.ws = (unsigned char*)d_ws;
    hipLaunchKernelGGL(fwd, dim3(grid), dim3(NTHR), LDS_BYTES, stream, p);
}
```

```cpp
#include <hip/hip_runtime.h>
#include <stdint.h>
#include <stdio.h>

#define LAS __attribute__((address_space(3)))
typedef unsigned short bf16_t;
typedef short bf16x8 __attribute__((ext_vector_type(8)));
typedef float f32x4 __attribute__((ext_vector_type(4)));
typedef unsigned u32x4 __attribute__((ext_vector_type(4)));
typedef unsigned u32x2 __attribute__((ext_vector_type(2)));

constexpr int T = 8192, D = 2048, NE = 64, FF = 512, TOPK = 6;
constexpr int NTHR = 512;
constexpr float EPS = 1e-6f;
#define REP_GEMM 1
#define REP_CVT 1
#define REP_MLS 1
#define REP_HYF 1
#define REP_F1 1
#define REP_TAP 1
#define REP_COMB 1
#define REP_PRO 1
#define REP_HCT 1

#define XB_TMO      128
#define XB_XCNT(j)  (256  + 64 * (j))
#define XB_XSUB(j)  (1280 + 64 * (j))
#define XB_XGEN(j)  (2304 + 64 * (j))
#define XB_TOP      3328
#define XB_TOPGEN   3392
#define XCD_BAR_WORDS 3456
#define XB_SPIN_CAP (1u << 18)

__device__ __forceinline__ unsigned xb_ld(unsigned* p)              { return __hip_atomic_load(p, __ATOMIC_RELAXED, __HIP_MEMORY_SCOPE_AGENT); }
__device__ __forceinline__ unsigned xb_add(unsigned* p, unsigned v) { return __hip_atomic_fetch_add(p, v, __ATOMIC_RELAXED, __HIP_MEMORY_SCOPE_AGENT); }
__device__ __forceinline__ unsigned xb_xcc_id() { return (unsigned)__builtin_amdgcn_s_getreg((3 << 11) | 20) & 0xFu; }
#define XB_SPIN(cond, bar) do { unsigned _sp = 0; while (cond) { __builtin_amdgcn_s_sleep(1); \
    if ((++_sp & 255u) == 0u) { if (xb_ld(&(bar)[XB_TMO])) break; if (_sp > XB_SPIN_CAP) { atomicAdd(&(bar)[XB_TMO], 1u); break; } } } } while (0)

struct XcdBarrier { unsigned* bar; unsigned x; volatile LAS unsigned* st; };

__device__ __forceinline__ XcdBarrier xcd_barrier_post(unsigned* bar, volatile LAS unsigned* st) {
    XcdBarrier b; b.bar = bar; b.x = xb_xcc_id(); b.st = st;
    if (threadIdx.x == 0) (void)xb_add(&bar[XB_XCNT(b.x)], 1u);
    return b;
}
__device__ __forceinline__ void xcd_barrier_complete(unsigned* bar, unsigned x, unsigned& nloc, unsigned& nx) {
    const unsigned G = gridDim.x * gridDim.y * gridDim.z;
    unsigned sum, cnt, mine, sp = 0u;
    for (;;) {
        sum = 0u; cnt = 0u; mine = 0u;
#pragma unroll
        for (unsigned j = 0; j < 16; ++j) { const unsigned c = xb_ld(&bar[XB_XCNT(j)]); sum += c; cnt += (c > 0u) ? 1u : 0u; mine = (j == x) ? c : mine; }
        if (sum == G) break;
        __builtin_amdgcn_s_sleep(1);
        if ((++sp & 255u) == 0u) { if (xb_ld(&bar[XB_TMO])) break; if (sp > XB_SPIN_CAP) { atomicAdd(&bar[XB_TMO], 1u); break; } }
    }
    nloc = mine > 0u ? mine : 1u; nx = cnt > 0u ? cnt : 1u;
}
__device__ __forceinline__ void xcd_barrier(const XcdBarrier& b) {
    asm volatile("s_waitcnt vmcnt(0)" ::: "memory");
    __syncthreads();
    if (threadIdx.x == 0) {
        unsigned* bar = b.bar;
        __builtin_amdgcn_s_waitcnt(0);
        unsigned nloc = b.st[0], nx = b.st[1];
        if (nloc == 0u) { xcd_barrier_complete(bar, b.x, nloc, nx); b.st[0] = nloc; b.st[1] = nx; }
        const unsigned old = xb_add(&bar[XB_XSUB(b.x)], 1u);
        const unsigned gen = old / nloc;
        if (old + 1u == (gen + 1u) * nloc) {
            __builtin_amdgcn_fence(__ATOMIC_RELEASE, "agent");
            asm volatile("s_waitcnt vmcnt(0)" ::: "memory");
            const unsigned og = xb_add(&bar[XB_TOP], 1u);
            const unsigned tg = og / nx;
            if (og + 1u == (tg + 1u) * nx) xb_add(&bar[XB_TOPGEN], 1u);
            else XB_SPIN(xb_ld(&bar[XB_TOPGEN]) == tg, bar);
            __builtin_amdgcn_fence(__ATOMIC_ACQUIRE, "agent");
            xb_add(&bar[XB_XGEN(b.x)], 1u);
            asm volatile("s_waitcnt vmcnt(0)" ::: "memory");
        } else {
            XB_SPIN(xb_ld(&bar[XB_XGEN(b.x)]) == gen, bar);
            __builtin_amdgcn_fence(__ATOMIC_ACQUIRE, "agent");
            asm volatile("s_waitcnt vmcnt(0)" ::: "memory");
        }
    }
    __syncthreads();
}

constexpr size_t WS_CTL   = 0;
constexpr size_t CTL_BYTES = 65536;
constexpr size_t CTL_CNT  = 16384;
constexpr size_t WS_ADA   = WS_CTL + CTL_BYTES;
constexpr size_t WS_WHYIN = WS_ADA + 131072;
constexpr size_t WS_WHYOUT= WS_WHYIN + (size_t)6144 * 2048 * 2;
constexpr size_t WS_WMLIN = WS_WHYOUT + (size_t)2048 * 2048 * 2;
constexpr size_t WS_WMLOUT= WS_WMLIN + (size_t)6144 * 2048 * 2;
constexpr size_t WS_WGU   = WS_WMLOUT + (size_t)2048 * 2048 * 2;
constexpr size_t WGU_L    = (size_t)65 * 1024 * 2048;
constexpr size_t WS_WD    = WS_WGU + 2 * WGU_L * 2;
constexpr size_t WD_L     = (size_t)65 * 2048 * 512;
constexpr size_t WS_HBUF  = WS_WD + 2 * WD_L * 2;
constexpr size_t WS_XA    = WS_HBUF + (size_t)T * D * 2;
constexpr size_t WS_XB    = WS_XA + (size_t)T * D * 4;
constexpr size_t WS_LIST  = WS_XB + (size_t)T * D * 4;
constexpr size_t WS_REC   = WS_LIST + (size_t)NE * T * 4;
constexpr int    SLOT_SH  = 65280;
constexpr int    NSLOT    = SLOT_SH + T;
constexpr size_t WS_H     = WS_REC + (size_t)T * TOPK * 8;
constexpr size_t WS_BIG   = WS_H + (size_t)NSLOT * FF * 2;
constexpr size_t WS_END   = WS_BIG + (size_t)NSLOT * D * 2;

constexpr int LDS_STAGE = 131072;
constexpr int LDS_MISC  = 135168;
constexpr int LDS_TSTART = LDS_MISC + 64;
constexpr int LDS_TILEE  = LDS_TSTART + 72 * 4;
constexpr int LDS_CNT    = LDS_TILEE + 320 * 4;
constexpr int LDS_BYTES  = LDS_MISC + 8192;

struct Params { const float* in[34]; float* out; unsigned char* ws; };
typedef const Params __attribute__((address_space(4)))* KP;
__device__ __forceinline__ int tid_fresh() { int t = threadIdx.x; asm volatile("" : "+v"(t)); return t; }
__device__ __forceinline__ KP kparams() { KP q = (KP)__builtin_amdgcn_kernarg_segment_ptr(); asm volatile("" : "+s"(q)); return q; }

__device__ __forceinline__ unsigned cvt_pk_bf16(float lo, float hi) { unsigned r; asm volatile("v_cvt_pk_bf16_f32 %0, %1, %2" : "=v"(r) : "v"(lo), "v"(hi)); return r; }
__device__ __forceinline__ float bf_lo(unsigned w) { return __uint_as_float(w << 16); }
__device__ __forceinline__ float bf_hi(unsigned w) { return __uint_as_float(w & 0xffff0000u); }
__device__ __forceinline__ float wave_sum(float v) {
#pragma unroll
    for (int o = 32; o > 0; o >>= 1) v += __shfl_xor(v, o);
    return v;
}
__device__ __forceinline__ float siluf(float v) { return v / (1.f + expf(-v)); }

constexpr int BM = 256, BK = 64, HALF = 128, HTB = HALF * BK * 2, NXCD = 8, WGM = 8;
__device__ __forceinline__ int lds_byte(int r, int c) { const int st = (r >> 4) * 2 + (c >> 5), rr = r & 15, cc = c & 31, ob = rr * 64 + cc * 2; return st * 1024 + (ob ^ (((ob >> 9) & 1) << 5)); }
__device__ __forceinline__ void stage_rc(int b, int& R, int& C) { const int st = b / 1024, sb = b % 1024, swz = sb ^ (((sb >> 9) & 1) << 5); R = (st >> 1) * 16 + swz / 64; C = (st & 1) * 32 + (swz % 64) / 2; }
__device__ __forceinline__ int perm32(int rho) { const int n = rho >> 4, i = rho & 15; return 8 * (i >> 2) + 4 * n + (i & 3); }

struct Unit { int pm, pn, e, rbase; };

template <class Epi, class Sched>
__device__ __forceinline__ void gemm_phase(LAS unsigned char* lds, const int K, const Sched& S, const Epi& E) {
    const int tid = tid_fresh(), wid = __builtin_amdgcn_readfirstlane(tid >> 6), lane = tid & 63, wr = wid >> 2, wc = wid & 3, fr = lane & 15, fq = lane >> 4;
    const int nt = K / BK;
    int R0, C0, R1, C1; stage_rc(tid * 16, R0, C0); stage_rc(tid * 16 + 8192, R1, C1);
    const int Rb0 = Epi::PERM ? ((R0 & ~31) + perm32(R0 & 31)) : R0, Rb1 = Epi::PERM ? ((R1 & ~31) + perm32(R1 & 31)) : R1;
    const unsigned voffB0 = S.b_off(Rb0, C0), voffB1 = S.b_off(Rb1, C1);
    const size_t kstep = (size_t)(BK * 2);
    const size_t kstepB = S.b_kstep(), hstep = S.b_hstep();
    const unsigned ldsw = (unsigned)wid * 1024u;
    const int aoff = lds_byte(wr * 64 + fr, fq * 8), boff = lds_byte(wc * 32 + fr, fq * 8);
#define PG8_SA(b, h) (((b) * 2 + (h)) * HTB)
#define PG8_SB(b, h) ((4 + (b) * 2 + (h)) * HTB)
#define PG8_STAGE(bufoff, gbase, v0, v1) do { \
        __builtin_amdgcn_global_load_lds((const unsigned*)((const char*)(gbase) + (v0)), (LAS unsigned*)(lds + (bufoff) + ldsw), 16, 0, 0); \
        __builtin_amdgcn_global_load_lds((const unsigned*)((const char*)(gbase) + (v1)), (LAS unsigned*)(lds + (bufoff) + ldsw + 8192), 16, 0, 0); } while (0)
#define PG8_LDA(dst, b, h) do { _Pragma("unroll") for (int m = 0; m < 4; ++m) _Pragma("unroll") for (int k = 0; k < 2; ++k) dst[m][k] = *(const LAS bf16x8*)(lds + PG8_SA(b, h) + aoff + m * 2048 + k * 1024); } while (0)
#define PG8_LDB(dst, b, h) do { _Pragma("unroll") for (int n = 0; n < 2; ++n) _Pragma("unroll") for (int k = 0; k < 2; ++k) dst[n][k] = *(const LAS bf16x8*)(lds + PG8_SB(b, h) + boff + n * 2048 + k * 1024); } while (0)
#define PG8_MMA(ai, bj, At, Bt) do { __builtin_amdgcn_s_setprio(1); _Pragma("unroll") for (int m = 0; m < 4; ++m) _Pragma("unroll") for (int n = 0; n < 2; ++n) _Pragma("unroll") for (int k = 0; k < 2; ++k) \
        acc[ai][bj][m][n] = __builtin_amdgcn_mfma_f32_16x16x32_bf16(Bt[n][k], At[m][k], acc[ai][bj][m][n], 0, 0, 0); __builtin_amdgcn_s_setprio(0); } while (0)
#define PG8_WAIT_V(n) asm volatile("s_waitcnt vmcnt(" #n ")" ::: "memory")
#define PG8_WAIT_L(n) asm volatile("s_waitcnt lgkmcnt(" #n ")" ::: "memory")
#define PG8_BAR __builtin_amdgcn_s_barrier()
#define PG8_SCHED __builtin_amdgcn_sched_barrier(0)
#define PG8_AOFFS(u, o00, o01, o10, o11) do { S.a_off4(u, R0, R1, o00, o01, o10, o11); o00 += (unsigned)C0 * 2u; o01 += (unsigned)C1 * 2u; o10 += (unsigned)C0 * 2u; o11 += (unsigned)C1 * 2u; } while (0)
    Unit cur, nxt; int ui = 0;
    if (!S.next(0, cur)) return;
    f32x4 acc[2][2][4][2];
#pragma unroll
    for (int a = 0; a < 2; ++a)
#pragma unroll
        for (int b = 0; b < 2; ++b)
#pragma unroll
            for (int m = 0; m < 4; ++m)
#pragma unroll
                for (int n = 0; n < 2; ++n) acc[a][b][m][n] = (f32x4){0.f, 0.f, 0.f, 0.f};
    bf16x8 At[4][2], B0[2][2], B1[2][2];
    const char* const gA = S.a_base();
    unsigned c00, c01, c10, c11, n00, n01, n10, n11;
    PG8_AOFFS(cur, c00, c01, c10, c11);
    const char* cB = S.b_ptr(cur);
    PG8_STAGE(PG8_SB(0, 0), cB, voffB0, voffB1); PG8_STAGE(PG8_SA(0, 0), gA, c00, c01); PG8_STAGE(PG8_SB(0, 1), cB + hstep, voffB0, voffB1); PG8_STAGE(PG8_SA(0, 1), gA, c10, c11);
    if (wr == 1) PG8_BAR;
    PG8_WAIT_V(4); PG8_BAR;
    PG8_STAGE(PG8_SB(1, 0), cB + kstepB, voffB0, voffB1); PG8_STAGE(PG8_SA(1, 0), gA + kstep, c00, c01); PG8_STAGE(PG8_SB(1, 1), cB + hstep + kstepB, voffB0, voffB1);
    PG8_WAIT_V(6); PG8_BAR;
    for (;;) {
        const bool has_next = S.next(ui + 1, nxt);
        const char* nB = cB;
        if (has_next) { PG8_AOFFS(nxt, n00, n01, n10, n11); nB = S.b_ptr(nxt); } else { n00 = c00; n01 = c01; n10 = c10; n11 = c11; }
        for (int t = 0; t < nt; t += 2) {
            const bool last = (t == nt - 2);
            const char* a1 = gA + (size_t)(t + 1) * kstep;
            const char* a2 = last ? gA : gA + (size_t)(t + 2) * kstep; const char* b2 = last ? nB : cB + (size_t)(t + 2) * kstepB;
            const char* a3 = a2 + kstep; const char* b3 = b2 + kstepB;
            const unsigned x00 = last ? n00 : c00, x01 = last ? n01 : c01, x10 = last ? n10 : c10, x11 = last ? n11 : c11;
            PG8_LDB(B0, 0, 0); PG8_SCHED; PG8_LDA(At, 0, 0); PG8_STAGE(PG8_SA(1, 1), a1, c10, c11);
            PG8_WAIT_L(8); PG8_BAR; PG8_WAIT_L(0); PG8_MMA(0, 0, At, B0); PG8_BAR; PG8_SCHED;
            PG8_LDB(B1, 0, 1); PG8_STAGE(PG8_SB(0, 0), b2, voffB0, voffB1);
            PG8_BAR; PG8_WAIT_L(0); PG8_MMA(0, 1, At, B1); PG8_BAR;
            PG8_LDA(At, 0, 1); PG8_STAGE(PG8_SA(0, 0), a2, x00, x01);
            PG8_BAR; PG8_WAIT_L(0); PG8_MMA(1, 0, At, B0); PG8_BAR; PG8_SCHED;
            PG8_STAGE(PG8_SB(0, 1), b2 + hstep, voffB0, voffB1);
            PG8_WAIT_V(6); PG8_BAR; PG8_MMA(1, 1, At, B1); PG8_BAR;
            PG8_LDB(B0, 1, 0); PG8_SCHED; PG8_LDA(At, 1, 0); PG8_STAGE(PG8_SA(0, 1), a2, x10, x11);
            PG8_WAIT_L(8); PG8_BAR; PG8_WAIT_L(0); PG8_MMA(0, 0, At, B0); PG8_BAR; PG8_SCHED;
            PG8_LDB(B1, 1, 1); PG8_STAGE(PG8_SB(1, 0), b3, voffB0, voffB1);
            PG8_BAR; PG8_WAIT_L(0); PG8_MMA(0, 1, At, B1); PG8_BAR;
            PG8_LDA(At, 1, 1); PG8_STAGE(PG8_SA(1, 0), a3, x00, x01);
            PG8_BAR; PG8_WAIT_L(0); PG8_MMA(1, 0, At, B0); PG8_BAR; PG8_SCHED;
            PG8_STAGE(PG8_SB(1, 1), b3 + hstep, voffB0, voffB1);
            PG8_WAIT_V(6); PG8_BAR; PG8_MMA(1, 1, At, B1); PG8_BAR;
        }
        E(acc, cur, wr, wc, fr, fq);
        if (!has_next) break;
#pragma unroll
        for (int a = 0; a < 2; ++a)
#pragma unroll
            for (int b = 0; b < 2; ++b)
#pragma unroll
                for (int m = 0; m < 4; ++m)
#pragma unroll
                    for (int n = 0; n < 2; ++n) acc[a][b][m][n] = (f32x4){0.f, 0.f, 0.f, 0.f};
        cur = nxt; cB = nB; c00 = n00; c01 = n01; c10 = n10; c11 = n11; ++ui;
    }
    PG8_WAIT_V(0);
    if (wr == 0) PG8_BAR;
    PG8_BAR;
#undef PG8_SA
#undef PG8_SB
#undef PG8_STAGE
#undef PG8_LDA
#undef PG8_LDB
#undef PG8_MMA
#undef PG8_WAIT_V
#undef PG8_WAIT_L
#undef PG8_BAR
#undef PG8_SCHED
#undef PG8_AOFFS
}

struct DenseOrder {
    const bf16_t* A; const bf16_t* Bt; int K, nM, nN, nwg, G, c;
    __device__ __forceinline__ void init(const bf16_t* A_, const bf16_t* Bt_, int M, int N, int K_, int G_, int c_) { A = A_; Bt = Bt_; K = K_; nM = M / BM; nN = N / BM; nwg = nM * nN; G = G_; c = c_; }
    __device__ __forceinline__ bool next(int i, Unit& u) const {
        const long L = (long)i * G + c; if (L >= nwg) return false;
        int wgid = (int)L; { const int q = nwg / NXCD, r = nwg % NXCD, xcd = wgid % NXCD, off = wgid / NXCD; wgid = (xcd < r ? xcd * (q + 1) : r * (q + 1) + (xcd - r) * q) + off; }
        const int nig = WGM * nN, gid = wgid / nig, fm = gid * WGM, gsz = (nM - fm) < WGM ? (nM - fm) : WGM;
        u.pm = fm + ((wgid % nig) % gsz); u.pn = (wgid % nig) / gsz; u.e = 0; u.rbase = u.pm * BM; return true;
    }
    __device__ __forceinline__ const char* a_base() const { return (const char*)A; }
    __device__ __forceinline__ unsigned a_off(const Unit& u, int r) const { return (unsigned)((u.pm * BM + r) * K) * 2u; }
    __device__ __forceinline__ void a_off4(const Unit& u, int r0, int r1, unsigned& o00, unsigned& o01, unsigned& o10, unsigned& o11) const { o00 = a_off(u, r0); o01 = a_off(u, r1); o10 = a_off(u, HALF + r0); o11 = a_off(u, HALF + r1); }
    __device__ __forceinline__ const char* b_ptr(const Unit& u) const { return (const char*)(Bt + (size_t)u.pn * BM * K); }
    __device__ __forceinline__ unsigned b_off(int R, int C) const { return (unsigned)(R * K + C) * 2u; }
    __device__ __forceinline__ size_t b_kstep() const { return (size_t)(BK * 2); }
    __device__ __forceinline__ size_t b_hstep() const { return (size_t)HALF * K * 2; }
};
struct MoeGuOrder {
    const bf16_t* A; const bf16_t* W; const int* list; const LAS int* tstart; const LAS int* tile_e; const LAS int* cnt; int ntiles, G, c;
    __device__ __forceinline__ bool next(int i, Unit& u) const {
        const int L = i * G + c; if (L >= ntiles * 4) return false;
        const int rt = L >> 2; u.pn = L & 3; u.e = tile_e[rt]; u.pm = rt - tstart[u.e]; u.rbase = (u.e < NE) ? rt * BM : SLOT_SH + u.pm * BM; return true;
    }
    __device__ __forceinline__ const char* a_base() const { return (const char*)A; }
    __device__ __forceinline__ unsigned a_off(const Unit& u, int r) const {
        const int pos = u.pm * BM + r; int tok = pos;
        if (u.e < NE) { tok = 0; if (pos < cnt[u.e]) tok = list[u.e * T + pos]; }
        return (unsigned)tok * (unsigned)(D * 2);
    }
    __device__ __forceinline__ void a_off4(const Unit& u, int r0, int r1, unsigned& o00, unsigned& o01, unsigned& o10, unsigned& o11) const {
        const int p0 = u.pm * BM + r0, p1 = u.pm * BM + r1, p2 = p0 + HALF, p3 = p1 + HALF;
        if (u.e >= NE) { o00 = (unsigned)p0 * (unsigned)(D * 2); o01 = (unsigned)p1 * (unsigned)(D * 2); o10 = (unsigned)p2 * (unsigned)(D * 2); o11 = (unsigned)p3 * (unsigned)(D * 2); return; }
        const int* lp = list + u.e * T;
        int v0 = lp[p0], v1 = lp[p1], v2 = lp[p2], v3 = lp[p3];
        asm volatile("" : "+v"(v0), "+v"(v1), "+v"(v2), "+v"(v3));
        const int c = cnt[u.e];
        o00 = p0 < c ? (unsigned)v0 * (unsigned)(D * 2) : 0u; o01 = p1 < c ? (unsigned)v1 * (unsigned)(D * 2) : 0u;
        o10 = p2 < c ? (unsigned)v2 * (unsigned)(D * 2) : 0u; o11 = p3 < c ? (unsigned)v3 * (unsigned)(D * 2) : 0u;
    }
    __device__ __forceinline__ const char* b_ptr(const Unit& u) const { return (const char*)(W + (size_t)u.e * 1024 * D + (size_t)u.pn * BM * 8); }
    __device__ __forceinline__ unsigned b_off(int R, int C) const { return (unsigned)((C >> 3) * 1024 + R) * 16u; }
    __device__ __forceinline__ size_t b_kstep() const { return (size_t)8 * 1024 * 16; }
    __device__ __forceinline__ size_t b_hstep() const { return (size_t)HALF * 16; }
};
struct MoeDownOrder {
    const bf16_t* A; const bf16_t* W; const LAS int* tstart; const LAS int* tile_e; int ntiles, G, c;
    __device__ __forceinline__ bool next(int i, Unit& u) const {
        const int L = i * G + c; if (L >= ntiles * 8) return false;
        const int rt = L >> 3; u.pn = L & 7; u.e = tile_e[rt]; u.pm = rt - tstart[u.e]; u.rbase = (u.e < NE) ? rt * BM : SLOT_SH + u.pm * BM; return true;
    }
    __device__ __forceinline__ const char* a_base() const { return (const char*)A; }
    __device__ __forceinline__ unsigned a_off(const Unit& u, int r) const { return (unsigned)((u.rbase + r) * FF) * 2u; }
    __device__ __forceinline__ void a_off4(const Unit& u, int r0, int r1, unsigned& o00, unsigned& o01, unsigned& o10, unsigned& o11) const { o00 = a_off(u, r0); o01 = a_off(u, r1); o10 = a_off(u, HALF + r0); o11 = a_off(u, HALF + r1); }
    __device__ __forceinline__ const char* b_ptr(const Unit& u) const { return (const char*)(W + (size_t)u.e * D * FF + (size_t)u.pn * BM * 8); }
    __device__ __forceinline__ unsigned b_off(int R, int C) const { return (unsigned)((C >> 3) * D + R) * 16u; }
    __device__ __forceinline__ size_t b_kstep() const { return (size_t)8 * D * 16; }
    __device__ __forceinline__ size_t b_hstep() const { return (size_t)HALF * 16; }
};

struct EpiBf16 {
    static constexpr bool PERM = true;
    bf16_t* O; int ldc;
    __device__ __forceinline__ void operator()(const f32x4 (&acc)[2][2][4][2], const Unit& u, int wr, int wc, int fr, int fq) const {
        const int row0 = u.rbase + wr * 64 + fr, col0 = u.pn * BM + wc * 32 + 8 * fq;
#pragma unroll
        for (int ai = 0; ai < 2; ++ai)
#pragma unroll
            for (int m = 0; m < 4; ++m) { bf16_t* rowp = O + (size_t)(row0 + ai * HALF + m * 16) * ldc + col0;
#pragma unroll
                for (int bj = 0; bj < 2; ++bj) { const f32x4 v0 = acc[ai][bj][m][0], v1 = acc[ai][bj][m][1];
                    u32x4 w; w.x = cvt_pk_bf16(v0[0], v0[1]); w.y = cvt_pk_bf16(v0[2], v0[3]); w.z = cvt_pk_bf16(v1[0], v1[1]); w.w = cvt_pk_bf16(v1[2], v1[3]);
                    *(u32x4*)(rowp + bj * HALF) = w; } }
    }
};
__device__ __forceinline__ unsigned pk4_fp8(float a, float b, float c, float d) { int w = 0; w = __builtin_amdgcn_cvt_pk_fp8_f32(a, b, w, false); w = __builtin_amdgcn_cvt_pk_fp8_f32(c, d, w, true); return (unsigned)w; }
typedef float f32x2v __attribute__((ext_vector_type(2)));
constexpr float Y8_SCALE = 16.f, Y8_INV = 1.f / 16.f;
struct EpiF8 {
    static constexpr bool PERM = true;
    unsigned char* O; int ldc; float scale;
    __device__ __forceinline__ void operator()(const f32x4 (&acc)[2][2][4][2], const Unit& u, int wr, int wc, int fr, int fq) const {
        const int row0 = u.rbase + wr * 64 + fr, col0 = u.pn * BM + wc * 32 + 8 * fq;
#pragma unroll
        for (int ai = 0; ai < 2; ++ai)
#pragma unroll
            for (int m = 0; m < 4; ++m) { unsigned char* rowp = O + (size_t)(row0 + ai * HALF + m * 16) * ldc + col0;
#pragma unroll
                for (int bj = 0; bj < 2; ++bj) { const f32x4 v0 = acc[ai][bj][m][0] * scale, v1 = acc[ai][bj][m][1] * scale;
                    u32x2 w; w.x = pk4_fp8(v0[0], v0[1], v0[2], v0[3]); w.y = pk4_fp8(v1[0], v1[1], v1[2], v1[3]);
                    *(u32x2*)(rowp + bj * HALF) = w; } }
    }
};
struct EpiSwiglu {
    static constexpr bool PERM = true;
    bf16_t* O;
    __device__ __forceinline__ void operator()(const f32x4 (&acc)[2][2][4][2], const Unit& u, int wr, int wc, int fr, int fq) const {
        const int row0 = u.rbase + wr * 64 + fr, col0 = u.pn * HALF + wc * 32 + 8 * fq;
#pragma unroll
        for (int ai = 0; ai < 2; ++ai)
#pragma unroll
            for (int m = 0; m < 4; ++m) { bf16_t* rowp = O + (size_t)(row0 + ai * HALF + m * 16) * FF + col0;
                float h[8];
#pragma unroll
                for (int n = 0; n < 2; ++n)
#pragma unroll
                    for (int j = 0; j < 4; ++j) { const float g = acc[ai][0][m][n][j], up = acc[ai][1][m][n][j]; h[n * 4 + j] = g / (1.f + __expf(-g)) * up; }
                u32x4 w; w.x = cvt_pk_bf16(h[0], h[1]); w.y = cvt_pk_bf16(h[2], h[3]); w.z = cvt_pk_bf16(h[4], h[5]); w.w = cvt_pk_bf16(h[6], h[7]);
                *(u32x4*)rowp = w; }
    }
};
struct EpiResid {
    static constexpr bool PERM = false;
    const float* xin; float* out; const float* gate;
    __device__ __forceinline__ void operator()(const f32x4 (&acc)[2][2][4][2], const Unit& u, int wr, int wc, int fr, int fq) const {
        const int row0 = u.rbase + wr * 64 + fr, col0 = u.pn * BM + wc * 32 + 4 * fq;
        f32x4 gv[2][2];
#pragma unroll
        for (int bj = 0; bj < 2; ++bj)
#pragma unroll
            for (int n = 0; n < 2; ++n) gv[bj][n] = *(const f32x4*)(gate + col0 + bj * HALF + n * 16);
#pragma unroll
        for (int ai = 0; ai < 2; ++ai) {
            f32x4 xv[4][2][2];
#pragma unroll
            for (int m = 0; m < 4; ++m) { const size_t ro = (size_t)(row0 + ai * HALF + m * 16) * D + col0;
#pragma unroll
                for (int bj = 0; bj < 2; ++bj)
#pragma unroll
                    for (int n = 0; n < 2; ++n) xv[m][bj][n] = *(const f32x4*)(xin + ro + bj * HALF + n * 16); }
#pragma unroll
            for (int m = 0; m < 4; ++m) { const size_t ro = (size_t)(row0 + ai * HALF + m * 16) * D + col0;
#pragma unroll
                for (int bj = 0; bj < 2; ++bj)
#pragma unroll
                    for (int n = 0; n < 2; ++n) *(f32x4*)(out + ro + bj * HALF + n * 16) = xv[m][bj][n] + gv[bj][n] * acc[ai][bj][m][n]; }
        }
    }
};

__device__ __forceinline__ void cvt_group(LAS float* tile, int bid, int G, const float* src, size_t sbs, int ldS, int K, int N, bf16_t* dst, size_t dbs, int mode, int nbatch, int nrimg = 0) {
    const int tid = tid_fresh();
    const int tk = K / 64, tn = N / 256, per = tk * tn, total = per * nbatch;
    const int kr = tid >> 6, c4 = tid & 63;
#define CVT_LOAD(jx) do { const int b_ = (jx) / per, r_ = (jx) - b_ * per, kt_ = r_ / tn, nt_ = r_ - kt_ * tn; \
        const float* s_ = src + (size_t)b_ * sbs + (size_t)(kt_ * 64) * ldS + nt_ * 256; \
        _Pragma("unroll") for (int q = 0; q < 8; ++q) v[q] = *(const float4*)(s_ + (size_t)(kr + 8 * q) * ldS + c4 * 4); } while (0)
    float4 v[8];
    if (bid < total) CVT_LOAD(bid);
    for (int j = bid; j < total; j += G) {
        const int b = j / per, r = j - b * per, kt = r / tn, ntile = r - kt * tn;
        __syncthreads();
#pragma unroll
        for (int q = 0; q < 8; ++q) { LAS float* tp = tile + (kr + 8 * q) * 257 + c4 * 4; tp[0] = v[q].x; tp[1] = v[q].y; tp[2] = v[q].z; tp[3] = v[q].w; }
        if (j + G < total) CVT_LOAD(j + G);
        __syncthreads();
        bf16_t* dmat = dst + (size_t)b * dbs;
#pragma unroll
        for (int q = 0; q < 4; ++q) {
            const int id = tid + NTHR * q, nr = id >> 3, kc = id & 7;
            const int n = ntile * 256 + nr;
            const int drow = (mode == 0) ? n : ((n >> 7) * 256 + (mode == 2 ? 128 : 0) + (n & 127));
            const LAS float* tp = tile + (kc * 8) * 257 + nr;
            u32x4 w; w.x = cvt_pk_bf16(tp[0], tp[257]); w.y = cvt_pk_bf16(tp[2 * 257], tp[3 * 257]); w.z = cvt_pk_bf16(tp[4 * 257], tp[5 * 257]); w.w = cvt_pk_bf16(tp[6 * 257], tp[7 * 257]);
            if (nrimg) *(u32x4*)(dmat + ((size_t)(kt * 8 + kc) * nrimg + drow) * 8) = w;
            else *(u32x4*)(dmat + (size_t)drow * K + kt * 64 + kc * 8) = w;
        }
    }
#undef CVT_LOAD
    __syncthreads();
}

__device__ __forceinline__ void ada_phase(LAS float* sm, int bid, int G, const float* c, const float* ada_w, const float* ada_b, float* ada) {
    const int tid = tid_fresh();
    LAS float* cs = sm; LAS float* red = sm + 2048;
    for (int i = tid; i < D; i += NTHR) cs[i] = siluf(c[i]);
    __syncthreads();
    const int kg = tid >> 5, c4 = tid & 31;
    for (int j = bid; j < 192; j += G) {
        const int l = j / 96, cb = j - l * 96;
        const float* w = ada_w + (size_t)l * D * 12288 + (size_t)(kg * 128) * 12288 + cb * 128 + c4 * 4;
        float4 a = make_float4(0.f, 0.f, 0.f, 0.f);
#pragma unroll 8
        for (int k = 0; k < 128; ++k) { const float4 wv = *(const float4*)(w + (size_t)k * 12288); const float s = cs[kg * 128 + k]; a.x += s * wv.x; a.y += s * wv.y; a.z += s * wv.z; a.w += s * wv.w; }
        __syncthreads();
        LAS float* rp = red + kg * 128 + c4 * 4; rp[0] = a.x; rp[1] = a.y; rp[2] = a.z; rp[3] = a.w;
        __syncthreads();
        if (tid < 128) { float s = 0.f;
#pragma unroll
            for (int q = 0; q < 16; ++q) s += red[q * 128 + tid];
            ada[l * 12288 + cb * 128 + tid] = s + ada_b[l * 12288 + cb * 128 + tid]; }
    }
    __syncthreads();
}

__device__ __forceinline__ void row_norm_mod(float4 (&v)[8], int lane, const float* g, const float* sc, const float* sh) {
    float4 ga[8], s1a[8], s0a[8];
#pragma unroll
    for (int i = 0; i < 8; ++i) { const int c = (lane + 64 * i) * 4; ga[i] = *(const float4*)(g + c); s1a[i] = *(const float4*)(sc + c); s0a[i] = *(const float4*)(sh + c); }
    float ss = 0.f;
#pragma unroll
    for (int i = 0; i < 8; ++i) ss += v[i].x * v[i].x + v[i].y * v[i].y + v[i].z * v[i].z + v[i].w * v[i].w;
    ss = wave_sum(ss);
    const float r = rsqrtf(ss * (1.f / D) + EPS);
#pragma unroll
    for (int i = 0; i < 8; ++i) { const float4 gg = ga[i], s1 = s1a[i], s0 = s0a[i];
        v[i].x = v[i].x * r * gg.x * (1.f + s1.x) + s0.x; v[i].y = v[i].y * r * gg.y * (1.f + s1.y) + s0.y; v[i].z = v[i].z * r * gg.z * (1.f + s1.z) + s0.z; v[i].w = v[i].w * r * gg.w * (1.f + s1.w) + s0.w; }
}

__device__ __forceinline__ void row_norm_mod2(float4 (&v0)[8], float4 (&v1)[8], int lane, const float* g, const float* sc, const float* sh) {
    float4 ga[8], s1a[8];
#pragma unroll
    for (int i = 0; i < 8; ++i) { const int c = (lane + 64 * i) * 4; ga[i] = *(const float4*)(g + c); s1a[i] = *(const float4*)(sc + c); }
    float ssa = 0.f, ssb = 0.f;
#pragma unroll
    for (int i = 0; i < 8; ++i) { ssa += v0[i].x * v0[i].x + v0[i].y * v0[i].y + v0[i].z * v0[i].z + v0[i].w * v0[i].w; ssb += v1[i].x * v1[i].x + v1[i].y * v1[i].y + v1[i].z * v1[i].z + v1[i].w * v1[i].w; }
    ssa = wave_sum(ssa); ssb = wave_sum(ssb);
    const float ra = rsqrtf(ssa * (1.f / D) + EPS), rb = rsqrtf(ssb * (1.f / D) + EPS);
#pragma unroll
    for (int i = 0; i < 8; ++i) { const int c = (lane + 64 * i) * 4; const float4 gg = ga[i], s1 = s1a[i], s0 = *(const float4*)(sh + c);
        v0[i].x = v0[i].x * ra * gg.x * (1.f + s1.x) + s0.x; v0[i].y = v0[i].y * ra * gg.y * (1.f + s1.y) + s0.y; v0[i].z = v0[i].z * ra * gg.z * (1.f + s1.z) + s0.z; v0[i].w = v0[i].w * ra * gg.w * (1.f + s1.w) + s0.w;
        v1[i].x = v1[i].x * rb * gg.x * (1.f + s1.x) + s0.x; v1[i].y = v1[i].y * rb * gg.y * (1.f + s1.y) + s0.y; v1[i].z = v1[i].z * rb * gg.z * (1.f + s1.z) + s0.z; v1[i].w = v1[i].w * rb * gg.w * (1.f + s1.w) + s0.w; }
}

constexpr int HFS_LD = 2050;
template <int NT>
__device__ __forceinline__ void rows16_matmul(const LAS float* hfs, const float* W, int ldw, int col0, int wave, int lane, f32x4 (&acc)[NT]) {
#pragma unroll
    for (int jt = 0; jt < NT; ++jt) acc[jt] = (f32x4){0.f, 0.f, 0.f, 0.f};
    const LAS float* ap = hfs + (lane & 15) * HFS_LD + wave * 256 + (lane >> 4);
    const float* bp = W + (size_t)(wave * 256 + (lane >> 4)) * ldw + col0 + (lane & 15);
#pragma unroll 8
    for (int s4 = 0; s4 < 64; ++s4) {
        const float a = ap[s4 * 4];
        float b[NT];
#pragma unroll
        for (int jt = 0; jt < NT; ++jt) b[jt] = bp[(size_t)(s4 * 4) * ldw + jt * 16];
#pragma unroll
        for (int jt = 0; jt < NT; ++jt) acc[jt] = __builtin_amdgcn_mfma_f32_16x16x4f32(a, b[jt], acc[jt], 0, 0, 0);
    }
}

__device__ __forceinline__ void route_phase(LAS unsigned char* lds, int bid, int G, const float* x, const float* g, const float* sc, const float* sh,
                                            const float* rw, const float* rbias, bf16_t* hbuf, int* cnt, int* list, u32x2* rec) {
    LAS float* hfs = (LAS float*)lds;
    LAS float* part = (LAS float*)lds;
    for (int r0 = bid * 16; r0 < T; r0 += G * 16) {
        const int tid = tid_fresh();
        const int lane = tid & 63, wave = tid >> 6;
        __syncthreads();
        {   const int row = r0 + wave * 2;
            float4 va[8], vb[8];
#pragma unroll
            for (int i = 0; i < 8; ++i) { va[i] = *(const float4*)(x + (size_t)row * D + (lane + 64 * i) * 4); vb[i] = *(const float4*)(x + (size_t)(row + 1) * D + (lane + 64 * i) * 4); }
            row_norm_mod2(va, vb, lane, g, sc, sh);
#pragma unroll
            for (int i = 0; i < 8; ++i) { const int c = (lane + 64 * i) * 4;
                u32x2 w; w.x = cvt_pk_bf16(va[i].x, va[i].y); w.y = cvt_pk_bf16(va[i].z, va[i].w); *(u32x2*)(hbuf + (size_t)row * D + c) = w;
                u32x2 w2; w2.x = cvt_pk_bf16(vb[i].x, vb[i].y); w2.y = cvt_pk_bf16(vb[i].z, vb[i].w); *(u32x2*)(hbuf + (size_t)(row + 1) * D + c) = w2;
                LAS float* hp = hfs + (wave * 2) * HFS_LD + c; hp[0] = va[i].x; hp[1] = va[i].y; hp[2] = va[i].z; hp[3] = va[i].w;
                hp[HFS_LD] = vb[i].x; hp[HFS_LD + 1] = vb[i].y; hp[HFS_LD + 2] = vb[i].z; hp[HFS_LD + 3] = vb[i].w; }
        }
        __syncthreads();
        f32x4 acc[4];
        rows16_matmul<4>(hfs, rw, NE, 0, wave, lane, acc);
        __syncthreads();
#pragma unroll
        for (int jt = 0; jt < 4; ++jt)
#pragma unroll
            for (int r = 0; r < 4; ++r) part[(wave * 16 + (lane >> 4) * 4 + r) * 64 + jt * 16 + (lane & 15)] = acc[jt][r];
        __syncthreads();
#pragma unroll 1
        for (int rr = 0; rr < 2; ++rr) {
            const int rl = wave * 2 + rr, row = r0 + rl;
            float logit = 0.f;
#pragma unroll
            for (int w = 0; w < 8; ++w) logit += part[(w * 16 + rl) * 64 + lane];
            const float score = 1.f / (1.f + expf(-logit));
            const float sel = score + rbias[lane];
            float m1 = sel; m1 = fmaxf(m1, __shfl_xor(m1, 1)); m1 = fmaxf(m1, __shfl_xor(m1, 2)); m1 = fmaxf(m1, __shfl_xor(m1, 4));
            const unsigned long long bal = __ballot(sel == m1);
            const unsigned gbits = (unsigned)(bal >> (lane & ~7)) & 0xffu;
            const int idx1 = (lane & ~7) + __ffs(gbits) - 1;
            float m2 = (lane == idx1) ? -INFINITY : sel; m2 = fmaxf(m2, __shfl_xor(m2, 1)); m2 = fmaxf(m2, __shfl_xor(m2, 2)); m2 = fmaxf(m2, __shfl_xor(m2, 4));
            const float gs = m1 + m2;
            const int grp = lane >> 3; int grank = 0;
#pragma unroll
            for (int gp = 0; gp < 8; ++gp) { const float o = __shfl(gs, gp * 8); grank += ((o > gs) || (o == gs && gp < grp)) ? 1 : 0; }
            const bool elig = grank < 4;
            const float sm = elig ? sel : -INFINITY;
            int rank = 0;
            for (int j = 0; j < 64; ++j) { const float o = __shfl(sm, j); rank += ((o > sm) || (o == sm && j < lane)) ? 1 : 0; }
            const bool chosen = elig && rank < TOPK;
            const float wsum = wave_sum(chosen ? score : 0.f);
            const float wgt = score / wsum * 2.5f;
            const unsigned long long cb = __ballot(chosen);
            if (chosen) {
                const int pos = atomicAdd(&cnt[lane], 1);
                list[lane * T + pos] = row;
                const int j = __popcll(cb & ((1ull << lane) - 1ull));
                u32x2 rr2; rr2.x = (unsigned)(lane * T + pos); rr2.y = __float_as_uint(wgt);
                rec[row * TOPK + j] = rr2;
            }
        }
    }
    __syncthreads();
}

__device__ __forceinline__ int moe_tables(LAS unsigned char* ldsb, int* cnt_g) {
    const int tid = tid_fresh();
    LAS int* tstart = (LAS int*)(ldsb + LDS_TSTART); LAS int* tile_e = (LAS int*)(ldsb + LDS_TILEE); LAS int* cl = (LAS int*)(ldsb + LDS_CNT);
    __syncthreads();
    if (tid < NE) cl[tid] = (int)__hip_atomic_load((unsigned*)cnt_g + tid, __ATOMIC_RELAXED, __HIP_MEMORY_SCOPE_AGENT);
    __syncthreads();
    if (tid == 0) { int s = 0; for (int e = 0; e < NE; ++e) { tstart[e] = s; s += (cl[e] + BM - 1) / BM; } tstart[NE] = s; tstart[NE + 1] = s + T / BM; }
    __syncthreads();
    const int ntiles = tstart[NE + 1];
    for (int i = tid; i < ntiles; i += NTHR) { int e = 0; while (e < NE && i >= tstart[e + 1]) ++e; tile_e[i] = e; }
    __syncthreads();
    return ntiles;
}

template <int MODE>
__device__ __forceinline__ void combine_phase(LAS unsigned char* ldsb, int bid, int G, const float* x, const float* gf, const bf16_t* Y, const u32x2* rec,
                                              float* xout, const float* ng, const float* sc, const float* sh, bf16_t* hbuf) {
    const LAS int* tstart = (const LAS int*)(ldsb + LDS_TSTART);
    const int wave0 = tid_fresh() >> 6;
    for (int rowi = bid * 16 + wave0 * 2; rowi < T; rowi += ((rowi & 1) ? (G * 16 - 1) : 1)) {
        const int row = rowi;
        const int lane = tid_fresh() & 63;
        float a[4][8];
#pragma unroll
        for (int i = 0; i < 4; ++i)
#pragma unroll
            for (int q = 0; q < 8; ++q) a[i][q] = 0.f;
        u32x2 rr[TOPK];
#pragma unroll
        for (int j = 0; j < TOPK; ++j) rr[j] = rec[row * TOPK + j];
        float4 xr[4][2];
#pragma unroll
        for (int i = 0; i < 4; ++i) { const int c = lane * 8 + i * 512; xr[i][0] = *(const float4*)(x + (size_t)row * D + c); xr[i][1] = *(const float4*)(x + (size_t)row * D + c + 4); }
#pragma unroll
        for (int jb = 0; jb <= TOPK; jb += 8) {
            u32x2 yv[7][4]; float wj[7];
#pragma unroll
            for (int jj = 0; jj < 7; ++jj) { const int j = jb + jj; if (j > TOPK) break;
                size_t slot = (size_t)SLOT_SH + row; wj[jj] = Y8_INV;
                if (j < TOPK) { const int e = (int)(rr[j].x >> 13), pos = (int)(rr[j].x & 8191u); wj[jj] = __uint_as_float(rr[j].y) * Y8_INV; slot = (size_t)tstart[e] * BM + pos; }
                const unsigned char* yp = (const unsigned char*)Y + slot * D + lane * 8;
#pragma unroll
                for (int i = 0; i < 4; ++i) yv[jj][i] = *(const u32x2*)(yp + i * 512);
            }
#pragma unroll
            for (int jj = 0; jj < 7; ++jj) { const int j = jb + jj; if (j > TOPK) break; const float w = wj[jj];
#pragma unroll
                for (int i = 0; i < 4; ++i) { const u32x2 y2 = yv[jj][i];
                    const f32x2v p0 = __builtin_amdgcn_cvt_pk_f32_fp8((int)y2.x, false), p1 = __builtin_amdgcn_cvt_pk_f32_fp8((int)y2.x, true), p2 = __builtin_amdgcn_cvt_pk_f32_fp8((int)y2.y, false), p3 = __builtin_amdgcn_cvt_pk_f32_fp8((int)y2.y, true);
                    a[i][0] += w * p0.x; a[i][1] += w * p0.y; a[i][2] += w * p1.x; a[i][3] += w * p1.y;
                    a[i][4] += w * p2.x; a[i][5] += w * p2.y; a[i][6] += w * p3.x; a[i][7] += w * p3.y; }
            }
            asm volatile("" ::: "memory");
        }
        float ss = 0.f;
#pragma unroll
        for (int i = 0; i < 4; ++i) { const int c = lane * 8 + i * 512;
#pragma unroll
            for (int h = 0; h < 2; ++h) { const float4 xv = xr[i][h], gv = *(const float4*)(gf + c + h * 4);
                a[i][h * 4 + 0] = xv.x + gv.x * a[i][h * 4 + 0]; a[i][h * 4 + 1] = xv.y + gv.y * a[i][h * 4 + 1]; a[i][h * 4 + 2] = xv.z + gv.z * a[i][h * 4 + 2]; a[i][h * 4 + 3] = xv.w + gv.w * a[i][h * 4 + 3]; }
#pragma unroll
            for (int q = 0; q < 8; ++q) ss += a[i][q] * a[i][q]; }
        if (MODE == 0 || MODE == 2) {
#pragma unroll
            for (int i = 0; i < 4; ++i) { float* op = xout + (size_t)row * D + lane * 8 + i * 512; *(float4*)op = make_float4(a[i][0], a[i][1], a[i][2], a[i][3]); *(float4*)(op + 4) = make_float4(a[i][4], a[i][5], a[i][6], a[i][7]); }
        }
        if (MODE == 1 || MODE == 2) {
            ss = wave_sum(ss);
            const float r = rsqrtf(ss * (1.f / D) + EPS);
            asm volatile("" ::: "memory");
            float4 g4[4][2];
#pragma unroll
            for (int i = 0; i < 4; ++i) { const int c = lane * 8 + i * 512; g4[i][0] = *(const float4*)(ng + c); g4[i][1] = *(const float4*)(ng + c + 4); }
#pragma unroll
            for (int i = 0; i < 4; ++i) { const int c = lane * 8 + i * 512; float o[8];
                const float gq[8] = {g4[i][0].x, g4[i][0].y, g4[i][0].z, g4[i][0].w, g4[i][1].x, g4[i][1].y, g4[i][1].z, g4[i][1].w};
#pragma unroll
                for (int q = 0; q < 8; ++q) { o[q] = a[i][q] * r * gq[q]; if (MODE == 2) o[q] = o[q] * (1.f + sc[c + q]) + sh[c + q]; }
                if (MODE == 1) { float* op = xout + (size_t)row * D + c; *(float4*)op = make_float4(o[0], o[1], o[2], o[3]); *(float4*)(op + 4) = make_float4(o[4], o[5], o[6], o[7]); }
                else { u32x4 w; w.x = cvt_pk_bf16(o[0], o[1]); w.y = cvt_pk_bf16(o[2], o[3]); w.z = cvt_pk_bf16(o[4], o[5]); w.w = cvt_pk_bf16(o[6], o[7]); *(u32x4*)(hbuf + (size_t)row * D + c) = w; } }
        }
    }
}

constexpr int BG_STEPS = 2 * 3 * 4096 * 8;
struct BgState { float r[64]; bf16_t* dst[2]; int o2[2]; int st; };
__device__ __forceinline__ bool bg_decode(int st, int wg, int NW, int lane, KP kp, const float*& src, int& ldS, bf16_t*& dst, int& o2) {
    const int g = st * NW + wg;
    if (g >= BG_STEPS) { src = kp->in[27] + lane; ldS = 0; dst = nullptr; o2 = 0; return false; }
    const int l = g / 98304, r = g - l * 98304;
    unsigned char* ws = kp->ws;
    if (r < 65536) {
        const int e = r >> 10, kc = (r >> 2) & 255, kind = (r >> 1) & 1, cc = r & 1, n = cc * 256 + lane;
        ldS = FF; o2 = 256 * 8;
        src = kp->in[27 + kind] + ((size_t)(l * NE + e) * D + kc * 8) * FF + n;
        const int drow = (n >> 7) * 256 + kind * 128 + (n & 127);
        dst = (bf16_t*)(ws + WS_WGU) + l * WGU_L + (size_t)e * 1024 * D + ((size_t)kc * 1024 + drow) * 8;
    } else {
        const int r2 = r - 65536, e = r2 >> 9, kc = (r2 >> 3) & 63, cc = r2 & 7, n = cc * 256 + lane;
        ldS = D; o2 = 128 * 8;
        src = kp->in[29] + ((size_t)(l * NE + e) * FF + kc * 8) * D + n;
        dst = (bf16_t*)(ws + WS_WD) + l * WD_L + (size_t)e * D * FF + ((size_t)kc * D + n) * 8;
    }
    return true;
}
template <int NS> __device__ __forceinline__ void bg_issue(BgState& b, int wg, int NW, int lane) {
    KP kp = kparams();
#pragma unroll
    for (int s = 0; s < NS; ++s) { const float* src; int ldS; bf16_t* dst; int o2;
        bg_decode(b.st + s, wg, NW, lane, kp, src, ldS, dst, o2);
        b.dst[s] = dst; b.o2[s] = o2;
#pragma unroll
        for (int i = 0; i < 8; ++i) { const float* p = src + (size_t)i * ldS;
            asm volatile("global_load_dword %0, %4, off\n\tglobal_load_dword %1, %4, off offset:256\n\tglobal_load_dword %2, %4, off offset:512\n\tglobal_load_dword %3, %4, off offset:768"
                         : "=&v"(b.r[(s * 8 + i) * 4 + 0]), "=&v"(b.r[(s * 8 + i) * 4 + 1]), "=&v"(b.r[(s * 8 + i) * 4 + 2]), "=&v"(b.r[(s * 8 + i) * 4 + 3]) : "v"(p) : "memory"); }
    }
}
#define BG_TIE16(o) "+v"(b.r[o + 0]), "+v"(b.r[o + 1]), "+v"(b.r[o + 2]), "+v"(b.r[o + 3]), "+v"(b.r[o + 4]), "+v"(b.r[o + 5]), "+v"(b.r[o + 6]), "+v"(b.r[o + 7]), "+v"(b.r[o + 8]), "+v"(b.r[o + 9]), "+v"(b.r[o + 10]), "+v"(b.r[o + 11]), "+v"(b.r[o + 12]), "+v"(b.r[o + 13]), "+v"(b.r[o + 14]), "+v"(b.r[o + 15])
template <int NS> __device__ __forceinline__ void bg_finish(BgState& b, int wg, int NW, int lane) {
    asm volatile("s_waitcnt vmcnt(0)" ::: "memory");
    asm volatile("" : BG_TIE16(0) :: "memory");
    asm volatile("" : BG_TIE16(16) :: "memory");
    if (NS == 2) { asm volatile("" : BG_TIE16(32) :: "memory"); asm volatile("" : BG_TIE16(48) :: "memory"); }
#pragma unroll
    for (int s = 0; s < NS; ++s) { bf16_t* dst = b.dst[s];
        if (dst != nullptr) {
#pragma unroll
            for (int c = 0; c < 4; ++c) { u32x4 w;
                w.x = cvt_pk_bf16(b.r[(s * 8 + 0) * 4 + c], b.r[(s * 8 + 1) * 4 + c]); w.y = cvt_pk_bf16(b.r[(s * 8 + 2) * 4 + c], b.r[(s * 8 + 3) * 4 + c]);
                w.z = cvt_pk_bf16(b.r[(s * 8 + 4) * 4 + c], b.r[(s * 8 + 5) * 4 + c]); w.w = cvt_pk_bf16(b.r[(s * 8 + 6) * 4 + c], b.r[(s * 8 + 7) * 4 + c]);
                bf16_t* dp = dst + (c & 1) * 512 + (c >> 1) * b.o2[s];
                asm volatile("global_store_dwordx4 %0, %1, off\n\ts_nop 1" :: "v"(dp), "v"(w) : "memory"); }
        } }
    b.st += NS;
}
template <int BANK> __device__ __forceinline__ void bg_issue1(BgState& b, int wg, int NW, int lane) {
    KP kp = kparams();
    const float* src; int ldS; bf16_t* dst; int o2;
    bg_decode(b.st, wg, NW, lane, kp, src, ldS, dst, o2);
    b.dst[BANK] = dst; b.o2[BANK] = o2;
    asm volatile("s_nop 6" ::: "memory");
#pragma unroll
    for (int i = 0; i < 8; ++i) { const float* p = src + (size_t)i * ldS;
        asm volatile("global_load_dword %0, %4, off\n\tglobal_load_dword %1, %4, off offset:256\n\tglobal_load_dword %2, %4, off offset:512\n\tglobal_load_dword %3, %4, off offset:768"
                     : "=&v"(b.r[(BANK * 8 + i) * 4 + 0]), "=&v"(b.r[(BANK * 8 + i) * 4 + 1]), "=&v"(b.r[(BANK * 8 + i) * 4 + 2]), "=&v"(b.r[(BANK * 8 + i) * 4 + 3]) : "v"(p) : "memory"); }
    b.st += 1;
}
template <int BANK, int WAITN> __device__ __forceinline__ void bg_finish1(BgState& b) {
    if (WAITN == 32) asm volatile("s_waitcnt vmcnt(32)" ::: "memory"); else asm volatile("s_waitcnt vmcnt(0)" ::: "memory");
    asm volatile("" : BG_TIE16(BANK * 32) :: "memory");
    asm volatile("" : BG_TIE16(BANK * 32 + 16) :: "memory");
    bf16_t* dst = b.dst[BANK];
    if (dst != nullptr) {
#pragma unroll
        for (int c = 0; c < 4; ++c) { u32x4 w;
            w.x = cvt_pk_bf16(b.r[(BANK * 8 + 0) * 4 + c], b.r[(BANK * 8 + 1) * 4 + c]); w.y = cvt_pk_bf16(b.r[(BANK * 8 + 2) * 4 + c], b.r[(BANK * 8 + 3) * 4 + c]);
            w.z = cvt_pk_bf16(b.r[(BANK * 8 + 4) * 4 + c], b.r[(BANK * 8 + 5) * 4 + c]); w.w = cvt_pk_bf16(b.r[(BANK * 8 + 6) * 4 + c], b.r[(BANK * 8 + 7) * 4 + c]);
            bf16_t* dp = dst + (c & 1) * 512 + (c >> 1) * b.o2[BANK];
            asm volatile("global_store_dwordx4 %0, %1, off\n\ts_nop 1" :: "v"(dp), "v"(w) : "memory"); }
    }
}
#undef BG_TIE16

constexpr size_t BIG_U    = 0;
constexpr size_t BIG_X0C  = (size_t)104857600;
constexpr size_t BIG_VGT  = (size_t)146800640;
constexpr size_t BIG_A3   = (size_t)220200960;
constexpr size_t BIG_GSPEC = (size_t)230686720;
#define FFT_HD __device__ __forceinline__
typedef float cf2 __attribute__((ext_vector_type(2)));
FFT_HD cf2 mk2(float x, float y) { return (cf2){x, y}; }
FFT_HD void fft_sincos(float frac, float& s, float& c) { s = __builtin_amdgcn_sinf(frac); c = __builtin_amdgcn_cosf(frac); }
constexpr int FN = 16384;
#define PADI(n) ((n) + (((n) >> 6) << 1))
constexpr int FN_PAD = FN + (FN >> 6) * 2;
FFT_HD cf2 cmul(cf2 a, cf2 b) { return mk2(a.x * b.x - a.y * b.y, a.x * b.y + a.y * b.x); }
FFT_HD cf2 cmulc(cf2 a, cf2 b) { return mk2(a.x * b.x + a.y * b.y, a.y * b.x - a.x * b.y); }
FFT_HD cf2 cadd(cf2 a, cf2 b) { return mk2(a.x + b.x, a.y + b.y); }
FFT_HD cf2 csub(cf2 a, cf2 b) { return mk2(a.x - b.x, a.y - b.y); }
template <bool INV> FFT_HD void dft4(cf2& a, cf2& b, cf2& c, cf2& d) {
    const cf2 s0 = cadd(a, c), s1 = csub(a, c), s2 = cadd(b, d), s3 = csub(b, d);
    a = cadd(s0, s2); c = csub(s0, s2);
    const cf2 r = INV ? mk2(-s3.y, s3.x) : mk2(s3.y, -s3.x);
    b = cadd(s1, r); d = csub(s1, r);
}
template <bool INV> FFT_HD void dft16(cf2 (&x)[16]) {
    const float C1 = 0.9238795325112867f, S1 = 0.3826834323650898f, H = 0.7071067811865476f;
#pragma unroll
    for (int b = 0; b < 4; ++b) dft4<INV>(x[b], x[4 + b], x[8 + b], x[12 + b]);
    const float s = INV ? -1.f : 1.f;
    x[4 + 1] = cmul(x[4 + 1], mk2(C1, -s * S1)); x[8 + 1] = cmul(x[8 + 1], mk2(H, -s * H));   x[12 + 1] = cmul(x[12 + 1], mk2(S1, -s * C1));
    x[4 + 2] = cmul(x[4 + 2], mk2(H, -s * H));   x[8 + 2] = cmul(x[8 + 2], mk2(0.f, -s));     x[12 + 2] = cmul(x[12 + 2], mk2(-H, -s * H));
    x[4 + 3] = cmul(x[4 + 3], mk2(S1, -s * C1)); x[8 + 3] = cmul(x[8 + 3], mk2(-H, -s * H));  x[12 + 3] = cmul(x[12 + 3], mk2(-C1, s * S1));
#pragma unroll
    for (int c = 0; c < 4; ++c) dft4<INV>(x[4 * c], x[4 * c + 1], x[4 * c + 2], x[4 * c + 3]);
#pragma unroll
    for (int c = 0; c < 4; ++c)
#pragma unroll
        for (int d = c + 1; d < 4; ++d) { const cf2 t = x[4 * c + d]; x[4 * c + d] = x[4 * d + c]; x[4 * d + c] = t; }
}
FFT_HD void fft_gen_tw(float frac, cf2 (&tw)[16]) {
    float sn, cs; fft_sincos(frac, sn, cs);
    tw[1] = mk2(cs, -sn);
    tw[2] = cmul(tw[1], tw[1]); tw[3] = cmul(tw[2], tw[1]); tw[4] = cmul(tw[2], tw[2]); tw[5] = cmul(tw[4], tw[1]); tw[6] = cmul(tw[4], tw[2]); tw[7] = cmul(tw[4], tw[3]);
    tw[8] = cmul(tw[4], tw[4]);
#pragma unroll
    for (int j = 9; j < 16; ++j) tw[j] = cmul(tw[8], tw[j - 8]);
}
template <bool INV, int lS, class ZP> FFT_HD void fft_r16_pass(ZP z, int tid) {
    constexpr int S = 1 << lS, STEP = (S >= 64) ? S + S / 32 : S;
    constexpr float inv = 1.0f / (float)(16 * S);
    cf2 tw[16];
    if (lS != 10) {
        fft_gen_tw((float)(tid & (S - 1)) * inv, tw);
        const int w0 = tid, w1 = tid + 512;
        const int pb0 = PADI(((w0 >> lS) << (lS + 4)) + (w0 & (S - 1))), pb1 = PADI(((w1 >> lS) << (lS + 4)) + (w1 & (S - 1)));
        cf2 x[16], y[16];
#pragma unroll
        for (int j = 0; j < 16; ++j) x[j] = z[pb0 + j * STEP];
#pragma unroll
        for (int j = 0; j < 16; ++j) y[j] = z[pb1 + j * STEP];
        if (INV) {
#pragma unroll
            for (int j = 1; j < 16; ++j) x[j] = cmulc(x[j], tw[j]);
        }
        dft16<INV>(x);
        if (!INV) {
#pragma unroll
            for (int j = 1; j < 16; ++j) x[j] = cmul(x[j], tw[j]);
        }
#pragma unroll
        for (int j = 0; j < 16; ++j) z[pb0 + j * STEP] = x[j];
        if (INV) {
#pragma unroll
            for (int j = 1; j < 16; ++j) y[j] = cmulc(y[j], tw[j]);
        }
        dft16<INV>(y);
        if (!INV) {
#pragma unroll
            for (int j = 1; j < 16; ++j) y[j] = cmul(y[j], tw[j]);
        }
#pragma unroll
        for (int j = 0; j < 16; ++j) z[pb1 + j * STEP] = y[j];
    } else {
#pragma unroll 1
        for (int it = 0; it < 2; ++it) {
            const int w = tid + 512 * it;
            const int blk = w >> lS, p = w & (S - 1), pb = PADI((blk << (lS + 4)) + p);
            fft_gen_tw((float)p * inv, tw);
            cf2 x[16];
#pragma unroll
            for (int j = 0; j < 16; ++j) x[j] = z[pb + j * STEP];
            if (INV) {
#pragma unroll
                for (int j = 1; j < 16; ++j) x[j] = cmulc(x[j], tw[j]);
            }
            dft16<INV>(x);
            if (!INV) {
#pragma unroll
                for (int j = 1; j < 16; ++j) x[j] = cmul(x[j], tw[j]);
            }
#pragma unroll
            for (int j = 0; j < 16; ++j) z[pb + j * STEP] = x[j];
        }
    }
}
template <bool INV, class ZP> FFT_HD void fft_r4_pass(ZP z, int tid, int nthr) {
    for (int w = tid; w < FN / 4; w += nthr) {
        const int base = PADI(4 * w);
        cf2 a = z[base], b = z[base + 1], c = z[base + 2], d = z[base + 3];
        dft4<INV>(a, b, c, d);
        z[base] = a; z[base + 1] = b; z[base + 2] = c; z[base + 3] = d;
    }
}
FFT_HD int fpos(int k) { return ((k & 15) << 10) + (((k >> 4) & 15) << 6) + (((k >> 8) & 15) << 2) + (k >> 12); }

__device__ __forceinline__ void hy_filter_mlp(LAS float* sm, int bid, int G, const float* w0, const float* b0, const float* w1, const float* b1, const float* w2, const float* b2, const float* freq, float* a3) {
    const int tid = tid_fresh(), lane = tid & 63, wave = tid >> 6;
    LAS float* w0s = sm; LAS float* w1s = sm + 33 * 64; LAS float* w2s = w1s + 4096;
    __syncthreads();
    for (int i = tid; i < 33 * 64; i += NTHR) w0s[i] = w0[i];
    for (int i = tid; i < 4096; i += NTHR) { w1s[i] = w1[i]; w2s[i] = w2[i]; }
    __syncthreads();
    const float fr = freq[lane], bb0 = b0[lane], bb1 = b1[lane], bb2 = b2[lane];
    for (int row = bid * 8 + wave; row < T; row += G * 8) {
        const float tn = (float)row / (float)(T - 1);
        const float ang = 6.283185307179586f * (float)row / (float)T;
        float zi = 0.f;
        if (lane == 0) zi = tn;
        else if (lane <= 16) { const float band = 1e-4f + (float)(lane - 1) * ((15.f - 1e-4f) / 15.f); zi = cosf(ang * band); }
        else if (lane <= 32) { const float band = 1e-4f + (float)(lane - 17) * ((15.f - 1e-4f) / 15.f); zi = -sinf(ang * band); }
        float acc = bb0;
#pragma unroll 1
        for (int i = 0; i < 33; ++i) acc += __shfl(zi, i) * w0s[i * 64 + lane];
        float a = sinf(fr * acc);
        acc = bb1;
#pragma unroll 4
        for (int i = 0; i < 64; ++i) acc += __shfl(a, i) * w1s[i * 64 + lane];
        a = sinf(fr * acc);
        acc = bb2;
#pragma unroll 4
        for (int i = 0; i < 64; ++i) acc += __shfl(a, i) * w2s[i * 64 + lane];
        a = sinf(fr * acc);
        a3[(size_t)row * 64 + lane] = a;
    }
    __syncthreads();
}

__device__ __forceinline__ void hy_conv_phase(LAS unsigned char* lds, int bid, int G, const bf16_t* u, const float* cw, const float* cb, bf16_t* x0c, bf16_t* vgT) {
    LAS float* sm = (LAS float*)lds;
    const int tid = tid_fresh();
#define HC_LOAD(tile_, v_) do { const int t0_ = ((tile_) >> 5) * 64, c0_ = ((tile_) & 31) * 64; \
        _Pragma("unroll") for (int it = 0; it < 4; ++it) { const int id0 = tid + NTHR * it, id = id0 < 3 * 66 * 8 ? id0 : 3 * 66 * 8 - 1; \
            const int g = id / 528, r = id - g * 528, row = r >> 3, ch = r & 7, t1 = t0_ - 1 + row, t = t1 < 0 ? 0 : (t1 > T - 1 ? T - 1 : t1); \
            v_[it] = *(const u32x4*)(u + (size_t)t * 6144 + g * 2048 + c0_ + ch * 8); } } while (0)
    u32x4 pv[4];
    if (bid < 4096) HC_LOAD(bid, pv);
    float wa[8], wb[8], wc_[8], wd[8]; float p0 = 0.f, p1 = 0.f, p2 = 0.f, pb = 0.f, q0 = 0.f, q1 = 0.f, q2 = 0.f, qb = 0.f; int cwc0 = -1;
    for (int tile = bid; tile < 4096; tile += G) {
        const int t0 = (tile >> 5) * 64, c0 = (tile & 31) * 64;
        if (c0 != cwc0) { cwc0 = c0;
#pragma unroll
            for (int q = 0; q < 8; ++q) { const int cc = c0 + (tid & 7) * 8 + q; wa[q] = cw[cc]; wb[q] = cw[6144 + cc]; wc_[q] = cw[12288 + cc]; wd[q] = cb[cc]; }
            const int c1 = 2048 + c0 + (tid >> 3), c2 = 4096 + c0 + (tid >> 3);
            p0 = cw[c1]; p1 = cw[6144 + c1]; p2 = cw[12288 + c1]; pb = cb[c1]; q0 = cw[c2]; q1 = cw[6144 + c2]; q2 = cw[12288 + c2]; qb = cb[c2]; }
        __syncthreads();
#pragma unroll
        for (int it = 0; it < 4; ++it) { const int id = tid + NTHR * it;
            if (id < 3 * 66 * 8) { const int g = id / 528, r = id - g * 528, row = r >> 3, ch = r & 7; const u32x4 v = pv[it];
                const int tr = t0 - 1 + row; const float mk = (tr >= 0 && tr < T) ? 1.f : 0.f;
                LAS float* dp = sm + (g * 66 + row) * 65 + ch * 8;
                dp[0] = bf_lo(v.x) * mk; dp[1] = bf_hi(v.x) * mk; dp[2] = bf_lo(v.y) * mk; dp[3] = bf_hi(v.y) * mk; dp[4] = bf_lo(v.z) * mk; dp[5] = bf_hi(v.z) * mk; dp[6] = bf_lo(v.w) * mk; dp[7] = bf_hi(v.w) * mk; } }
        if (tile + G < 4096) HC_LOAD(tile + G, pv);
        __syncthreads();
        {   const int t = tid >> 3, ch = tid & 7; float o[8];
#pragma unroll
            for (int q = 0; q < 8; ++q) { const int c = ch * 8 + q;
                o[q] = sm[t * 65 + c] * wa[q] + sm[(t + 1) * 65 + c] * wb[q] + sm[(t + 2) * 65 + c] * wc_[q] + wd[q]; }
            u32x4 w; w.x = cvt_pk_bf16(o[0], o[1]); w.y = cvt_pk_bf16(o[2], o[3]); w.z = cvt_pk_bf16(o[4], o[5]); w.w = cvt_pk_bf16(o[6], o[7]);
            *(u32x4*)(x0c + (size_t)(t0 + t) * D + c0 + ch * 8) = w; }
        {   const int c = tid >> 3, tc = tid & 7;
            float o[8];
#pragma unroll
            for (int q = 0; q < 8; ++q) { const int t = tc * 8 + q;
                const float x1 = sm[(66 + t) * 65 + c] * p0 + sm[(66 + t + 1) * 65 + c] * p1 + sm[(66 + t + 2) * 65 + c] * p2 + pb;
                const float vv = sm[(132 + t) * 65 + c] * q0 + sm[(132 + t + 1) * 65 + c] * q1 + sm[(132 + t + 2) * 65 + c] * q2 + qb;
                o[q] = x1 * vv; }
            u32x4 w; w.x = cvt_pk_bf16(o[0], o[1]); w.y = cvt_pk_bf16(o[2], o[3]); w.z = cvt_pk_bf16(o[4], o[5]); w.w = cvt_pk_bf16(o[6], o[7]);
            *(u32x4*)(vgT + (size_t)(c0 + c) * T + t0 + tc * 8) = w; }
    }
#undef HC_LOAD
    __syncthreads();
}

#define SEG_LD32(dst, off, base) asm volatile("global_load_dword %0, %1, %2" : "=v"(dst) : "v"(off), "s"(base) : "memory")
#define SEG_LD64(dst, off, base) asm volatile("global_load_dwordx2 %0, %1, %2" : "=v"(dst) : "v"(off), "s"(base) : "memory")
#define SEG_WAIT() asm volatile("s_waitcnt vmcnt(32)\n\ts_nop 7" ::: "memory")
#define SEG_TIE8(a, o) "+v"(a[o + 0]), "+v"(a[o + 1]), "+v"(a[o + 2]), "+v"(a[o + 3]), "+v"(a[o + 4]), "+v"(a[o + 5]), "+v"(a[o + 6]), "+v"(a[o + 7])
constexpr int GS_LD = 8256;
__device__ __forceinline__ void hy_fft_phase(LAS unsigned char* lds, int bid, int G, const bf16_t* vgT, bf16_t* zT, const float* a3, const float* wout, const float* skip, float* filt, float4* gspec) {
    LAS cf2* z = (LAS cf2*)lds;
    bf16_t* F = (bf16_t*)filt + (size_t)bid * 8 * FN;
    u32x2* GS = (u32x2*)gspec + (size_t)bid * GS_LD;
    BgState bg; bg.st = 0; const int bgNW = G * 8; int bgwg, bglane;
    { const int t0_ = tid_fresh(); bgwg = __builtin_amdgcn_readfirstlane(bid * 8 + (t0_ >> 6)); bglane = t0_ & 63; }
#define BG_BEGIN(ns) bg_issue<ns>(bg, bgwg, bgNW, bglane)
#define BG_END(ns) bg_finish<ns>(bg, bgwg, bgNW, bglane)
#define BG_I(x) bg_issue1<x>(bg, bgwg, bgNW, bglane)
#define BG_F(y) bg_finish1<y, 32>(bg)
    const int nch = (D - bid + G - 1) / G;
    for (int g0 = 0; g0 < nch; g0 += 8) {
#pragma unroll 1
        for (int rept_ = 0; rept_ < REP_TAP; ++rept_)
        {
            const int tid = tid_fresh(), lane = tid & 63, wave = tid >> 6, col = lane & 15, kc = lane >> 4;
            const int ci = g0 + (col >> 1), c = bid + G * ci; const bool cok = ci < nch;
            bf16x8 bw[2];
#pragma unroll
            for (int ks = 0; ks < 2; ++ks) { float wv[8];
#pragma unroll
                for (int q = 0; q < 8; ++q) wv[q] = wout[(size_t)(ks * 32 + kc * 8 + q) * 4096 + (col & 1) * D + (cok ? c : bid)] * (cok ? 1.f : 0.f);
                u32x4 w; w.x = cvt_pk_bf16(wv[0], wv[1]); w.y = cvt_pk_bf16(wv[2], wv[3]); w.z = cvt_pk_bf16(wv[4], wv[5]); w.w = cvt_pk_bf16(wv[6], wv[7]);
                bw[ks] = __builtin_bit_cast(bf16x8, w); }
            const float dlo = -15.350567286626973f, dhi = -3.0701134573253946f;
            const float delta = fabsf(dlo + (float)c * ((dhi - dlo) / (float)(D - 1)));
            __syncthreads();
            auto tap_load = [&](int blk, float4 (&av)[4]) {
                const float* ap = a3 + (size_t)(blk * 16 + col) * 64 + kc * 8;
                av[0] = *(const float4*)(ap); av[1] = *(const float4*)(ap + 4); av[2] = *(const float4*)(ap + 32); av[3] = *(const float4*)(ap + 36);
            };
            auto tap_blk = [&](int blk, const float4 (&av)[4]) {
                f32x4 acc = (f32x4){0.f, 0.f, 0.f, 0.f};
#pragma unroll
                for (int ks = 0; ks < 2; ++ks) { const float4 a0 = av[ks * 2], a1 = av[ks * 2 + 1];
                    u32x4 w; w.x = cvt_pk_bf16(a0.x, a0.y); w.y = cvt_pk_bf16(a0.z, a0.w); w.z = cvt_pk_bf16(a1.x, a1.y); w.w = cvt_pk_bf16(a1.z, a1.w);
                    acc = __builtin_amdgcn_mfma_f32_16x16x32_bf16(__builtin_bit_cast(bf16x8, w), bw[ks], acc, 0, 0, 0); }
                const int tb = blk * 16 + kc * 4;
                float4 o;
                o.x = acc[0] * expf(-((float)(tb + 0) / (float)(T - 1)) * delta); o.y = acc[1] * expf(-((float)(tb + 1) / (float)(T - 1)) * delta);
                o.z = acc[2] * expf(-((float)(tb + 2) / (float)(T - 1)) * delta); o.w = acc[3] * expf(-((float)(tb + 3) / (float)(T - 1)) * delta);
                bf16_t* Arow = F + (size_t)(col >> 1) * FN;
                if ((col & 1) == 0) { u32x2 w; w.x = cvt_pk_bf16(o.x, o.y); w.y = cvt_pk_bf16(o.z, o.w); *(u32x2*)(Arow + tb) = w; }
                else {
                    Arow[FN - tb - 3] = (bf16_t)(cvt_pk_bf16(o.w, 0.f) & 0xffffu);
                    *(unsigned*)(Arow + FN - tb - 2) = cvt_pk_bf16(o.z, o.y);
                    if (tb > 0) Arow[FN - tb] = (bf16_t)(cvt_pk_bf16(o.x, 0.f) & 0xffffu); else Arow[T] = (bf16_t)0;
                }
            };
            BG_I(0);
#pragma unroll 1
            for (int ob = 0; ob < 8; ob += 2) {
                BG_I(1);
#define TAP_GROUP(b0) do { float4 av_[4][4]; \
                    _Pragma("unroll") for (int bi = 0; bi < 4; ++bi) tap_load(wave + 8 * ((b0) + bi), av_[bi]); \
                    _Pragma("unroll") for (int bi = 0; bi < 4; ++bi) tap_blk(wave + 8 * ((b0) + bi), av_[bi]); } while (0)
                TAP_GROUP(ob * 8); TAP_GROUP(ob * 8 + 4);
                BG_F(0);
                BG_I(0);
                TAP_GROUP((ob + 1) * 8); TAP_GROUP((ob + 1) * 8 + 4);
#undef TAP_GROUP
                BG_F(1);
            }
            __syncthreads();
        }
        int tid = tid_fresh();
#define FFT_FWD_ALL() do { tid = tid_fresh(); BG_I(0); fft_r16_pass<false, 10>(z, tid); __syncthreads(); BG_F(1); BG_I(1); fft_r16_pass<false, 6>(z, tid); __syncthreads(); BG_F(0); BG_I(0); fft_r16_pass<false, 2>(z, tid); __syncthreads(); BG_F(1); BG_I(1); fft_r4_pass<false>(z, tid, NTHR); __syncthreads(); BG_F(0); } while (0)
        for (int ci = g0; ci < g0 + 8 && ci < nch; ci += 2) {
            const bool has2 = (ci + 1 < nch);
            const int c1 = bid + G * ci, c2 = has2 ? bid + G * (ci + 1) : c1;
            const bf16_t* A1 = F + (size_t)(ci - g0) * FN; const bf16_t* A2 = has2 ? A1 + FN : A1;
            const bf16_t* v1 = vgT + (size_t)c1 * T; const bf16_t* v2 = vgT + (size_t)c2 * T;
            __syncthreads();
#pragma unroll 1
            for (int rep_ = 0; rep_ < REP_F1; ++rep_) {
            tid = tid_fresh();
            {   unsigned pa[16], pb[16]; float sk[2];
                const float* skp = skip; asm volatile("" : "+s"(skp));
#pragma unroll
                for (int i = 0; i < 16; ++i) { const unsigned off = 4u * tid + 2048u * i; SEG_LD32(pa[i], off, A1); SEG_LD32(pb[i], off, A2); }
                { const unsigned o1 = 4u * c1, o2 = 4u * c2; SEG_LD32(sk[0], o1, skp); SEG_LD32(sk[1], o2, skp); }
                BG_I(1);
                SEG_WAIT(); asm volatile("" : SEG_TIE8(pa, 0), SEG_TIE8(pa, 8), SEG_TIE8(pb, 0) :: "memory");
                asm volatile("" : SEG_TIE8(pb, 8), "+v"(sk[0]), "+v"(sk[1]) :: "memory");
                const float sk1 = (tid == 0) ? sk[0] : 0.f, sk2 = (tid == 0 && has2) ? sk[1] : 0.f;
#pragma unroll
                for (int i = 0; i < 16; ++i) { const int n = 2 * tid + 2 * NTHR * i;
                    f32x4 fv = (f32x4){bf_lo(pa[i]), has2 ? bf_lo(pb[i]) : 0.f, bf_hi(pa[i]), has2 ? bf_hi(pb[i]) : 0.f};
                    if (i == 0) { fv[0] += sk1; fv[1] += sk2; }
                    *(LAS f32x4*)&z[PADI(n)] = fv; }
                BG_F(0);
            }
            __syncthreads();
            FFT_FWD_ALL();
            tid = tid_fresh();
            BG_I(0);
#pragma unroll 4
            for (int k = tid; k <= FN / 2; k += NTHR) {
                const cf2 zk = z[PADI(fpos(k))], zm = z[PADI(fpos((FN - k) & (FN - 1)))];
                u32x2 g; g.x = cvt_pk_bf16(0.5f * (zk.x + zm.x), 0.5f * (zk.y - zm.y)); g.y = cvt_pk_bf16(0.5f * (zk.y + zm.y), -0.5f * (zk.x - zm.x)); GS[k] = g;
            }
            BG_F(1);
            __syncthreads();
            }
            tid = tid_fresh();
            {   unsigned pa[8], pb[8];
#pragma unroll
                for (int i = 0; i < 8; ++i) { const unsigned off = 4u * tid + 2048u * i; SEG_LD32(pa[i], off, v1); SEG_LD32(pb[i], off, v2); }
                BG_I(1);
                SEG_WAIT(); asm volatile("" : SEG_TIE8(pa, 0), SEG_TIE8(pb, 0) :: "memory");
#pragma unroll
                for (int i = 0; i < 8; ++i) { const int n = 2 * tid + 2 * NTHR * i;
                    *(LAS f32x4*)&z[PADI(n)] = (f32x4){bf_lo(pa[i]), has2 ? bf_lo(pb[i]) : 0.f, bf_hi(pa[i]), has2 ? bf_hi(pb[i]) : 0.f};
                    *(LAS f32x4*)&z[PADI(T + n)] = (f32x4){0.f, 0.f, 0.f, 0.f}; }
                BG_F(0);
            }
            __syncthreads();
            FFT_FWD_ALL();
            tid = tid_fresh();
            {   u32x2 gq[16], gh;
#pragma unroll
                for (int i = 0; i < 16; ++i) { const unsigned off = 8u * tid + 4096u * i; SEG_LD64(gq[i], off, GS); }
                { const unsigned off = 8u * (FN / 2); SEG_LD64(gh, off, GS); }
                BG_I(0);
                SEG_WAIT(); asm volatile("" : SEG_TIE8(gq, 0), SEG_TIE8(gq, 8), "+v"(gh) :: "memory");
#pragma unroll
                for (int i = 0; i < 16; ++i) { const int k = tid + NTHR * i;
                    const int p1 = PADI(fpos(k)), p2 = PADI(fpos((FN - k) & (FN - 1)));
                    const cf2 zk = z[p1], zm = z[p2];
                    const cf2 V1 = mk2(0.5f * (zk.x + zm.x), 0.5f * (zk.y - zm.y)), V2 = mk2(0.5f * (zk.y + zm.y), -0.5f * (zk.x - zm.x));
                    const cf2 Y1 = cmul(V1, mk2(bf_lo(gq[i].x), bf_hi(gq[i].x))), Y2 = cmul(V2, mk2(bf_lo(gq[i].y), bf_hi(gq[i].y)));
                    z[p1] = mk2(Y1.x - Y2.y, Y1.y + Y2.x); z[p2] = mk2(Y1.x + Y2.y, Y2.x - Y1.y); }
                if (tid == 0) { const int k = FN / 2, p1 = PADI(fpos(k)); const cf2 zk = z[p1]; const float4 g1 = make_float4(bf_lo(gh.x), bf_hi(gh.x), bf_lo(gh.y), bf_hi(gh.y));
                    z[p1] = mk2(zk.x * g1.x, zk.y * g1.z); }
                BG_F(1);
            }
            __syncthreads();
            tid = tid_fresh();
            BG_I(1); fft_r4_pass<true>(z, tid, NTHR); __syncthreads(); BG_F(0);
            BG_I(0); fft_r16_pass<true, 2>(z, tid); __syncthreads(); BG_F(1); BG_I(1); fft_r16_pass<true, 6>(z, tid); __syncthreads(); BG_F(0); BG_I(0); fft_r16_pass<true, 10>(z, tid); __syncthreads(); BG_F(1);
            tid = tid_fresh();
            bf16_t* o1 = zT + (size_t)c1 * T; bf16_t* o2 = zT + (size_t)c2 * T;

            {
#pragma unroll
                for (int i = 0; i < 8; ++i) { const int n = 2 * tid + 2 * NTHR * i; const f32x4 y = *(const LAS f32x4*)&z[PADI(n)];
                    *(unsigned*)(o1 + n) = cvt_pk_bf16(y[0] * (1.f / (float)FN), y[2] * (1.f / (float)FN));
                    if (has2) *(unsigned*)(o2 + n) = cvt_pk_bf16(y[1] * (1.f / (float)FN), y[3] * (1.f / (float)FN)); }
            }

        }
        bg_finish1<0, 0>(bg);
#undef FFT_FWD_ALL
    }
    { const int nst = (BG_STEPS + bgNW - 1) / bgNW;
#pragma unroll 1
      while (bg.st < nst) { BG_BEGIN(2); BG_END(2); } }
#undef BG_BEGIN
#undef BG_END
#undef BG_I
#undef BG_F
    __syncthreads();
}

__device__ __forceinline__ void hy_tr_phase(LAS unsigned char* lds, int bid, int G, const bf16_t* zT, const bf16_t* x0c, bf16_t* yA) {
    LAS float* sm = (LAS float*)lds;
    const int tid = tid_fresh();
    const int c = tid >> 3, tc = tid & 7, t = tid >> 3, ch = tid & 7;
#define HT_LOAD(tile_) do { const int t0_ = ((tile_) >> 5) * 64, c0_ = ((tile_) & 31) * 64; pz = *(const u32x4*)(zT + (size_t)(c0_ + c) * T + t0_ + tc * 8); px = *(const u32x4*)(x0c + (size_t)(t0_ + t) * D + c0_ + ch * 8); } while (0)
    u32x4 pz = (u32x4){0u, 0u, 0u, 0u}, px = (u32x4){0u, 0u, 0u, 0u};
    if (bid < 4096) HT_LOAD(bid);
    for (int tile = bid; tile < 4096; tile += G) {
        const int t0 = (tile >> 5) * 64, c0 = (tile & 31) * 64;
        __syncthreads();
        {   LAS float* dp = sm + c * 65 + tc * 8; dp[0] = bf_lo(pz.x); dp[1] = bf_hi(pz.x); dp[2] = bf_lo(pz.y); dp[3] = bf_hi(pz.y); dp[4] = bf_lo(pz.z); dp[5] = bf_hi(pz.z); dp[6] = bf_lo(pz.w); dp[7] = bf_hi(pz.w); }
        const u32x4 xv = px;
        if (tile + G < 4096) HT_LOAD(tile + G);
        __syncthreads();
        {   const size_t off = (size_t)(t0 + t) * D + c0 + ch * 8;
            const LAS float* sp = sm + (ch * 8) * 65 + t;
            u32x4 w; w.x = cvt_pk_bf16(sp[0] * bf_lo(xv.x), sp[65] * bf_hi(xv.x)); w.y = cvt_pk_bf16(sp[130] * bf_lo(xv.y), sp[195] * bf_hi(xv.y));
            w.z = cvt_pk_bf16(sp[260] * bf_lo(xv.z), sp[325] * bf_hi(xv.z)); w.w = cvt_pk_bf16(sp[390] * bf_lo(xv.w), sp[455] * bf_hi(xv.w));
            *(u32x4*)(yA + off) = w; }
    }
#undef HT_LOAD
    __syncthreads();
}

constexpr size_t BIG_GATES = (size_t)283115520;
constexpr size_t BIG_SLOC  = BIG_VGT;
constexpr size_t BIG_ZLOC  = BIG_SLOC + (size_t)2 * 8 * 32 * 256 * 128 * 4;
constexpr size_t BIG_GTOT  = BIG_ZLOC + (size_t)2 * 8 * 32 * 128 * 4;
constexpr int MLC = 256, MLNC = T / MLC;
typedef float f32x4v __attribute__((ext_vector_type(4)));

__device__ __forceinline__ float logsigf(float x) { return fminf(x, 0.f) - log1pf(expf(-fabsf(x))); }

__device__ __forceinline__ void ml_norm_gates_phase(LAS unsigned char* lds, int bid, int G, const float* x, const float* g, const float* sc, const float* sh,
                                                    const float* w_in, const float* gate_b, bf16_t* hbuf, float* gates) {
    LAS float* hfs = (LAS float*)lds;
    LAS float* part = (LAS float*)lds;
    const int tid = tid_fresh();
    const int lane = tid & 63, wave = tid >> 6;
    for (int r0 = bid * 16; r0 < T; r0 += G * 16) {
        __syncthreads();
#pragma unroll 1
        for (int rr = 0; rr < 2; ++rr) {
            const int row = r0 + wave * 2 + rr;
            float4 v[8];
#pragma unroll
            for (int i = 0; i < 8; ++i) v[i] = *(const float4*)(x + (size_t)row * D + (lane + 64 * i) * 4);
            row_norm_mod(v, lane, g, sc, sh);
#pragma unroll
            for (int i = 0; i < 8; ++i) { const int c = (lane + 64 * i) * 4;
                u32x2 w; w.x = cvt_pk_bf16(v[i].x, v[i].y); w.y = cvt_pk_bf16(v[i].z, v[i].w); *(u32x2*)(hbuf + (size_t)row * D + c) = w;
                LAS float* hp = hfs + (wave * 2 + rr) * HFS_LD + c; hp[0] = v[i].x; hp[1] = v[i].y; hp[2] = v[i].z; hp[3] = v[i].w; }
        }
        __syncthreads();
        f32x4 acc[2];
        rows16_matmul<2>(hfs, w_in, 6176, 6144, wave, lane, acc);
        __syncthreads();
#pragma unroll
        for (int jt = 0; jt < 2; ++jt)
#pragma unroll
            for (int r = 0; r < 4; ++r) part[(wave * 16 + (lane >> 4) * 4 + r) * 32 + jt * 16 + (lane & 15)] = acc[jt][r];
        __syncthreads();
        {   const int rl = wave * 2 + (lane >> 5), col = lane & 31;
            float sacc = gate_b[col];
#pragma unroll
            for (int w = 0; w < 8; ++w) sacc += part[(w * 16 + rl) * 32 + col];
            gates[(size_t)(r0 + rl) * 32 + col] = sacc; }
    }
    __syncthreads();
}

__device__ __forceinline__ void ml_conv8(const bf16_t* P, int t, int col, const float* cw, const float* cb, int cch, float scale, float (&o)[8]) {
    const u32x4 z4 = (u32x4){0u, 0u, 0u, 0u};
    const u32x4 v0 = *(const u32x4*)(P + (size_t)t * 6144 + col);
    const u32x4 vm = (t > 0) ? *(const u32x4*)(P + (size_t)(t - 1) * 6144 + col) : z4;
    const u32x4 vp = (t < T - 1) ? *(const u32x4*)(P + (size_t)(t + 1) * 6144 + col) : z4;
    const float m[8] = {bf_lo(vm.x), bf_hi(vm.x), bf_lo(vm.y), bf_hi(vm.y), bf_lo(vm.z), bf_hi(vm.z), bf_lo(vm.w), bf_hi(vm.w)};
    const float c[8] = {bf_lo(v0.x), bf_hi(v0.x), bf_lo(v0.y), bf_hi(v0.y), bf_lo(v0.z), bf_hi(v0.z), bf_lo(v0.w), bf_hi(v0.w)};
    const float p[8] = {bf_lo(vp.x), bf_hi(vp.x), bf_lo(vp.y), bf_hi(vp.y), bf_lo(vp.z), bf_hi(vp.z), bf_lo(vp.w), bf_hi(vp.w)};
#pragma unroll
    for (int q = 0; q < 8; ++q) { const float xv = cw[cch + q] * m[q] + cw[2048 + cch + q] * c[q] + cw[4096 + cch + q] * p[q] + cb[cch + q]; o[q] = xv / (1.f + __expf(-xv)) * scale; }
}

struct Row3 { u32x4 vm, v0, vp; float fm, fp; };
__device__ __forceinline__ Row3 ml_load3(const bf16_t* P, int t, int col) {
    Row3 r;
    const int tm = t > 0 ? t - 1 : 0, tp = t < T - 1 ? t + 1 : T - 1;
    r.v0 = *(const u32x4*)(P + (size_t)t * 6144 + col);
    r.vm = *(const u32x4*)(P + (size_t)tm * 6144 + col);
    r.vp = *(const u32x4*)(P + (size_t)tp * 6144 + col);
    r.fm = t > 0 ? 1.f : 0.f; r.fp = t < T - 1 ? 1.f : 0.f;
    return r;
}
struct Cw8 { float4 a[8]; };
__device__ __forceinline__ Cw8 ml_cw_load(const float* cw, const float* cb, int cch) {
    Cw8 w;
#pragma unroll
    for (int k = 0; k < 3; ++k) { w.a[2 * k] = *(const float4*)(cw + k * 2048 + cch); w.a[2 * k + 1] = *(const float4*)(cw + k * 2048 + cch + 4); }
    w.a[6] = *(const float4*)(cb + cch); w.a[7] = *(const float4*)(cb + cch + 4);
    return w;
}
__device__ __forceinline__ void ml_conv8c(const Row3& r, const Cw8& w, float scale, float (&o)[8]) {
    const float m[8] = {bf_lo(r.vm.x), bf_hi(r.vm.x), bf_lo(r.vm.y), bf_hi(r.vm.y), bf_lo(r.vm.z), bf_hi(r.vm.z), bf_lo(r.vm.w), bf_hi(r.vm.w)};
    const float c[8] = {bf_lo(r.v0.x), bf_hi(r.v0.x), bf_lo(r.v0.y), bf_hi(r.v0.y), bf_lo(r.v0.z), bf_hi(r.v0.z), bf_lo(r.v0.w), bf_hi(r.v0.w)};
    const float p[8] = {bf_lo(r.vp.x), bf_hi(r.vp.x), bf_lo(r.vp.y), bf_hi(r.vp.y), bf_lo(r.vp.z), bf_hi(r.vp.z), bf_lo(r.vp.w), bf_hi(r.vp.w)};
    const float w0[8] = {w.a[0].x, w.a[0].y, w.a[0].z, w.a[0].w, w.a[1].x, w.a[1].y, w.a[1].z, w.a[1].w};
    const float w1[8] = {w.a[2].x, w.a[2].y, w.a[2].z, w.a[2].w, w.a[3].x, w.a[3].y, w.a[3].z, w.a[3].w};
    const float w2[8] = {w.a[4].x, w.a[4].y, w.a[4].z, w.a[4].w, w.a[5].x, w.a[5].y, w.a[5].z, w.a[5].w};
    const float wb[8] = {w.a[6].x, w.a[6].y, w.a[6].z, w.a[6].w, w.a[7].x, w.a[7].y, w.a[7].z, w.a[7].w};
#pragma unroll
    for (int q = 0; q < 8; ++q) { const float xv = (w0[q] * r.fm) * m[q] + w1[q] * c[q] + (w2[q] * r.fp) * p[q] + wb[q]; o[q] = xv / (1.f + __expf(-xv)) * scale; }
}

__device__ __forceinline__ void ml_chunk_gates(int tid, const float* gates, int h, int t0, LAS float* bf, LAS float* cbs, LAS float* gif, LAS float* gib, LAS float* tmpf, LAS float* tmpb) {
    const int lane = tid & 63, wave = tid >> 6;
    float p = 0.f, q = 0.f;
    if (tid < MLC) { const float* gp = gates + (size_t)(t0 + tid) * 32; gif[tid] = gp[h]; gib[tid] = gp[16 + h]; p = logsigf(gp[8 + h]); q = logsigf(gp[24 + h]);
#pragma unroll
        for (int o = 1; o < 64; o <<= 1) { const float v = __shfl_up(p, o); const float w = __shfl_down(q, o); if (lane >= o) p += v; if (lane + o < 64) q += w; }
        if (lane == 63) tmpf[wave] = p;
        if (lane == 0) tmpb[wave] = q; }
    __syncthreads();
    if (tid < MLC) { float ap = 0.f, aq = 0.f;
#pragma unroll
        for (int w = 0; w < 4; ++w) { if (w < wave) ap += tmpf[w]; if (w > wave) aq += tmpb[w]; }
        bf[tid] = p + ap; cbs[tid] = q + aq; }
    __syncthreads();
}

__device__ __forceinline__ void ml_state_phase(LAS unsigned char* lds, int bid, int G, const bf16_t* P, const float* gates, const float* cw, const float* cb, bf16_t* Sloc, float* zloc, float* Gtot) {
    LAS bf16_t* kw = (LAS bf16_t*)lds;
    LAS bf16_t* vT = (LAS bf16_t*)(lds + 36864);
    LAS float* bf = (LAS float*)(lds + 73728); LAS float* cbs = bf + 256; LAS float* gif = bf + 512; LAS float* gib = bf + 768; LAS float* wf = bf + 1024; LAS float* wb = bf + 1280;
    for (int u = bid; u < 8 * MLNC; u += G) {
        const int h = u / MLNC, n = u - h * MLNC, t0 = n * MLC;
        int tid = tid_fresh();
        __syncthreads();
        ml_chunk_gates(tid, gates, h, t0, bf, cbs, gif, gib, wf, wb);
        float Gf = bf[MLC - 1], Gb = cbs[0];
        __syncthreads();
        if (tid < MLC) { wf[tid] = expf(Gf - bf[tid] + gif[tid]); wb[tid] = expf(Gb - cbs[tid] + gib[tid]); }
        if (tid == 0) { Gtot[(0 * 8 + h) * MLNC + n] = Gf; Gtot[(1 * 8 + h) * MLNC + n] = Gb; }
        f32x4v acc[8][4];
#pragma unroll
        for (int m = 0; m < 8; ++m)
#pragma unroll
            for (int q = 0; q < 4; ++q) acc[m][q] = (f32x4v){0.f, 0.f, 0.f, 0.f};
        float zacc = 0.f;
#pragma unroll 1
        for (int sb = 0; sb < 4; ++sb) {
            __syncthreads();
            tid = tid_fresh();
            {
                Row3 rk[2]; u32x4 vv[4]; Cw8 cwk[2];
#pragma unroll
                for (int it = 0; it < 2; ++it) { const int item = tid + NTHR * it, sl = (item >> 2) & 63, dc = (item & 3) + 4 * (item >> 8);
                    cwk[it] = ml_cw_load(cw, cb, 1024 + h * 128 + dc * 8); rk[it] = ml_load3(P, t0 + sb * 64 + sl, 1024 + h * 128 + dc * 8); }
#pragma unroll
                for (int it = 0; it < 4; ++it) { const int item = tid + NTHR * it, sl = (item >> 2) & 63, ec = (item & 3) + 4 * (item >> 8);
                    vv[it] = *(const u32x4*)(P + (size_t)(t0 + sb * 64 + sl) * 6144 + 2048 + h * 256 + ec * 8); }
#pragma unroll
                for (int it = 0; it < 2; ++it) { const int item = tid + NTHR * it, sl = (item >> 2) & 63, dc = (item & 3) + 4 * (item >> 8), sc_ = sb * 64 + sl;
                    float o[8]; ml_conv8c(rk[it], cwk[it], 0.08838834764831845f, o);
                    const float w0 = wf[sc_], w1 = wb[sc_];
#pragma unroll
                    for (int q = 0; q < 8; ++q) { kw[(dc * 8 + q) * 72 + sl] = (bf16_t)(cvt_pk_bf16(o[q] * w0, 0.f) & 0xffffu); kw[(128 + dc * 8 + q) * 72 + sl] = (bf16_t)(cvt_pk_bf16(o[q] * w1, 0.f) & 0xffffu); } }
#pragma unroll
                for (int it = 0; it < 4; ++it) { const int item = tid + NTHR * it, sl = (item >> 2) & 63, ec = (item & 3) + 4 * (item >> 8); const u32x4 v4 = vv[it];
                    LAS bf16_t* vp = vT + (ec * 8) * 72 + sl;
                    vp[0] = (bf16_t)(v4.x & 0xffffu); vp[72] = (bf16_t)(v4.x >> 16); vp[144] = (bf16_t)(v4.y & 0xffffu); vp[216] = (bf16_t)(v4.y >> 16);
                    vp[288] = (bf16_t)(v4.z & 0xffffu); vp[360] = (bf16_t)(v4.z >> 16); vp[432] = (bf16_t)(v4.w & 0xffffu); vp[504] = (bf16_t)(v4.w >> 16); }
            }
            __syncthreads();
            tid = tid_fresh();
            const int lane = tid & 63, wave = __builtin_amdgcn_readfirstlane(tid >> 6), wr = wave >> 2, wc = wave & 3, fr = lane & 15, fq = lane >> 4;
            if (tid < 256) { const LAS bf16_t* kp = kw + tid * 72; float s = 0.f;
#pragma unroll 8
                for (int q = 0; q < 64; ++q) s += __uint_as_float((unsigned)kp[q] << 16);
                zacc += s; }
            __builtin_amdgcn_sched_barrier(0);
#pragma unroll
            for (int ks = 0; ks < 2; ++ks) {
                bf16x8 bfr[4];
#pragma unroll
                for (int q = 0; q < 4; ++q) bfr[q] = *(const LAS bf16x8*)(kw + (wc * 64 + q * 16 + fr) * 72 + ks * 32 + fq * 8);
#pragma unroll
                for (int m = 0; m < 8; ++m) { const bf16x8 afr = *(const LAS bf16x8*)(vT + (wr * 128 + m * 16 + fr) * 72 + ks * 32 + fq * 8);
#pragma unroll
                    for (int q = 0; q < 4; ++q) acc[m][q] = __builtin_amdgcn_mfma_f32_16x16x32_bf16(bfr[q], afr, acc[m][q], 0, 0, 0);
                    if (m & 1) __builtin_amdgcn_sched_barrier(0); }
            }
        }
        tid = tid_fresh();
        const int lane = tid & 63, wave = __builtin_amdgcn_readfirstlane(tid >> 6), wr = wave >> 2, wc = wave & 3, fr = lane & 15, fq = lane >> 4;
#pragma unroll
        for (int m = 0; m < 8; ++m)
#pragma unroll
            for (int q = 0; q < 4; ++q) { const int c = wc * 64 + q * 16 + fq * 4, dir = c >> 7, d = c & 127, e = wr * 128 + m * 16 + fr;
                u32x2 w; w.x = cvt_pk_bf16(acc[m][q][0], acc[m][q][1]); w.y = cvt_pk_bf16(acc[m][q][2], acc[m][q][3]);
                *(u32x2*)(Sloc + ((((size_t)dir * 8 + h) * MLNC + n) * 256 + e) * 128 + d) = w;
                __builtin_amdgcn_sched_barrier(0); }
        if (tid < 256) zloc[(((size_t)(tid >> 7) * 8 + h) * MLNC + n) * 128 + (tid & 127)] = zacc;
    }
    __syncthreads();
}

__device__ __forceinline__ void ml_scan_phase(int bid, int G, bf16_t* Sloc, float* zloc, const float* Gtot) {
    const int tid = tid_fresh();
    for (int item = bid * NTHR + tid; item < 16 * 8192; item += G * NTHR) {
        const int dh = __builtin_amdgcn_readfirstlane(item >> 13), r = item & 8191, dir = dh >> 3;
        const float* gp = Gtot + dh * MLNC;
        bf16_t* base = Sloc + (size_t)dh * MLNC * 32768 + (size_t)r * 4;
        u32x2 loc[MLNC];
#pragma unroll
        for (int step = 0; step < MLNC; ++step) { const int n = dir ? (MLNC - 1 - step) : step; loc[step] = *(const u32x2*)(base + (size_t)n * 32768); }
        float dcy[MLNC];
#pragma unroll
        for (int step = 0; step < MLNC; ++step) { const int n = dir ? (MLNC - 1 - step) : step; dcy[step] = gp[n]; }
        float s0 = 0.f, s1 = 0.f, s2 = 0.f, s3 = 0.f;
#pragma unroll
        for (int step = 0; step < MLNC; ++step) { const int n = dir ? (MLNC - 1 - step) : step;
            u32x2 w; w.x = cvt_pk_bf16(s0, s1); w.y = cvt_pk_bf16(s2, s3); *(u32x2*)(base + (size_t)n * 32768) = w;
            const float dec = expf(dcy[step]);
            s0 = dec * s0 + bf_lo(loc[step].x); s1 = dec * s1 + bf_hi(loc[step].x); s2 = dec * s2 + bf_lo(loc[step].y); s3 = dec * s3 + bf_hi(loc[step].y); }
    }
    for (int item = bid * NTHR + tid; item < 16 * 128; item += G * NTHR) {
        const int dh = __builtin_amdgcn_readfirstlane(item >> 7), r = item & 127, dir = dh >> 3;
        const float* gp = Gtot + dh * MLNC;
        float* base = zloc + (size_t)dh * MLNC * 128 + r;
        float loc[MLNC];
#pragma unroll
        for (int step = 0; step < MLNC; ++step) { const int n = dir ? (MLNC - 1 - step) : step; loc[step] = base[(size_t)n * 128]; }
        float dcy[MLNC];
#pragma unroll
        for (int step = 0; step < MLNC; ++step) { const int n = dir ? (MLNC - 1 - step) : step; dcy[step] = gp[n]; }
        float st = 0.f;
#pragma unroll
        for (int step = 0; step < MLNC; ++step) { const int n = dir ? (MLNC - 1 - step) : step; base[(size_t)n * 128] = st; st = expf(dcy[step]) * st + loc[step]; }
    }
}

__device__ __forceinline__ void ml_out_phase(LAS unsigned char* lds, int bid, int G, const bf16_t* P, const float* gates, const float* cw, const float* cb,
                                             const bf16_t* Sst, const float* zst, const float* head_g, bf16_t* hs) {
    LAS bf16_t* Q  = (LAS bf16_t*)lds;
    LAS bf16_t* ST = (LAS bf16_t*)(lds + 34816);
    LAS bf16_t* Kb = (LAS bf16_t*)(lds + 34816);
    LAS bf16_t* VT = (LAS bf16_t*)(lds + 34816 + 17408);
    LAS bf16_t* PW = (LAS bf16_t*)(lds + 104448);
    LAS float* bf = (LAS float*)(lds + 122880); LAS float* cbs = bf + 256; LAS float* gif = bf + 512; LAS float* gib = bf + 768;
    LAS float* zs = bf + 1024;
    LAS float* tmp = bf + 1280;
#define ML_IDS() tid = tid_fresh(); const int lane = tid & 63, wave = __builtin_amdgcn_readfirstlane(tid >> 6), fr = lane & 15, fq = lane >> 4; const int trel = half * 128 + wave * 16 + fr; LAS bf16_t* pw = PW + wave * 16 * 72; (void)pw; (void)fq; (void)trel
    for (int u = bid; u < 8 * MLNC * 2; u += G) {
        const int half = u & 1, hn = u >> 1, h = hn / MLNC, n = hn - h * MLNC, t0 = n * MLC;
        int tid = tid_fresh();
        __syncthreads();
        ml_chunk_gates(tid, gates, h, t0, bf, cbs, gif, gib, tmp, tmp + 256);
        {   const int dc = tid & 15, tlb = tid >> 4;
            const Cw8 cwq = ml_cw_load(cw, cb, h * 128 + dc * 8);
            Row3 rq[4];
#pragma unroll
            for (int it = 0; it < 4; ++it) rq[it] = ml_load3(P, t0 + half * 128 + tlb + 32 * it, h * 128 + dc * 8);
#pragma unroll
            for (int it = 0; it < 4; ++it) { float o[8]; ml_conv8c(rq[it], cwq, 1.f, o);
                u32x4 w; w.x = cvt_pk_bf16(o[0], o[1]); w.y = cvt_pk_bf16(o[2], o[3]); w.z = cvt_pk_bf16(o[4], o[5]); w.w = cvt_pk_bf16(o[6], o[7]);
                *(LAS u32x4*)(Q + (tlb + 32 * it) * 136 + dc * 8) = w; }
        }
        f32x4v accf[16], accb[16];
#pragma unroll
        for (int q = 0; q < 16; ++q) { accf[q] = (f32x4v){0.f, 0.f, 0.f, 0.f}; accb[q] = (f32x4v){0.f, 0.f, 0.f, 0.f}; }
        Row3 rk[2]; u32x4 vv[4];
#define ML_LOADKV(sbx) do { const int t_ = tid_fresh(); const int dc_ = t_ & 15, slb_ = t_ >> 4; \
            _Pragma("unroll") for (int it = 0; it < 2; ++it) rk[it] = ml_load3(P, t0 + (sbx) * 64 + slb_ + 32 * it, 1024 + h * 128 + dc_ * 8); \
            _Pragma("unroll") for (int it = 0; it < 4; ++it) { const int item = t_ + NTHR * it, sl = (item >> 2) & 63, ec = (item & 3) + 4 * (item >> 8); \
                vv[it] = *(const u32x4*)(P + (size_t)(t0 + (sbx) * 64 + sl) * 6144 + 2048 + h * 256 + ec * 8); } } while (0)
        u32x4 sv[8];
#define ML_LOADS(dirx) do { const int t_ = tid_fresh(); const bf16_t* Sp = Sst + (((size_t)(dirx) * 8 + h) * MLNC + n) * 32768; \
            _Pragma("unroll") for (int it = 0; it < 8; ++it) { const int item = t_ + NTHR * it, e = item >> 4, dc_ = item & 15; sv[it] = *(const u32x4*)(Sp + (size_t)e * 128 + dc_ * 8); } } while (0)
        ML_LOADS(0);
#pragma unroll
        for (int dir = 0; dir < 2; ++dir) {
            __syncthreads();
            tid = tid_fresh();
#pragma unroll
            for (int it = 0; it < 8; ++it) { const int item = tid + NTHR * it, e = item >> 4, dc = item & 15; *(LAS u32x4*)(ST + e * 136 + dc * 8) = sv[it]; }
            if (tid < 128) zs[dir * 128 + tid] = zst[(((size_t)dir * 8 + h) * MLNC + n) * 128 + tid];
            __syncthreads();
            if (dir == 0) ML_LOADS(1); else ML_LOADKV(0);
            ML_IDS();
#pragma unroll 1
            for (int ks = 0; ks < 4; ++ks) {
                const bf16x8 qf = *(const LAS bf16x8*)(Q + (wave * 16 + fr) * 136 + ks * 32 + fq * 8);
#pragma unroll
                for (int q = 0; q < 16; ++q) { const bf16x8 sf = *(const LAS bf16x8*)(ST + (q * 16 + fr) * 136 + ks * 32 + fq * 8);
                    if (dir == 0) accf[q] = __builtin_amdgcn_mfma_f32_16x16x32_bf16(sf, qf, accf[q], 0, 0, 0);
                    else accb[q] = __builtin_amdgcn_mfma_f32_16x16x32_bf16(sf, qf, accb[q], 0, 0, 0);
                    if ((q & 3) == 3) __builtin_amdgcn_sched_barrier(0); }
            }
        }
        float denf, denb;
        {   ML_IDS();
            const float ebf = expf(bf[trel]), ebb = expf(cbs[trel]);
#pragma unroll
            for (int q = 0; q < 16; ++q) { accf[q] *= ebf; accb[q] *= ebb; }
            float pf = 0.f, pb = 0.f; const LAS bf16_t* qp = Q + (wave * 16 + fr) * 136 + fq * 32;
#pragma unroll 8
            for (int d = 0; d < 32; ++d) { const float qv = __uint_as_float((unsigned)qp[d] << 16); pf += qv * zs[fq * 32 + d]; pb += qv * zs[128 + fq * 32 + d]; }
            pf += __shfl_xor(pf, 16); pf += __shfl_xor(pf, 32); pb += __shfl_xor(pb, 16); pb += __shfl_xor(pb, 32);
            denf = ebf * pf; denb = ebb * pb; }
        float sumf = 0.f, sumb = 0.f;
#pragma unroll 1
        for (int sb = 0; sb < 4; ++sb) {
            const bool need_f = (sb * 64 <= half * 128 + 127), need_b = (sb * 64 + 63 >= half * 128);
            __syncthreads();
            tid = tid_fresh();
            {   const int dc = tid & 15, slb = tid >> 4;
                const Cw8 cwk = ml_cw_load(cw, cb, 1024 + h * 128 + dc * 8);
#pragma unroll
                for (int it = 0; it < 2; ++it) { float o[8]; ml_conv8c(rk[it], cwk, 0.08838834764831845f, o);
                    u32x4 w; w.x = cvt_pk_bf16(o[0], o[1]); w.y = cvt_pk_bf16(o[2], o[3]); w.z = cvt_pk_bf16(o[4], o[5]); w.w = cvt_pk_bf16(o[6], o[7]);
                    *(LAS u32x4*)(Kb + (slb + 32 * it) * 136 + dc * 8) = w; }
#pragma unroll
                for (int it = 0; it < 4; ++it) { const int item = tid + NTHR * it, sl = (item >> 2) & 63, ec = (item & 3) + 4 * (item >> 8); const u32x4 v4 = vv[it];
                    LAS bf16_t* vp = VT + (ec * 8) * 72 + sl;
                    vp[0] = (bf16_t)(v4.x & 0xffffu); vp[72] = (bf16_t)(v4.x >> 16); vp[144] = (bf16_t)(v4.y & 0xffffu); vp[216] = (bf16_t)(v4.y >> 16);
                    vp[288] = (bf16_t)(v4.z & 0xffffu); vp[360] = (bf16_t)(v4.z >> 16); vp[432] = (bf16_t)(v4.w & 0xffffu); vp[504] = (bf16_t)(v4.w >> 16); }
            }
            __syncthreads();
            if (sb < 3) ML_LOADKV(sb + 1);
            ML_IDS();
            f32x4v sc[4];
#pragma unroll
            for (int st = 0; st < 4; ++st) sc[st] = (f32x4v){0.f, 0.f, 0.f, 0.f};
#pragma unroll
            for (int ks = 0; ks < 4; ++ks) {
                const bf16x8 qf = *(const LAS bf16x8*)(Q + (wave * 16 + fr) * 136 + ks * 32 + fq * 8);
#pragma unroll
                for (int st = 0; st < 4; ++st) { const bf16x8 kf = *(const LAS bf16x8*)(Kb + (st * 16 + fr) * 136 + ks * 32 + fq * 8);
                    sc[st] = __builtin_amdgcn_mfma_f32_16x16x32_bf16(kf, qf, sc[st], 0, 0, 0); }
            }
#pragma unroll
            for (int dir = 0; dir < 2; ++dir) {
                if (dir == 0 ? !need_f : !need_b) continue;
                const float bt = dir == 0 ? bf[trel] : cbs[trel];
#pragma unroll
                for (int st = 0; st < 4; ++st) { float pv[4];
#pragma unroll
                    for (int r = 0; r < 4; ++r) { const int srel = sb * 64 + st * 16 + fq * 4 + r;
                        const float bs = dir == 0 ? bf[srel] : cbs[srel], gi = dir == 0 ? gif[srel] : gib[srel];
                        const bool ok = dir == 0 ? (srel <= trel) : (srel >= trel);
                        pv[r] = ok ? __expf(bt - bs + gi) * sc[st][r] : 0.f;
                        if (dir == 0) sumf += pv[r]; else sumb += pv[r]; }
                    u32x2 w; w.x = cvt_pk_bf16(pv[0], pv[1]); w.y = cvt_pk_bf16(pv[2], pv[3]);
                    *(LAS u32x2*)(pw + fr * 72 + st * 16 + fq * 4) = w; }
#pragma unroll 1
                for (int ks = 0; ks < 2; ++ks) {
                    const bf16x8 pf = *(const LAS bf16x8*)(pw + fr * 72 + ks * 32 + fq * 8);
#pragma unroll
                    for (int q = 0; q < 16; ++q) { const bf16x8 vf = *(const LAS bf16x8*)(VT + (q * 16 + fr) * 72 + ks * 32 + fq * 8);
                        if (dir == 0) accf[q] = __builtin_amdgcn_mfma_f32_16x16x32_bf16(vf, pf, accf[q], 0, 0, 0);
                        else accb[q] = __builtin_amdgcn_mfma_f32_16x16x32_bf16(vf, pf, accb[q], 0, 0, 0);
                        if ((q & 3) == 3) __builtin_amdgcn_sched_barrier(0); }
                }
            }
        }
        ML_IDS();
        sumf += __shfl_xor(sumf, 16); sumf += __shfl_xor(sumf, 32); sumb += __shfl_xor(sumb, 16); sumb += __shfl_xor(sumb, 32);
        const float invf = 1.f / fmaxf(fabsf(denf + sumf), 1.f), invb = 1.f / fmaxf(fabsf(denb + sumb), 1.f);
        float ss = 0.f;
#pragma unroll
        for (int q = 0; q < 16; ++q) { accf[q] = accf[q] * invf + accb[q] * invb; ss += accf[q][0] * accf[q][0] + accf[q][1] * accf[q][1] + accf[q][2] * accf[q][2] + accf[q][3] * accf[q][3]; }
        ss += __shfl_xor(ss, 16); ss += __shfl_xor(ss, 32);
        const float rn = rsqrtf(ss * (1.f / 256.f) + EPS);
        const size_t tabs = (size_t)t0 + trel;
#pragma unroll
        for (int qb = 0; qb < 16; qb += 8) {
            u32x2 ovv[8]; float4 hgv[8];
#pragma unroll
            for (int qq = 0; qq < 8; ++qq) { const int e = (qb + qq) * 16 + fq * 4; ovv[qq] = *(const u32x2*)(P + tabs * 6144 + 4096 + h * 256 + e); hgv[qq] = *(const float4*)(head_g + h * 256 + e); }
#pragma unroll
            for (int qq = 0; qq < 8; ++qq) { const int q = qb + qq, e = q * 16 + fq * 4; const u32x2 ov = ovv[qq]; const float4 hg = hgv[qq];
                const float o0 = bf_lo(ov.x), o1 = bf_hi(ov.x), o2 = bf_lo(ov.y), o3 = bf_hi(ov.y);
                const float r0 = accf[q][0] * rn * hg.x / (1.f + __expf(-o0)), r1 = accf[q][1] * rn * hg.y / (1.f + __expf(-o1)), r2 = accf[q][2] * rn * hg.z / (1.f + __expf(-o2)), r3 = accf[q][3] * rn * hg.w / (1.f + __expf(-o3));
                u32x2 w; w.x = cvt_pk_bf16(r0, r1); w.y = cvt_pk_bf16(r2, r3);
                *(u32x2*)(hs + tabs * D + h * 256 + e) = w; }
            __builtin_amdgcn_sched_barrier(0); }
    }
    __syncthreads();
#undef ML_IDS
}

__device__ __forceinline__ void norm_phase(int bid, int G, const float* x, const float* g, const float* sc, const float* sh, bf16_t* hbuf) {
    const int tid = tid_fresh(), lane = tid & 63, wave = tid >> 6;
    for (int row = bid * 8 + wave; row < T; row += G * 8) {
        float4 v[8];
#pragma unroll
        for (int i = 0; i < 8; ++i) v[i] = *(const float4*)(x + (size_t)row * D + (lane + 64 * i) * 4);
        row_norm_mod(v, lane, g, sc, sh);
#pragma unroll
        for (int i = 0; i < 8; ++i) { u32x2 w; w.x = cvt_pk_bf16(v[i].x, v[i].y); w.y = cvt_pk_bf16(v[i].z, v[i].w); *(u32x2*)(hbuf + (size_t)row * D + (lane + 64 * i) * 4) = w; }
    }
}

template <int L>
__device__ __forceinline__ void moe_layer(LAS unsigned char* lds, const XcdBarrier& bar, int bid, int G, int vcu, const float* xcur, float* xout) {
    {
        KP kp = kparams(); unsigned char* ws = kp->ws; const float* adl = (const float*)(ws + WS_ADA) + L * 12288;
        route_phase(lds, bid, G, xcur, kp->in[5] + L * D, adl + 4 * D, adl + 3 * D, kp->in[25] + (size_t)L * D * NE, kp->in[26] + L * NE,
                    (bf16_t*)(ws + WS_HBUF), (int*)(ws + WS_CTL + CTL_CNT) + L * 64, (int*)(ws + WS_LIST), (u32x2*)(ws + WS_REC));
    }
    xcd_barrier(bar);
    int ntiles;
    { KP kp = kparams(); ntiles = moe_tables(lds, (int*)(kp->ws + WS_CTL + CTL_CNT) + L * 64); }
    {
        KP kp = kparams(); unsigned char* ws = kp->ws;
        MoeGuOrder S{(const bf16_t*)(ws + WS_HBUF), (const bf16_t*)(ws + WS_WGU) + L * WGU_L, (const int*)(ws + WS_LIST), (const LAS int*)(lds + LDS_TSTART), (const LAS int*)(lds + LDS_TILEE), (const LAS int*)(lds + LDS_CNT), ntiles, G, vcu};
        EpiSwiglu E{(bf16_t*)(ws + WS_H)};
        _Pragma("unroll 1") for (int rep_ = 0; rep_ < REP_GEMM; ++rep_) gemm_phase<EpiSwiglu, MoeGuOrder>(lds, D, S, E);
    }
    xcd_barrier(bar);
    {
        KP kp = kparams(); unsigned char* ws = kp->ws;
        MoeDownOrder S{(const bf16_t*)(ws + WS_H), (const bf16_t*)(ws + WS_WD) + L * WD_L, (const LAS int*)(lds + LDS_TSTART), (const LAS int*)(lds + LDS_TILEE), ntiles, G, vcu};
        EpiF8 E{(unsigned char*)(ws + WS_BIG), D, Y8_SCALE};
        _Pragma("unroll 1") for (int rep_ = 0; rep_ < REP_GEMM; ++rep_) gemm_phase<EpiF8, MoeDownOrder>(lds, FF, S, E);
    }
    xcd_barrier(bar);
    {
        KP kp = kparams(); unsigned char* ws = kp->ws; const float* adl = (const float*)(ws + WS_ADA) + L * 12288;
#pragma unroll 1
        for (int rep_ = 0; rep_ < REP_COMB; ++rep_)
        if (L == 0) combine_phase<0>(lds, bid, G, xcur, adl + 5 * D, (const bf16_t*)(ws + WS_BIG), (const u32x2*)(ws + WS_REC), xout, nullptr, nullptr, nullptr, nullptr);
        else combine_phase<1>(lds, bid, G, xcur, adl + 5 * D, (const bf16_t*)(ws + WS_BIG), (const u32x2*)(ws + WS_REC), kp->out, kp->in[33], nullptr, nullptr, nullptr);
    }
}

__device__ __forceinline__ void hyena_layer(LAS unsigned char* lds, const XcdBarrier& bar, int bid, int G, int vcu) {
    { KP kp = kparams(); unsigned char* ws = kp->ws; const float* adl = (const float*)(ws + WS_ADA);
      for (int rep_ = 0; rep_ < REP_HCT; ++rep_) norm_phase(bid, G, kp->in[0], kp->in[4], adl + 1 * D, adl + 0 * D, (bf16_t*)(ws + WS_HBUF)); }
    xcd_barrier(bar);
    { KP kp = kparams(); unsigned char* ws = kp->ws;
      DenseOrder S; S.init((const bf16_t*)(ws + WS_HBUF), (const bf16_t*)(ws + WS_WHYIN), T, 6144, D, G, vcu);
      EpiBf16 E{(bf16_t*)(ws + WS_BIG + BIG_U), 6144};
      _Pragma("unroll 1") for (int rep_ = 0; rep_ < REP_GEMM; ++rep_) gemm_phase<EpiBf16, DenseOrder>(lds, D, S, E); }
    xcd_barrier(bar);
    { KP kp = kparams(); unsigned char* ws = kp->ws;
      for (int rep_ = 0; rep_ < REP_HCT; ++rep_) hy_conv_phase(lds, bid, G, (const bf16_t*)(ws + WS_BIG + BIG_U), kp->in[7], kp->in[8], (bf16_t*)(ws + WS_BIG + BIG_X0C), (bf16_t*)(ws + WS_BIG + BIG_VGT)); }
    xcd_barrier(bar);
#pragma unroll 1
    for (int rep_ = 0; rep_ < REP_HYF; ++rep_)
    { KP kp = kparams(); unsigned char* ws = kp->ws;
      hy_fft_phase(lds, bid, G, (const bf16_t*)(ws + WS_BIG + BIG_VGT), (bf16_t*)(ws + WS_BIG + BIG_U), (const float*)(ws + WS_BIG + BIG_A3), kp->in[16], kp->in[17], (float*)(ws + WS_XB), (float4*)(ws + WS_BIG + BIG_GSPEC)); }
    xcd_barrier(bar);
    { KP kp = kparams(); unsigned char* ws = kp->ws;
      for (int rep_ = 0; rep_ < REP_HCT; ++rep_) hy_tr_phase(lds, bid, G, (const bf16_t*)(ws + WS_BIG + BIG_U), (const bf16_t*)(ws + WS_BIG + BIG_X0C), (bf16_t*)(ws + WS_HBUF)); }
    xcd_barrier(bar);
    { KP kp = kparams(); unsigned char* ws = kp->ws; const float* adl = (const float*)(ws + WS_ADA);
      DenseOrder S; S.init((const bf16_t*)(ws + WS_HBUF), (const bf16_t*)(ws + WS_WHYOUT), T, D, D, G, vcu);
      EpiResid E{kp->in[0], (float*)(ws + WS_XA), adl + 2 * D};
      _Pragma("unroll 1") for (int rep_ = 0; rep_ < REP_GEMM; ++rep_) gemm_phase<EpiResid, DenseOrder>(lds, D, S, E); }
    xcd_barrier(bar);
}

__device__ __forceinline__ void mlstm_layer(LAS unsigned char* lds, const XcdBarrier& bar, int bid, int G, int vcu) {
    { KP kp = kparams(); unsigned char* ws = kp->ws; const float* adl = (const float*)(ws + WS_ADA) + 12288;
      ml_norm_gates_phase(lds, bid, G, (const float*)(ws + WS_XB), kp->in[4] + D, adl + 1 * D, adl + 0 * D, kp->in[19], kp->in[22], (bf16_t*)(ws + WS_HBUF), (float*)(ws + WS_BIG + BIG_GATES)); }
    xcd_barrier(bar);
    { KP kp = kparams(); unsigned char* ws = kp->ws;
      DenseOrder S; S.init((const bf16_t*)(ws + WS_HBUF), (const bf16_t*)(ws + WS_WMLIN), T, 6144, D, G, vcu);
      EpiBf16 E{(bf16_t*)(ws + WS_BIG + BIG_U), 6144};
      _Pragma("unroll 1") for (int rep_ = 0; rep_ < REP_GEMM; ++rep_) gemm_phase<EpiBf16, DenseOrder>(lds, D, S, E); }
    xcd_barrier(bar);
#pragma unroll 1
    for (int rep_ = 0; rep_ < REP_MLS; ++rep_) {
    { KP kp = kparams(); unsigned char* ws = kp->ws;
      ml_state_phase(lds, bid, G, (const bf16_t*)(ws + WS_BIG + BIG_U), (const float*)(ws + WS_BIG + BIG_GATES), kp->in[20], kp->in[21],
                     (bf16_t*)(ws + WS_BIG + BIG_SLOC), (float*)(ws + WS_BIG + BIG_ZLOC), (float*)(ws + WS_BIG + BIG_GTOT)); }
    xcd_barrier(bar);
    { KP kp = kparams(); unsigned char* ws = kp->ws;
      ml_scan_phase(bid, G, (bf16_t*)(ws + WS_BIG + BIG_SLOC), (float*)(ws + WS_BIG + BIG_ZLOC), (const float*)(ws + WS_BIG + BIG_GTOT)); }
    xcd_barrier(bar);
    { KP kp = kparams(); unsigned char* ws = kp->ws;
      ml_out_phase(lds, bid, G, (const bf16_t*)(ws + WS_BIG + BIG_U), (const float*)(ws + WS_BIG + BIG_GATES), kp->in[20], kp->in[21],
                   (const bf16_t*)(ws + WS_BIG + BIG_SLOC), (const float*)(ws + WS_BIG + BIG_ZLOC), kp->in[23], (bf16_t*)(ws + WS_HBUF)); }
    xcd_barrier(bar);
    }
    { KP kp = kparams(); unsigned char* ws = kp->ws; const float* adl = (const float*)(ws + WS_ADA) + 12288;
      DenseOrder S; S.init((const bf16_t*)(ws + WS_HBUF), (const bf16_t*)(ws + WS_WMLOUT), T, D, D, G, vcu);
      EpiResid E{(const float*)(ws + WS_XB), (float*)(ws + WS_XA), adl + 2 * D};
      _Pragma("unroll 1") for (int rep_ = 0; rep_ < REP_GEMM; ++rep_) gemm_phase<EpiResid, DenseOrder>(lds, D, S, E); }
    xcd_barrier(bar);
}

__global__ void __launch_bounds__(NTHR, 2) fwd(Params p_unused) {
    extern __shared__ __attribute__((aligned(16))) unsigned char lds_raw[];
    LAS unsigned char* lds = (LAS unsigned char*)lds_raw;
    const int G = gridDim.x, bid = blockIdx.x;
    const int vcu = (G % 8 == 0) ? (bid % 8) * (G / 8) + bid / 8 : bid;
    if (threadIdx.x < 4) ((LAS unsigned*)(lds + LDS_MISC))[threadIdx.x] = 0u;
    __syncthreads();
    XcdBarrier bar;
    { KP kp = kparams(); bar = xcd_barrier_post((unsigned*)(kp->ws + WS_CTL), (volatile LAS unsigned*)(lds + LDS_MISC)); }

#pragma unroll 1
    for (int repp_ = 0; repp_ < REP_PRO; ++repp_) {
    { KP kp = kparams(); ada_phase((LAS float*)lds, bid, G, kp->in[1], kp->in[2], kp->in[3], (float*)(kp->ws + WS_ADA)); }
    { KP kp = kparams(); hy_filter_mlp((LAS float*)lds, bid, G, kp->in[9], kp->in[10], kp->in[11], kp->in[12], kp->in[13], kp->in[14], kp->in[15], (float*)(kp->ws + WS_BIG + BIG_A3)); }
    {
        LAS float* tile = (LAS float*)lds;
        { KP kp = kparams(); cvt_group(tile, bid, G, kp->in[6], 0, 6144, D, 6144, (bf16_t*)(kp->ws + WS_WHYIN), 0, 0, 1); }
        { KP kp = kparams(); cvt_group(tile, bid, G, kp->in[18], 0, D, D, D, (bf16_t*)(kp->ws + WS_WHYOUT), 0, 0, 1); }
        { KP kp = kparams(); cvt_group(tile, bid, G, kp->in[19], 0, 6176, D, 6144, (bf16_t*)(kp->ws + WS_WMLIN), 0, 0, 1); }
        { KP kp = kparams(); cvt_group(tile, bid, G, kp->in[24], 0, D, D, D, (bf16_t*)(kp->ws + WS_WMLOUT), 0, 0, 1); }
#pragma unroll 1
        for (int l2 = 0; l2 < 2 * REP_CVT; ++l2) { const int l = l2 & 1;
            KP kp = kparams(); bf16_t* Wgu = (bf16_t*)(kp->ws + WS_WGU) + l * WGU_L; bf16_t* Wd = (bf16_t*)(kp->ws + WS_WD) + l * WD_L;
            cvt_group(tile, bid, G, kp->in[30] + (size_t)l * D * FF, 0, FF, D, FF, Wgu + (size_t)NE * 1024 * D, 0, 1, 1, 1024);
            cvt_group(tile, bid, G, kp->in[31] + (size_t)l * D * FF, 0, FF, D, FF, Wgu + (size_t)NE * 1024 * D, 0, 2, 1, 1024);
            cvt_group(tile, bid, G, kp->in[32] + (size_t)l * FF * D, 0, D, FF, D, Wd + (size_t)NE * D * FF, 0, 0, 1, D);
        }
    }
    }
    xcd_barrier(bar);

    hyena_layer(lds, bar, bid, G, vcu);
    { KP kp = kparams(); moe_layer<0>(lds, bar, bid, G, vcu, (const float*)(kp->ws + WS_XA), (float*)(kp->ws + WS_XB)); }
    asm volatile("s_waitcnt vmcnt(0)" ::: "memory"); __syncthreads();
    mlstm_layer(lds, bar, bid, G, vcu);
    { KP kp = kparams(); moe_layer<1>(lds, bar, bid, G, vcu, (const float*)(kp->ws + WS_XA), nullptr); }
}

extern "C" void kernel_launch(void* const* d_in, const int* in_sizes, int n_in, void* d_out, int out_size, void* d_ws, size_t ws_size, hipStream_t stream) {
    static int grid = 0;
    if (grid == 0) {
        if (n_in != 34 || ws_size < WS_END) { fprintf(stderr, "kernel_launch: n_in %d ws %zu need %zu\n", n_in, ws_size, (size_t)WS_END); grid = -1; return; }
        int dev = 0, cus = 0, per_cu = 0;
        hipGetDevice(&dev); hipDeviceGetAttribute(&cus, hipDeviceAttributeMultiprocessorCount, dev);
        hipFuncSetAttribute((const void*)fwd, hipFuncAttributeMaxDynamicSharedMemorySize, LDS_BYTES);
        hipOccupancyMaxActiveBlocksPerMultiprocessor(&per_cu, (const void*)fwd, NTHR, LDS_BYTES);
        (void)hipGetLastError();
        grid = (per_cu >= 1) ? (cus < 256 ? cus : 256) : -1;
        if (grid < 0) fprintf(stderr, "kernel_launch: occupancy query says 0 blocks per CU\n");
    }
    if (grid < 0) return;
    hipMemsetAsync((char*)d_ws + WS_CTL, 0, CTL_BYTES, stream);
    Params p{};
    for (int i = 0; i < 34; ++i) p.in[i] = (const float*)d_in[i];
    p.out = (float*)d_out; p.ws = (unsigned char*)d_ws;
    hipLaunchKernelGGL(fwd, dim3(grid), dim3(NTHR), LDS_BYTES, stream, p);
}
```

```cpp
#include <hip/hip_runtime.h>
#include <stdint.h>
#include <stdio.h>

#define LAS __attribute__((address_space(3)))
typedef unsigned short bf16_t;
typedef short bf16x8 __attribute__((ext_vector_type(8)));
typedef float f32x4 __attribute__((ext_vector_type(4)));
typedef unsigned u32x4 __attribute__((ext_vector_type(4)));
typedef unsigned u32x2 __attribute__((ext_vector_type(2)));

constexpr int T = 8192, D = 2048, NE = 64, FF = 512, TOPK = 6;
constexpr int NTHR = 512;
constexpr float EPS = 1e-6f;
#define REP_GEMM 1
#define REP_CVT 1
#define REP_MLS 1
#define REP_HYF 1
#define REP_F1 1
#define REP_TAP 1
#define REP_COMB 1
#define REP_PRO 1
#define REP_HCT 1

#define XB_TMO      128
#define XB_XCNT(j)  (256  + 64 * (j))
#define XB_XSUB(j)  (1280 + 64 * (j))
#define XB_XGEN(j)  (2304 + 64 * (j))
#define XB_TOP      3328
#define XB_TOPGEN   3392
#define XCD_BAR_WORDS 3456
#define XB_SPIN_CAP (1u << 18)

__device__ __forceinline__ unsigned xb_ld(unsigned* p)              { return __hip_atomic_load(p, __ATOMIC_RELAXED, __HIP_MEMORY_SCOPE_AGENT); }
__device__ __forceinline__ unsigned xb_add(unsigned* p, unsigned v) { return __hip_atomic_fetch_add(p, v, __ATOMIC_RELAXED, __HIP_MEMORY_SCOPE_AGENT); }
__device__ __forceinline__ unsigned xb_xcc_id() { return (unsigned)__builtin_amdgcn_s_getreg((3 << 11) | 20) & 0xFu; }
#define XB_SPIN(cond, bar) do { unsigned _sp = 0; while (cond) { __builtin_amdgcn_s_sleep(1); \
    if ((++_sp & 255u) == 0u) { if (xb_ld(&(bar)[XB_TMO])) break; if (_sp > XB_SPIN_CAP) { atomicAdd(&(bar)[XB_TMO], 1u); break; } } } } while (0)

struct XcdBarrier { unsigned* bar; unsigned x; volatile LAS unsigned* st; };

__device__ __forceinline__ XcdBarrier xcd_barrier_post(unsigned* bar, volatile LAS unsigned* st) {
    XcdBarrier b; b.bar = bar; b.x = xb_xcc_id(); b.st = st;
    if (threadIdx.x == 0) (void)xb_add(&bar[XB_XCNT(b.x)], 1u);
    return b;
}
__device__ __forceinline__ void xcd_barrier_complete(unsigned* bar, unsigned x, unsigned& nloc, unsigned& nx) {
    const unsigned G = gridDim.x * gridDim.y * gridDim.z;
    unsigned sum, cnt, mine, sp = 0u;
    for (;;) {
        sum = 0u; cnt = 0u; mine = 0u;
#pragma unroll
        for (unsigned j = 0; j < 16; ++j) { const unsigned c = xb_ld(&bar[XB_XCNT(j)]); sum += c; cnt += (c > 0u) ? 1u : 0u; mine = (j == x) ? c : mine; }
        if (sum == G) break;
        __builtin_amdgcn_s_sleep(1);
        if ((++sp & 255u) == 0u) { if (xb_ld(&bar[XB_TMO])) break; if (sp > XB_SPIN_CAP) { atomicAdd(&bar[XB_TMO], 1u); break; } }
    }
    nloc = mine > 0u ? mine : 1u; nx = cnt > 0u ? cnt : 1u;
}
__device__ __forceinline__ void xcd_barrier(const XcdBarrier& b) {
    asm volatile("s_waitcnt vmcnt(0)" ::: "memory");
    __syncthreads();
    if (threadIdx.x == 0) {
        unsigned* bar = b.bar;
        __builtin_amdgcn_s_waitcnt(0);
        unsigned nloc = b.st[0], nx = b.st[1];
        if (nloc == 0u) { xcd_barrier_complete(bar, b.x, nloc, nx); b.st[0] = nloc; b.st[1] = nx; }
        const unsigned old = xb_add(&bar[XB_XSUB(b.x)], 1u);
        const unsigned gen = old / nloc;
        if (old + 1u == (gen + 1u) * nloc) {
            __builtin_amdgcn_fence(__ATOMIC_RELEASE, "agent");
            asm volatile("s_waitcnt vmcnt(0)" ::: "memory");
            const unsigned og = xb_add(&bar[XB_TOP], 1u);
            const unsigned tg = og / nx;
            if (og + 1u == (tg + 1u) * nx) xb_add(&bar[XB_TOPGEN], 1u);
            else XB_SPIN(xb_ld(&bar[XB_TOPGEN]) == tg, bar);
            __builtin_amdgcn_fence(__ATOMIC_ACQUIRE, "agent");
            xb_add(&bar[XB_XGEN(b.x)], 1u);
            asm volatile("s_waitcnt vmcnt(0)" ::: "memory");
        } else {
            XB_SPIN(xb_ld(&bar[XB_XGEN(b.x)]) == gen, bar);
            __builtin_amdgcn_fence(__ATOMIC_ACQUIRE, "agent");
            asm volatile("s_waitcnt vmcnt(0)" ::: "memory");
        }
    }
    __syncthreads();
}

constexpr size_t WS_CTL   = 0;
constexpr size_t CTL_BYTES = 65536;
constexpr size_t CTL_CNT  = 16384;
constexpr size_t WS_ADA   = WS_CTL + CTL_BYTES;
constexpr size_t WS_WHYIN = WS_ADA + 131072;
constexpr size_t WS_WHYOUT= WS_WHYIN + (size_t)6144 * 2048 * 2;
constexpr size_t WS_WMLIN = WS_WHYOUT + (size_t)2048 * 2048 * 2;
constexpr size_t WS_WMLOUT= WS_WMLIN + (size_t)6144 * 2048 * 2;
constexpr size_t WS_WGU   = WS_WMLOUT + (size_t)2048 * 2048 * 2;
constexpr size_t WGU_L    = (size_t)65 * 1024 * 2048;
constexpr size_t WS_WD    = WS_WGU + 2 * WGU_L * 2;
constexpr size_t WD_L     = (size_t)65 * 2048 * 512;
constexpr size_t WS_HBUF  = WS_WD + 2 * WD_L * 2;
constexpr size_t WS_XA    = WS_HBUF + (size_t)T * D * 2;
constexpr size_t WS_XB    = WS_XA + (size_t)T * D * 4;
constexpr size_t WS_LIST  = WS_XB + (size_t)T * D * 4;
constexpr size_t WS_REC   = WS_LIST + (size_t)NE * T * 4;
constexpr int    SLOT_SH  = 65280;
constexpr int    NSLOT    = SLOT_SH + T;
constexpr size_t WS_H     = WS_REC + (size_t)T * TOPK * 8;
constexpr size_t WS_BIG   = WS_H + (size_t)NSLOT * FF * 2;
constexpr size_t WS_END   = WS_BIG + (size_t)NSLOT * D * 2;

constexpr int LDS_STAGE = 131072;
constexpr int LDS_MISC  = 135168;
constexpr int LDS_TSTART = LDS_MISC + 64;
constexpr int LDS_TILEE  = LDS_TSTART + 72 * 4;
constexpr int LDS_CNT    = LDS_TILEE + 320 * 4;
constexpr int LDS_BYTES  = LDS_MISC + 8192;

struct Params { const float* in[34]; float* out; unsigned char* ws; };
typedef const Params __attribute__((address_space(4)))* KP;
__device__ __forceinline__ int tid_fresh() { int t = threadIdx.x; asm volatile("" : "+v"(t)); return t; }
__device__ __forceinline__ KP kparams() { KP q = (KP)__builtin_amdgcn_kernarg_segment_ptr(); asm volatile("" : "+s"(q)); return q; }

__device__ __forceinline__ unsigned cvt_pk_bf16(float lo, float hi) { unsigned r; asm volatile("v_cvt_pk_bf16_f32 %0, %1, %2" : "=v"(r) : "v"(lo), "v"(hi)); return r; }
__device__ __forceinline__ float bf_lo(unsigned w) { return __uint_as_float(w << 16); }
__device__ __forceinline__ float bf_hi(unsigned w) { return __uint_as_float(w & 0xffff0000u); }
__device__ __forceinline__ float wave_sum(float v) {
#pragma unroll
    for (int o = 32; o > 0; o >>= 1) v += __shfl_xor(v, o);
    return v;
}
__device__ __forceinline__ float siluf(float v) { return v / (1.f + expf(-v)); }

constexpr int BM = 256, BK = 64, HALF = 128, HTB = HALF * BK * 2, NXCD = 8, WGM = 8;
__device__ __forceinline__ int lds_byte(int r, int c) { const int st = (r >> 4) * 2 + (c >> 5), rr = r & 15, cc = c & 31, ob = rr * 64 + cc * 2; return st * 1024 + (ob ^ (((ob >> 9) & 1) << 5)); }
__device__ __forceinline__ void stage_rc(int b, int& R, int& C) { const int st = b / 1024, sb = b % 1024, swz = sb ^ (((sb >> 9) & 1) << 5); R = (st >> 1) * 16 + swz / 64; C = (st & 1) * 32 + (swz % 64) / 2; }
__device__ __forceinline__ int perm32(int rho) { const int n = rho >> 4, i = rho & 15; return 8 * (i >> 2) + 4 * n + (i & 3); }

struct Unit { int pm, pn, e, rbase; };

template <class Epi, class Sched>
__device__ __forceinline__ void gemm_phase(LAS unsigned char* lds, const int K, const Sched& S, const Epi& E) {
    const int tid = tid_fresh(), wid = __builtin_amdgcn_readfirstlane(tid >> 6), lane = tid & 63, wr = wid >> 2, wc = wid & 3, fr = lane & 15, fq = lane >> 4;
    const int nt = K / BK;
    int R0, C0, R1, C1; stage_rc(tid * 16, R0, C0); stage_rc(tid * 16 + 8192, R1, C1);
    const int Rb0 = Epi::PERM ? ((R0 & ~31) + perm32(R0 & 31)) : R0, Rb1 = Epi::PERM ? ((R1 & ~31) + perm32(R1 & 31)) : R1;
    const unsigned voffB0 = S.b_off(Rb0, C0), voffB1 = S.b_off(Rb1, C1);
    const size_t kstep = (size_t)(BK * 2);
    const size_t kstepB = S.b_kstep(), hstep = S.b_hstep();
    const unsigned ldsw = (unsigned)wid * 1024u;
    const int aoff = lds_byte(wr * 64 + fr, fq * 8), boff = lds_byte(wc * 32 + fr, fq * 8);
#define PG8_SA(b, h) (((b) * 2 + (h)) * HTB)
#define PG8_SB(b, h) ((4 + (b) * 2 + (h)) * HTB)
#define PG8_STAGE(bufoff, gbase, v0, v1) do { \
        __builtin_amdgcn_global_load_lds((const unsigned*)((const char*)(gbase) + (v0)), (LAS unsigned*)(lds + (bufoff) + ldsw), 16, 0, 0); \
        __builtin_amdgcn_global_load_lds((const unsigned*)((const char*)(gbase) + (v1)), (LAS unsigned*)(lds + (bufoff) + ldsw + 8192), 16, 0, 0); } while (0)
#define PG8_LDA(dst, b, h) do { _Pragma("unroll") for (int m = 0; m < 4; ++m) _Pragma("unroll") for (int k = 0; k < 2; ++k) dst[m][k] = *(const LAS bf16x8*)(lds + PG8_SA(b, h) + aoff + m * 2048 + k * 1024); } while (0)
#define PG8_LDB(dst, b, h) do { _Pragma("unroll") for (int n = 0; n < 2; ++n) _Pragma("unroll") for (int k = 0; k < 2; ++k) dst[n][k] = *(const LAS bf16x8*)(lds + PG8_SB(b, h) + boff + n * 2048 + k * 1024); } while (0)
#define PG8_MMA(ai, bj, At, Bt) do { __builtin_amdgcn_s_setprio(1); _Pragma("unroll") for (int m = 0; m < 4; ++m) _Pragma("unroll") for (int n = 0; n < 2; ++n) _Pragma("unroll") for (int k = 0; k < 2; ++k) \
        acc[ai][bj][m][n] = __builtin_amdgcn_mfma_f32_16x16x32_bf16(Bt[n][k], At[m][k], acc[ai][bj][m][n], 0, 0, 0); __builtin_amdgcn_s_setprio(0); } while (0)
#define PG8_WAIT_V(n) asm volatile("s_waitcnt vmcnt(" #n ")" ::: "memory")
#define PG8_WAIT_L(n) asm volatile("s_waitcnt lgkmcnt(" #n ")" ::: "memory")
#define PG8_BAR __builtin_amdgcn_s_barrier()
#define PG8_SCHED __builtin_amdgcn_sched_barrier(0)
#define PG8_AOFFS(u, o00, o01, o10, o11) do { S.a_off4(u, R0, R1, o00, o01, o10, o11); o00 += (unsigned)C0 * 2u; o01 += (unsigned)C1 * 2u; o10 += (unsigned)C0 * 2u; o11 += (unsigned)C1 * 2u; } while (0)
    Unit cur, nxt; int ui = 0;
    if (!S.next(0, cur)) return;
    f32x4 acc[2][2][4][2];
#pragma unroll
    for (int a = 0; a < 2; ++a)
#pragma unroll
        for (int b = 0; b < 2; ++b)
#pragma unroll
            for (int m = 0; m < 4; ++m)
#pragma unroll
                for (int n = 0; n < 2; ++n) acc[a][b][m][n] = (f32x4){0.f, 0.f, 0.f, 0.f};
    bf16x8 At[4][2], B0[2][2], B1[2][2];
    const char* const gA = S.a_base();
    unsigned c00, c01, c10, c11, n00, n01, n10, n11;
    PG8_AOFFS(cur, c00, c01, c10, c11);
    const char* cB = S.b_ptr(cur);
    PG8_STAGE(PG8_SB(0, 0), cB, voffB0, voffB1); PG8_STAGE(PG8_SA(0, 0), gA, c00, c01); PG8_STAGE(PG8_SB(0, 1), cB + hstep, voffB0, voffB1); PG8_STAGE(PG8_SA(0, 1), gA, c10, c11);
    if (wr == 1) PG8_BAR;
    PG8_WAIT_V(4); PG8_BAR;
    PG8_STAGE(PG8_SB(1, 0), cB + kstepB, voffB0, voffB1); PG8_STAGE(PG8_SA(1, 0), gA + kstep, c00, c01); PG8_STAGE(PG8_SB(1, 1), cB + hstep + kstepB, voffB0, voffB1);
    PG8_WAIT_V(6); PG8_BAR;
    for (;;) {
        const bool has_next = S.next(ui + 1, nxt);
        const char* nB = cB;
        if (has_next) { PG8_AOFFS(nxt, n00, n01, n10, n11); nB = S.b_ptr(nxt); } else { n00 = c00; n01 = c01; n10 = c10; n11 = c11; }
        for (int t = 0; t < nt; t += 2) {
            const bool last = (t == nt - 2);
            const char* a1 = gA + (size_t)(t + 1) * kstep;
            const char* a2 = last ? gA : gA + (size_t)(t + 2) * kstep; const char* b2 = last ? nB : cB + (size_t)(t + 2) * kstepB;
            const char* a3 = a2 + kstep; const char* b3 = b2 + kstepB;
            const unsigned x00 = last ? n00 : c00, x01 = last ? n01 : c01, x10 = last ? n10 : c10, x11 = last ? n11 : c11;
            PG8_LDB(B0, 0, 0); PG8_SCHED; PG8_LDA(At, 0, 0); PG8_STAGE(PG8_SA(1, 1), a1, c10, c11);
            PG8_WAIT_L(8); PG8_BAR; PG8_WAIT_L(0); PG8_MMA(0, 0, At, B0); PG8_BAR; PG8_SCHED;
            PG8_LDB(B1, 0, 1); PG8_STAGE(PG8_SB(0, 0), b2, voffB0, voffB1);
            PG8_BAR; PG8_WAIT_L(0); PG8_MMA(0, 1, At, B1); PG8_BAR;
            PG8_LDA(At, 0, 1); PG8_STAGE(PG8_SA(0, 0), a2, x00, x01);
            PG8_BAR; PG8_WAIT_L(0); PG8_MMA(1, 0, At, B0); PG8_BAR; PG8_SCHED;
            PG8_STAGE(PG8_SB(0, 1), b2 + hstep, voffB0, voffB1);
            PG8_WAIT_V(6); PG8_BAR; PG8_MMA(1, 1, At, B1); PG8_BAR;
            PG8_LDB(B0, 1, 0); PG8_SCHED; PG8_LDA(At, 1, 0); PG8_STAGE(PG8_SA(0, 1), a2, x10, x11);
            PG8_WAIT_L(8); PG8_BAR; PG8_WAIT_L(0); PG8_MMA(0, 0, At, B0); PG8_BAR; PG8_SCHED;
            PG8_LDB(B1, 1, 1); PG8_STAGE(PG8_SB(1, 0), b3, voffB0, voffB1);
            PG8_BAR; PG8_WAIT_L(0); PG8_MMA(0, 1, At, B1); PG8_BAR;
            PG8_LDA(At, 1, 1); PG8_STAGE(PG8_SA(1, 0), a3, x00, x01);
            PG8_BAR; PG8_WAIT_L(0); PG8_MMA(1, 0, At, B0); PG8_BAR; PG8_SCHED;
            PG8_STAGE(PG8_SB(1, 1), b3 + hstep, voffB0, voffB1);
            PG8_WAIT_V(6); PG8_BAR; PG8_MMA(1, 1, At, B1); PG8_BAR;
        }
        E(acc, cur, wr, wc, fr, fq);
        if (!has_next) break;
#pragma unroll
        for (int a = 0; a < 2; ++a)
#pragma unroll
            for (int b = 0; b < 2; ++b)
#pragma unroll
                for (int m = 0; m < 4; ++m)
#pragma unroll
                    for (int n = 0; n < 2; ++n) acc[a][b][m][n] = (f32x4){0.f, 0.f, 0.f, 0.f};
        cur = nxt; cB = nB; c00 = n00; c01 = n01; c10 = n10; c11 = n11; ++ui;
    }
    PG8_WAIT_V(0);
    if (wr == 0) PG8_BAR;
    PG8_BAR;
#undef PG8_SA
#undef PG8_SB
#undef PG8_STAGE
#undef PG8_LDA
#undef PG8_LDB
#undef PG8_MMA
#undef PG8_WAIT_V
#undef PG8_WAIT_L
#undef PG8_BAR
#undef PG8_SCHED
#undef PG8_AOFFS
}

struct DenseOrder {
    const bf16_t* A; const bf16_t* Bt; int K, nM, nN, nwg, G, c;
    __device__ __forceinline__ void init(const bf16_t* A_, const bf16_t* Bt_, int M, int N, int K_, int G_, int c_) { A = A_; Bt = Bt_; K = K_; nM = M / BM; nN = N / BM; nwg = nM * nN; G = G_; c = c_; }
    __device__ __forceinline__ bool next(int i, Unit& u) const {
        const long L = (long)i * G + c; if (L >= nwg) return false;
        int wgid = (int)L; { const int q = nwg / NXCD, r = nwg % NXCD, xcd = wgid % NXCD, off = wgid / NXCD; wgid = (xcd < r ? xcd * (q + 1) : r * (q + 1) + (xcd - r) * q) + off; }
        const int nig = WGM * nN, gid = wgid / nig, fm = gid * WGM, gsz = (nM - fm) < WGM ? (nM - fm) : WGM;
        u.pm = fm + ((wgid % nig) % gsz); u.pn = (wgid % nig) / gsz; u.e = 0; u.rbase = u.pm * BM; return true;
    }
    __device__ __forceinline__ const char* a_base() const { return (const char*)A; }
    __device__ __forceinline__ unsigned a_off(const Unit& u, int r) const { return (unsigned)((u.pm * BM + r) * K) * 2u; }
    __device__ __forceinline__ void a_off4(const Unit& u, int r0, int r1, unsigned& o00, unsigned& o01, unsigned& o10, unsigned& o11) const { o00 = a_off(u, r0); o01 = a_off(u, r1); o10 = a_off(u, HALF + r0); o11 = a_off(u, HALF + r1); }
    __device__ __forceinline__ const char* b_ptr(const Unit& u) const { return (const char*)(Bt + (size_t)u.pn * BM * K); }
    __device__ __forceinline__ unsigned b_off(int R, int C) const { return (unsigned)(R * K + C) * 2u; }
    __device__ __forceinline__ size_t b_kstep() const { return (size_t)(BK * 2); }
    __device__ __forceinline__ size_t b_hstep() const { return (size_t)HALF * K * 2; }
};
struct MoeGuOrder {
    const bf16_t* A; const bf16_t* W; const int* list; const LAS int* tstart; const LAS int* tile_e; const LAS int* cnt; int ntiles, G, c;
    __device__ __forceinline__ bool next(int i, Unit& u) const {
        const int L = i * G + c; if (L >= ntiles * 4) return false;
        const int rt = L >> 2; u.pn = L & 3; u.e = tile_e[rt]; u.pm = rt - tstart[u.e]; u.rbase = (u.e < NE) ? rt * BM : SLOT_SH + u.pm * BM; return true;
    }
    __device__ __forceinline__ const char* a_base() const { return (const char*)A; }
    __device__ __forceinline__ unsigned a_off(const Unit& u, int r) const {
        const int pos = u.pm * BM + r; int tok = pos;
        if (u.e < NE) { tok = 0; if (pos < cnt[u.e]) tok = list[u.e * T + pos]; }
        return (unsigned)tok * (unsigned)(D * 2);
    }
    __device__ __forceinline__ void a_off4(const Unit& u, int r0, int r1, unsigned& o00, unsigned& o01, unsigned& o10, unsigned& o11) const {
        const int p0 = u.pm * BM + r0, p1 = u.pm * BM + r1, p2 = p0 + HALF, p3 = p1 + HALF;
        if (u.e >= NE) { o00 = (unsigned)p0 * (unsigned)(D * 2); o01 = (unsigned)p1 * (unsigned)(D * 2); o10 = (unsigned)p2 * (unsigned)(D * 2); o11 = (unsigned)p3 * (unsigned)(D * 2); return; }
        const int* lp = list + u.e * T;
        int v0 = lp[p0], v1 = lp[p1], v2 = lp[p2], v3 = lp[p3];
        asm volatile("" : "+v"(v0), "+v"(v1), "+v"(v2), "+v"(v3));
        const int c = cnt[u.e];
        o00 = p0 < c ? (unsigned)v0 * (unsigned)(D * 2) : 0u; o01 = p1 < c ? (unsigned)v1 * (unsigned)(D * 2) : 0u;
        o10 = p2 < c ? (unsigned)v2 * (unsigned)(D * 2) : 0u; o11 = p3 < c ? (unsigned)v3 * (unsigned)(D * 2) : 0u;
    }
    __device__ __forceinline__ const char* b_ptr(const Unit& u) const { return (const char*)(W + (size_t)u.e * 1024 * D + (size_t)u.pn * BM * 8); }
    __device__ __forceinline__ unsigned b_off(int R, int C) const { return (unsigned)((C >> 3) * 1024 + R) * 16u; }
    __device__ __forceinline__ size_t b_kstep() const { return (size_t)8 * 1024 * 16; }
    __device__ __forceinline__ size_t b_hstep() const { return (size_t)HALF * 16; }
};
struct MoeDownOrder {
    const bf16_t* A; const bf16_t* W; const LAS int* tstart; const LAS int* tile_e; int ntiles, G, c;
    __device__ __forceinline__ bool next(int i, Unit& u) const {
        const int L = i * G + c; if (L >= ntiles * 8) return false;
        const int rt = L >> 3; u.pn = L & 7; u.e = tile_e[rt]; u.pm = rt - tstart[u.e]; u.rbase = (u.e < NE) ? rt * BM : SLOT_SH + u.pm * BM; return true;
    }
    __device__ __forceinline__ const char* a_base() const { return (const char*)A; }
    __device__ __forceinline__ unsigned a_off(const Unit& u, int r) const { return (unsigned)((u.rbase + r) * FF) * 2u; }
    __device__ __forceinline__ void a_off4(const Unit& u, int r0, int r1, unsigned& o00, unsigned& o01, unsigned& o10, unsigned& o11) const { o00 = a_off(u, r0); o01 = a_off(u, r1); o10 = a_off(u, HALF + r0); o11 = a_off(u, HALF + r1); }
    __device__ __forceinline__ const char* b_ptr(const Unit& u) const { return (const char*)(W + (size_t)u.e * D * FF + (size_t)u.pn * BM * 8); }
    __device__ __forceinline__ unsigned b_off(int R, int C) const { return (unsigned)((C >> 3) * D + R) * 16u; }
    __device__ __forceinline__ size_t b_kstep() const { return (size_t)8 * D * 16; }
    __device__ __forceinline__ size_t b_hstep() const { return (size_t)HALF * 16; }
};

struct EpiBf16 {
    static constexpr bool PERM = true;
    bf16_t* O; int ldc;
    __device__ __forceinline__ void operator()(const f32x4 (&acc)[2][2][4][2], const Unit& u, int wr, int wc, int fr, int fq) const {
        const int row0 = u.rbase + wr * 64 + fr, col0 = u.pn * BM + wc * 32 + 8 * fq;
#pragma unroll
        for (int ai = 0; ai < 2; ++ai)
#pragma unroll
            for (int m = 0; m < 4; ++m) { bf16_t* rowp = O + (size_t)(row0 + ai * HALF + m * 16) * ldc + col0;
#pragma unroll
                for (int bj = 0; bj < 2; ++bj) { const f32x4 v0 = acc[ai][bj][m][0], v1 = acc[ai][bj][m][1];
                    u32x4 w; w.x = cvt_pk_bf16(v0[0], v0[1]); w.y = cvt_pk_bf16(v0[2], v0[3]); w.z = cvt_pk_bf16(v1[0], v1[1]); w.w = cvt_pk_bf16(v1[2], v1[3]);
                    *(u32x4*)(rowp + bj * HALF) = w; } }
    }
};
__device__ __forceinline__ unsigned pk4_fp8(float a, float b, float c, float d) { int w = 0; w = __builtin_amdgcn_cvt_pk_fp8_f32(a, b, w, false); w = __builtin_amdgcn_cvt_pk_fp8_f32(c, d, w, true); return (unsigned)w; }
typedef float f32x2v __attribute__((ext_vector_type(2)));
constexpr float Y8_SCALE = 16.f, Y8_INV = 1.f / 16.f;
struct EpiF8 {
    static constexpr bool PERM = true;
    unsigned char* O; int ldc; float scale;
    __device__ __forceinline__ void operator()(const f32x4 (&acc)[2][2][4][2], const Unit& u, int wr, int wc, int fr, int fq) const {
        const int row0 = u.rbase + wr * 64 + fr, col0 = u.pn * BM + wc * 32 + 8 * fq;
#pragma unroll
        for (int ai = 0; ai < 2; ++ai)
#pragma unroll
            for (int m = 0; m < 4; ++m) { unsigned char* rowp = O + (size_t)(row0 + ai * HALF + m * 16) * ldc + col0;
#pragma unroll
                for (int bj = 0; bj < 2; ++bj) { const f32x4 v0 = acc[ai][bj][m][0] * scale, v1 = acc[ai][bj][m][1] * scale;
                    u32x2 w; w.x = pk4_fp8(v0[0], v0[1], v0[2], v0[3]); w.y = pk4_fp8(v1[0], v1[1], v1[2], v1[3]);
                    *(u32x2*)(rowp + bj * HALF) = w; } }
    }
};
struct EpiSwiglu {
    static constexpr bool PERM = true;
    bf16_t* O;
    __device__ __forceinline__ void operator()(const f32x4 (&acc)[2][2][4][2], const Unit& u, int wr, int wc, int fr, int fq) const {
        const int row0 = u.rbase + wr * 64 + fr, col0 = u.pn * HALF + wc * 32 + 8 * fq;
#pragma unroll
        for (int ai = 0; ai < 2; ++ai)
#pragma unroll
            for (int m = 0; m < 4; ++m) { bf16_t* rowp = O + (size_t)(row0 + ai * HALF + m * 16) * FF + col0;
                float h[8];
#pragma unroll
                for (int n = 0; n < 2; ++n)
#pragma unroll
                    for (int j = 0; j < 4; ++j) { const float g = acc[ai][0][m][n][j], up = acc[ai][1][m][n][j]; h[n * 4 + j] = g / (1.f + __expf(-g)) * up; }
                u32x4 w; w.x = cvt_pk_bf16(h[0], h[1]); w.y = cvt_pk_bf16(h[2], h[3]); w.z = cvt_pk_bf16(h[4], h[5]); w.w = cvt_pk_bf16(h[6], h[7]);
                *(u32x4*)rowp = w; }
    }
};
struct EpiResid {
    static constexpr bool PERM = false;
    const float* xin; float* out; const float* gate;
    __device__ __forceinline__ void operator()(const f32x4 (&acc)[2][2][4][2], const Unit& u, int wr, int wc, int fr, int fq) const {
        const int row0 = u.rbase + wr * 64 + fr, col0 = u.pn * BM + wc * 32 + 4 * fq;
        f32x4 gv[2][2];
#pragma unroll
        for (int bj = 0; bj < 2; ++bj)
#pragma unroll
            for (int n = 0; n < 2; ++n) gv[bj][n] = *(const f32x4*)(gate + col0 + bj * HALF + n * 16);
#pragma unroll
        for (int ai = 0; ai < 2; ++ai) {
            f32x4 xv[4][2][2];
#pragma unroll
            for (int m = 0; m < 4; ++m) { const size_t ro = (size_t)(row0 + ai * HALF + m * 16) * D + col0;
#pragma unroll
                for (int bj = 0; bj < 2; ++bj)
#pragma unroll
                    for (int n = 0; n < 2; ++n) xv[m][bj][n] = *(const f32x4*)(xin + ro + bj * HALF + n * 16); }
#pragma unroll
            for (int m = 0; m < 4; ++m) { const size_t ro = (size_t)(row0 + ai * HALF + m * 16) * D + col0;
#pragma unroll
                for (int bj = 0; bj < 2; ++bj)
#pragma unroll
                    for (int n = 0; n < 2; ++n) *(f32x4*)(out + ro + bj * HALF + n * 16) = xv[m][bj][n] + gv[bj][n] * acc[ai][bj][m][n]; }
        }
    }
};

__device__ __forceinline__ void cvt_group(LAS float* tile, int bid, int G, const float* src, size_t sbs, int ldS, int K, int N, bf16_t* dst, size_t dbs, int mode, int nbatch, int nrimg = 0) {
    const int tid = tid_fresh();
    const int tk = K / 64, tn = N / 256, per = tk * tn, total = per * nbatch;
    const int kr = tid >> 6, c4 = tid & 63;
#define CVT_LOAD(jx) do { const int b_ = (jx) / per, r_ = (jx) - b_ * per, kt_ = r_ / tn, nt_ = r_ - kt_ * tn; \
        const float* s_ = src + (size_t)b_ * sbs + (size_t)(kt_ * 64) * ldS + nt_ * 256; \
        _Pragma("unroll") for (int q = 0; q < 8; ++q) v[q] = *(const float4*)(s_ + (size_t)(kr + 8 * q) * ldS + c4 * 4); } while (0)
    float4 v[8];
    if (bid < total) CVT_LOAD(bid);
    for (int j = bid; j < total; j += G) {
        const int b = j / per, r = j - b * per, kt = r / tn, ntile = r - kt * tn;
        __syncthreads();
#pragma unroll
        for (int q = 0; q < 8; ++q) { LAS float* tp = tile + (kr + 8 * q) * 257 + c4 * 4; tp[0] = v[q].x; tp[1] = v[q].y; tp[2] = v[q].z; tp[3] = v[q].w; }
        if (j + G < total) CVT_LOAD(j + G);
        __syncthreads();
        bf16_t* dmat = dst + (size_t)b * dbs;
#pragma unroll
        for (int q = 0; q < 4; ++q) {
            const int id = tid + NTHR * q, nr = id >> 3, kc = id & 7;
            const int n = ntile * 256 + nr;
            const int drow = (mode == 0) ? n : ((n >> 7) * 256 + (mode == 2 ? 128 : 0) + (n & 127));
            const LAS float* tp = tile + (kc * 8) * 257 + nr;
            u32x4 w; w.x = cvt_pk_bf16(tp[0], tp[257]); w.y = cvt_pk_bf16(tp[2 * 257], tp[3 * 257]); w.z = cvt_pk_bf16(tp[4 * 257], tp[5 * 257]); w.w = cvt_pk_bf16(tp[6 * 257], tp[7 * 257]);
            if (nrimg) *(u32x4*)(dmat + ((size_t)(kt * 8 + kc) * nrimg + drow) * 8) = w;
            else *(u32x4*)(dmat + (size_t)drow * K + kt * 64 + kc * 8) = w;
        }
    }
#undef CVT_LOAD
    __syncthreads();
}

__device__ __forceinline__ void ada_phase(LAS float* sm, int bid, int G, const float* c, const float* ada_w, const float* ada_b, float* ada) {
    const int tid = tid_fresh();
    LAS float* cs = sm; LAS float* red = sm + 2048;
    for (int i = tid; i < D; i += NTHR) cs[i] = siluf(c[i]);
    __syncthreads();
    const int kg = tid >> 5, c4 = tid & 31;
    for (int j = bid; j < 192; j += G) {
        const int l = j / 96, cb = j - l * 96;
        const float* w = ada_w + (size_t)l * D * 12288 + (size_t)(kg * 128) * 12288 + cb * 128 + c4 * 4;
        float4 a = make_float4(0.f, 0.f, 0.f, 0.f);
#pragma unroll 8
        for (int k = 0; k < 128; ++k) { const float4 wv = *(const float4*)(w + (size_t)k * 12288); const float s = cs[kg * 128 + k]; a.x += s * wv.x; a.y += s * wv.y; a.z += s * wv.z; a.w += s * wv.w; }
        __syncthreads();
        LAS float* rp = red + kg * 128 + c4 * 4; rp[0] = a.x; rp[1] = a.y; rp[2] = a.z; rp[3] = a.w;
        __syncthreads();
        if (tid < 128) { float s = 0.f;
#pragma unroll
            for (int q = 0; q < 16; ++q) s += red[q * 128 + tid];
            ada[l * 12288 + cb * 128 + tid] = s + ada_b[l * 12288 + cb * 128 + tid]; }
    }
    __syncthreads();
}

__device__ __forceinline__ void row_norm_mod(float4 (&v)[8], int lane, const float* g, const float* sc, const float* sh) {
    float4 ga[8], s1a[8], s0a[8];
#pragma unroll
    for (int i = 0; i < 8; ++i) { const int c = (lane + 64 * i) * 4; ga[i] = *(const float4*)(g + c); s1a[i] = *(const float4*)(sc + c); s0a[i] = *(const float4*)(sh + c); }
    float ss = 0.f;
#pragma unroll
    for (int i = 0; i < 8; ++i) ss += v[i].x * v[i].x + v[i].y * v[i].y + v[i].z * v[i].z + v[i].w * v[i].w;
    ss = wave_sum(ss);
    const float r = rsqrtf(ss * (1.f / D) + EPS);
#pragma unroll
    for (int i = 0; i < 8; ++i) { const float4 gg = ga[i], s1 = s1a[i], s0 = s0a[i];
        v[i].x = v[i].x * r * gg.x * (1.f + s1.x) + s0.x; v[i].y = v[i].y * r * gg.y * (1.f + s1.y) + s0.y; v[i].z = v[i].z * r * gg.z * (1.f + s1.z) + s0.z; v[i].w = v[i].w * r * gg.w * (1.f + s1.w) + s0.w; }
}

__device__ __forceinline__ void row_norm_mod2(float4 (&v0)[8], float4 (&v1)[8], int lane, const float* g, const float* sc, const float* sh) {
    float4 ga[8], s1a[8];
#pragma unroll
    for (int i = 0; i < 8; ++i) { const int c = (lane + 64 * i) * 4; ga[i] = *(const float4*)(g + c); s1a[i] = *(const float4*)(sc + c); }
    float ssa = 0.f, ssb = 0.f;
#pragma unroll
    for (int i = 0; i < 8; ++i) { ssa += v0[i].x * v0[i].x + v0[i].y * v0[i].y + v0[i].z * v0[i].z + v0[i].w * v0[i].w; ssb += v1[i].x * v1[i].x + v1[i].y * v1[i].y + v1[i].z * v1[i].z + v1[i].w * v1[i].w; }
    ssa = wave_sum(ssa); ssb = wave_sum(ssb);
    const float ra = rsqrtf(ssa * (1.f / D) + EPS), rb = rsqrtf(ssb * (1.f / D) + EPS);
#pragma unroll
    for (int i = 0; i < 8; ++i) { const int c = (lane + 64 * i) * 4; const float4 gg = ga[i], s1 = s1a[i], s0 = *(const float4*)(sh + c);
        v0[i].x = v0[i].x * ra * gg.x * (1.f + s1.x) + s0.x; v0[i].y = v0[i].y * ra * gg.y * (1.f + s1.y) + s0.y; v0[i].z = v0[i].z * ra * gg.z * (1.f + s1.z) + s0.z; v0[i].w = v0[i].w * ra * gg.w * (1.f + s1.w) + s0.w;
        v1[i].x = v1[i].x * rb * gg.x * (1.f + s1.x) + s0.x; v1[i].y = v1[i].y * rb * gg.y * (1.f + s1.y) + s0.y; v1[i].z = v1[i].z * rb * gg.z * (1.f + s1.z) + s0.z; v1[i].w = v1[i].w * rb * gg.w * (1.f + s1.w) + s0.w; }
}

constexpr int HFS_LD = 2050;
template <int NT>
__device__ __forceinline__ void rows16_matmul(const LAS float* hfs, const float* W, int ldw, int col0, int wave, int lane, f32x4 (&acc)[NT]) {
#pragma unroll
    for (int jt = 0; jt < NT; ++jt) acc[jt] = (f32x4){0.f, 0.f, 0.f, 0.f};
    const LAS float* ap = hfs + (lane & 15) * HFS_LD + wave * 256 + (lane >> 4);
    const float* bp = W + (size_t)(wave * 256 + (lane >> 4)) * ldw + col0 + (lane & 15);
#pragma unroll 8
    for (int s4 = 0; s4 < 64; ++s4) {
        const float a = ap[s4 * 4];
        float b[NT];
#pragma unroll
        for (int jt = 0; jt < NT; ++jt) b[jt] = bp[(size_t)(s4 * 4) * ldw + jt * 16];
#pragma unroll
        for (int jt = 0; jt < NT; ++jt) acc[jt] = __builtin_amdgcn_mfma_f32_16x16x4f32(a, b[jt], acc[jt], 0, 0, 0);
    }
}

__device__ __forceinline__ void route_phase(LAS unsigned char* lds, int bid, int G, const float* x, const float* g, const float* sc, const float* sh,
                                            const float* rw, const float* rbias, bf16_t* hbuf, int* cnt, int* list, u32x2* rec) {
    LAS float* hfs = (LAS float*)lds;
    LAS float* part = (LAS float*)lds;
    for (int r0 = bid * 16; r0 < T; r0 += G * 16) {
        const int tid = tid_fresh();
        const int lane = tid & 63, wave = tid >> 6;
        __syncthreads();
        {   const int row = r0 + wave * 2;
            float4 va[8], vb[8];
#pragma unroll
            for (int i = 0; i < 8; ++i) { va[i] = *(const float4*)(x + (size_t)row * D + (lane + 64 * i) * 4); vb[i] = *(const float4*)(x + (size_t)(row + 1) * D + (lane + 64 * i) * 4); }
            row_norm_mod2(va, vb, lane, g, sc, sh);
#pragma unroll
            for (int i = 0; i < 8; ++i) { const int c = (lane + 64 * i) * 4;
                u32x2 w; w.x = cvt_pk_bf16(va[i].x, va[i].y); w.y = cvt_pk_bf16(va[i].z, va[i].w); *(u32x2*)(hbuf + (size_t)row * D + c) = w;
                u32x2 w2; w2.x = cvt_pk_bf16(vb[i].x, vb[i].y); w2.y = cvt_pk_bf16(vb[i].z, vb[i].w); *(u32x2*)(hbuf + (size_t)(row + 1) * D + c) = w2;
                LAS float* hp = hfs + (wave * 2) * HFS_LD + c; hp[0] = va[i].x; hp[1] = va[i].y; hp[2] = va[i].z; hp[3] = va[i].w;
                hp[HFS_LD] = vb[i].x; hp[HFS_LD + 1] = vb[i].y; hp[HFS_LD + 2] = vb[i].z; hp[HFS_LD + 3] = vb[i].w; }
        }
        __syncthreads();
        f32x4 acc[4];
        rows16_matmul<4>(hfs, rw, NE, 0, wave, lane, acc);
        __syncthreads();
#pragma unroll
        for (int jt = 0; jt < 4; ++jt)
#pragma unroll
            for (int r = 0; r < 4; ++r) part[(wave * 16 + (lane >> 4) * 4 + r) * 64 + jt * 16 + (lane & 15)] = acc[jt][r];
        __syncthreads();
#pragma unroll 1
        for (int rr = 0; rr < 2; ++rr) {
            const int rl = wave * 2 + rr, row = r0 + rl;
            float logit = 0.f;
#pragma unroll
            for (int w = 0; w < 8; ++w) logit += part[(w * 16 + rl) * 64 + lane];
            const float score = 1.f / (1.f + expf(-logit));
            const float sel = score + rbias[lane];
            float m1 = sel; m1 = fmaxf(m1, __shfl_xor(m1, 1)); m1 = fmaxf(m1, __shfl_xor(m1, 2)); m1 = fmaxf(m1, __shfl_xor(m1, 4));
            const unsigned long long bal = __ballot(sel == m1);
            const unsigned gbits = (unsigned)(bal >> (lane & ~7)) & 0xffu;
            const int idx1 = (lane & ~7) + __ffs(gbits) - 1;
            float m2 = (lane == idx1) ? -INFINITY : sel; m2 = fmaxf(m2, __shfl_xor(m2, 1)); m2 = fmaxf(m2, __shfl_xor(m2, 2)); m2 = fmaxf(m2, __shfl_xor(m2, 4));
            const float gs = m1 + m2;
            const int grp = lane >> 3; int grank = 0;
#pragma unroll
            for (int gp = 0; gp < 8; ++gp) { const float o = __shfl(gs, gp * 8); grank += ((o > gs) || (o == gs && gp < grp)) ? 1 : 0; }
            const bool elig = grank < 4;
            const float sm = elig ? sel : -INFINITY;
            int rank = 0;
            for (int j = 0; j < 64; ++j) { const float o = __shfl(sm, j); rank += ((o > sm) || (o == sm && j < lane)) ? 1 : 0; }
            const bool chosen = elig && rank < TOPK;
            const float wsum = wave_sum(chosen ? score : 0.f);
            const float wgt = score / wsum * 2.5f;
            const unsigned long long cb = __ballot(chosen);
            if (chosen) {
                const int pos = atomicAdd(&cnt[lane], 1);
                list[lane * T + pos] = row;
                const int j = __popcll(cb & ((1ull << lane) - 1ull));
                u32x2 rr2; rr2.x = (unsigned)(lane * T + pos); rr2.y = __float_as_uint(wgt);
                rec[row * TOPK + j] = rr2;
            }
        }
    }
    __syncthreads();
}

__device__ __forceinline__ int moe_tables(LAS unsigned char* ldsb, int* cnt_g) {
    const int tid = tid_fresh();
    LAS int* tstart = (LAS int*)(ldsb + LDS_TSTART); LAS int* tile_e = (LAS int*)(ldsb + LDS_TILEE); LAS int* cl = (LAS int*)(ldsb + LDS_CNT);
    __syncthreads();
    if (tid < NE) {
        const int c = (int)__hip_atomic_load((unsigned*)cnt_g + tid, __ATOMIC_RELAXED, __HIP_MEMORY_SCOPE_AGENT);
        cl[tid] = c;
        const int nt = (c + BM - 1) / BM; int inc = nt;
#pragma unroll
        for (int o = 1; o < 64; o <<= 1) { const int v = __shfl_up(inc, o); if (tid >= o) inc += v; }
        tstart[tid] = inc - nt;
        if (tid == NE - 1) { tstart[NE] = inc; tstart[NE + 1] = inc + T / BM; }
    }
    __syncthreads();
    const int ntiles = tstart[NE + 1];
    for (int i = tid; i < ntiles; i += NTHR) {
        int lo = 0, hi = NE;
#pragma unroll
        for (int it = 0; it < 7; ++it) { const int mid = (lo + hi + 1) >> 1; if (lo < hi) { if (tstart[mid] <= i) lo = mid; else hi = mid - 1; } }
        tile_e[i] = lo; }
    __syncthreads();
    return ntiles;
}

template <int MODE>
__device__ __forceinline__ void combine_phase(LAS unsigned char* ldsb, int bid, int G, const float* x, const float* gf, const bf16_t* Y, const u32x2* rec,
                                              float* xout, const float* ng, const float* sc, const float* sh, bf16_t* hbuf) {
    const LAS int* tstart = (const LAS int*)(ldsb + LDS_TSTART);
    const int wave0 = tid_fresh() >> 6;
    for (int rowi = bid * 16 + wave0 * 2; rowi < T; rowi += ((rowi & 1) ? (G * 16 - 1) : 1)) {
        const int row = rowi;
        const int lane = tid_fresh() & 63;
        float a[4][8];
#pragma unroll
        for (int i = 0; i < 4; ++i)
#pragma unroll
            for (int q = 0; q < 8; ++q) a[i][q] = 0.f;
        u32x2 rr[TOPK];
#pragma unroll
        for (int j = 0; j < TOPK; ++j) rr[j] = rec[row * TOPK + j];
        float4 xr[4][2];
#pragma unroll
        for (int i = 0; i < 4; ++i) { const int c = lane * 8 + i * 512; xr[i][0] = *(const float4*)(x + (size_t)row * D + c); xr[i][1] = *(const float4*)(x + (size_t)row * D + c + 4); }
#pragma unroll
        for (int jb = 0; jb <= TOPK; jb += 8) {
            u32x2 yv[7][4]; float wj[7];
#pragma unroll
            for (int jj = 0; jj < 7; ++jj) { const int j = jb + jj; if (j > TOPK) break;
                size_t slot = (size_t)SLOT_SH + row; wj[jj] = Y8_INV;
                if (j < TOPK) { const int e = (int)(rr[j].x >> 13), pos = (int)(rr[j].x & 8191u); wj[jj] = __uint_as_float(rr[j].y) * Y8_INV; slot = (size_t)tstart[e] * BM + pos; }
                const unsigned char* yp = (const unsigned char*)Y + slot * D + lane * 8;
#pragma unroll
                for (int i = 0; i < 4; ++i) yv[jj][i] = *(const u32x2*)(yp + i * 512);
            }
#pragma unroll
            for (int jj = 0; jj < 7; ++jj) { const int j = jb + jj; if (j > TOPK) break; const float w = wj[jj];
#pragma unroll
                for (int i = 0; i < 4; ++i) { const u32x2 y2 = yv[jj][i];
                    const f32x2v p0 = __builtin_amdgcn_cvt_pk_f32_fp8((int)y2.x, false), p1 = __builtin_amdgcn_cvt_pk_f32_fp8((int)y2.x, true), p2 = __builtin_amdgcn_cvt_pk_f32_fp8((int)y2.y, false), p3 = __builtin_amdgcn_cvt_pk_f32_fp8((int)y2.y, true);
                    a[i][0] += w * p0.x; a[i][1] += w * p0.y; a[i][2] += w * p1.x; a[i][3] += w * p1.y;
                    a[i][4] += w * p2.x; a[i][5] += w * p2.y; a[i][6] += w * p3.x; a[i][7] += w * p3.y; }
            }
            asm volatile("" ::: "memory");
        }
        float ss = 0.f;
#pragma unroll
        for (int i = 0; i < 4; ++i) { const int c = lane * 8 + i * 512;
#pragma unroll
            for (int h = 0; h < 2; ++h) { const float4 xv = xr[i][h], gv = *(const float4*)(gf + c + h * 4);
                a[i][h * 4 + 0] = xv.x + gv.x * a[i][h * 4 + 0]; a[i][h * 4 + 1] = xv.y + gv.y * a[i][h * 4 + 1]; a[i][h * 4 + 2] = xv.z + gv.z * a[i][h * 4 + 2]; a[i][h * 4 + 3] = xv.w + gv.w * a[i][h * 4 + 3]; }
#pragma unroll
            for (int q = 0; q < 8; ++q) ss += a[i][q] * a[i][q]; }
        if (MODE == 0 || MODE == 2) {
#pragma unroll
            for (int i = 0; i < 4; ++i) { float* op = xout + (size_t)row * D + lane * 8 + i * 512; *(float4*)op = make_float4(a[i][0], a[i][1], a[i][2], a[i][3]); *(float4*)(op + 4) = make_float4(a[i][4], a[i][5], a[i][6], a[i][7]); }
        }
        if (MODE == 1 || MODE == 2) {
            ss = wave_sum(ss);
            const float r = rsqrtf(ss * (1.f / D) + EPS);
            asm volatile("" ::: "memory");
            float4 g4[4][2];
#pragma unroll
            for (int i = 0; i < 4; ++i) { const int c = lane * 8 + i * 512; g4[i][0] = *(const float4*)(ng + c); g4[i][1] = *(const float4*)(ng + c + 4); }
#pragma unroll
            for (int i = 0; i < 4; ++i) { const int c = lane * 8 + i * 512; float o[8];
                const float gq[8] = {g4[i][0].x, g4[i][0].y, g4[i][0].z, g4[i][0].w, g4[i][1].x, g4[i][1].y, g4[i][1].z, g4[i][1].w};
#pragma unroll
                for (int q = 0; q < 8; ++q) { o[q] = a[i][q] * r * gq[q]; if (MODE == 2) o[q] = o[q] * (1.f + sc[c + q]) + sh[c + q]; }
                if (MODE == 1) { float* op = xout + (size_t)row * D + c; *(float4*)op = make_float4(o[0], o[1], o[2], o[3]); *(float4*)(op + 4) = make_float4(o[4], o[5], o[6], o[7]); }
                else { u32x4 w; w.x = cvt_pk_bf16(o[0], o[1]); w.y = cvt_pk_bf16(o[2], o[3]); w.z = cvt_pk_bf16(o[4], o[5]); w.w = cvt_pk_bf16(o[6], o[7]); *(u32x4*)(hbuf + (size_t)row * D + c) = w; } }
        }
    }
}

constexpr int BG_STEPS = 2 * 3 * 4096 * 8;
struct BgState { float r[64]; bf16_t* dst[2]; int o2[2]; int st; };
__device__ __forceinline__ bool bg_decode(int st, int wg, int NW, int lane, KP kp, const float*& src, int& ldS, bf16_t*& dst, int& o2) {
    const int g = st * NW + wg;
    if (g >= BG_STEPS) { src = kp->in[27] + lane; ldS = 0; dst = nullptr; o2 = 0; return false; }
    const int l = g / 98304, r = g - l * 98304;
    unsigned char* ws = kp->ws;
    if (r < 65536) {
        const int e = r >> 10, kc = (r >> 2) & 255, kind = (r >> 1) & 1, cc = r & 1, n = cc * 256 + lane;
        ldS = FF; o2 = 256 * 8;
        src = kp->in[27 + kind] + ((size_t)(l * NE + e) * D + kc * 8) * FF + n;
        const int drow = (n >> 7) * 256 + kind * 128 + (n & 127);
        dst = (bf16_t*)(ws + WS_WGU) + l * WGU_L + (size_t)e * 1024 * D + ((size_t)kc * 1024 + drow) * 8;
    } else {
        const int r2 = r - 65536, e = r2 >> 9, kc = (r2 >> 3) & 63, cc = r2 & 7, n = cc * 256 + lane;
        ldS = D; o2 = 128 * 8;
        src = kp->in[29] + ((size_t)(l * NE + e) * FF + kc * 8) * D + n;
        dst = (bf16_t*)(ws + WS_WD) + l * WD_L + (size_t)e * D * FF + ((size_t)kc * D + n) * 8;
    }
    return true;
}
template <int NS> __device__ __forceinline__ void bg_issue(BgState& b, int wg, int NW, int lane) {
    KP kp = kparams();
#pragma unroll
    for (int s = 0; s < NS; ++s) { const float* src; int ldS; bf16_t* dst; int o2;
        bg_decode(b.st + s, wg, NW, lane, kp, src, ldS, dst, o2);
        b.dst[s] = dst; b.o2[s] = o2;
#pragma unroll
        for (int i = 0; i < 8; ++i) { const float* p = src + (size_t)i * ldS;
            asm volatile("global_load_dword %0, %4, off\n\tglobal_load_dword %1, %4, off offset:256\n\tglobal_load_dword %2, %4, off offset:512\n\tglobal_load_dword %3, %4, off offset:768"
                         : "=&v"(b.r[(s * 8 + i) * 4 + 0]), "=&v"(b.r[(s * 8 + i) * 4 + 1]), "=&v"(b.r[(s * 8 + i) * 4 + 2]), "=&v"(b.r[(s * 8 + i) * 4 + 3]) : "v"(p) : "memory"); }
    }
}
#define BG_TIE16(o) "+v"(b.r[o + 0]), "+v"(b.r[o + 1]), "+v"(b.r[o + 2]), "+v"(b.r[o + 3]), "+v"(b.r[o + 4]), "+v"(b.r[o + 5]), "+v"(b.r[o + 6]), "+v"(b.r[o + 7]), "+v"(b.r[o + 8]), "+v"(b.r[o + 9]), "+v"(b.r[o + 10]), "+v"(b.r[o + 11]), "+v"(b.r[o + 12]), "+v"(b.r[o + 13]), "+v"(b.r[o + 14]), "+v"(b.r[o + 15])
template <int NS> __device__ __forceinline__ void bg_finish(BgState& b, int wg, int NW, int lane) {
    asm volatile("s_waitcnt vmcnt(0)" ::: "memory");
    asm volatile("" : BG_TIE16(0) :: "memory");
    asm volatile("" : BG_TIE16(16) :: "memory");
    if (NS == 2) { asm volatile("" : BG_TIE16(32) :: "memory"); asm volatile("" : BG_TIE16(48) :: "memory"); }
#pragma unroll
    for (int s = 0; s < NS; ++s) { bf16_t* dst = b.dst[s];
        if (dst != nullptr) {
#pragma unroll
            for (int c = 0; c < 4; ++c) { u32x4 w;
                w.x = cvt_pk_bf16(b.r[(s * 8 + 0) * 4 + c], b.r[(s * 8 + 1) * 4 + c]); w.y = cvt_pk_bf16(b.r[(s * 8 + 2) * 4 + c], b.r[(s * 8 + 3) * 4 + c]);
                w.z = cvt_pk_bf16(b.r[(s * 8 + 4) * 4 + c], b.r[(s * 8 + 5) * 4 + c]); w.w = cvt_pk_bf16(b.r[(s * 8 + 6) * 4 + c], b.r[(s * 8 + 7) * 4 + c]);
                bf16_t* dp = dst + (c & 1) * 512 + (c >> 1) * b.o2[s];
                asm volatile("global_store_dwordx4 %0, %1, off\n\ts_nop 1" :: "v"(dp), "v"(w) : "memory"); }
        } }
    b.st += NS;
}
template <int BANK> __device__ __forceinline__ void bg_issue1(BgState& b, int wg, int NW, int lane) {
    KP kp = kparams();
    const float* src; int ldS; bf16_t* dst; int o2;
    bg_decode(b.st, wg, NW, lane, kp, src, ldS, dst, o2);
    b.dst[BANK] = dst; b.o2[BANK] = o2;
    asm volatile("s_nop 6" ::: "memory");
#pragma unroll
    for (int i = 0; i < 8; ++i) { const float* p = src + (size_t)i * ldS;
        asm volatile("global_load_dword %0, %4, off\n\tglobal_load_dword %1, %4, off offset:256\n\tglobal_load_dword %2, %4, off offset:512\n\tglobal_load_dword %3, %4, off offset:768"
                     : "=&v"(b.r[(BANK * 8 + i) * 4 + 0]), "=&v"(b.r[(BANK * 8 + i) * 4 + 1]), "=&v"(b.r[(BANK * 8 + i) * 4 + 2]), "=&v"(b.r[(BANK * 8 + i) * 4 + 3]) : "v"(p) : "memory"); }
    b.st += 1;
}
template <int BANK, int WAITN> __device__ __forceinline__ void bg_finish1(BgState& b) {
    if (WAITN == 32) asm volatile("s_waitcnt vmcnt(32)" ::: "memory"); else asm volatile("s_waitcnt vmcnt(0)" ::: "memory");
    asm volatile("" : BG_TIE16(BANK * 32) :: "memory");
    asm volatile("" : BG_TIE16(BANK * 32 + 16) :: "memory");
    bf16_t* dst = b.dst[BANK];
    if (dst != nullptr) {
#pragma unroll
        for (int c = 0; c < 4; ++c) { u32x4 w;
            w.x = cvt_pk_bf16(b.r[(BANK * 8 + 0) * 4 + c], b.r[(BANK * 8 + 1) * 4 + c]); w.y = cvt_pk_bf16(b.r[(BANK * 8 + 2) * 4 + c], b.r[(BANK * 8 + 3) * 4 + c]);
            w.z = cvt_pk_bf16(b.r[(BANK * 8 + 4) * 4 + c], b.r[(BANK * 8 + 5) * 4 + c]); w.w = cvt_pk_bf16(b.r[(BANK * 8 + 6) * 4 + c], b.r[(BANK * 8 + 7) * 4 + c]);
            bf16_t* dp = dst + (c & 1) * 512 + (c >> 1) * b.o2[BANK];
            asm volatile("global_store_dwordx4 %0, %1, off\n\ts_nop 1" :: "v"(dp), "v"(w) : "memory"); }
    }
}
#undef BG_TIE16

constexpr size_t BIG_U    = 0;
constexpr size_t BIG_X0C  = (size_t)104857600;
constexpr size_t BIG_VGT  = (size_t)146800640;
constexpr size_t BIG_A3   = (size_t)220200960;
constexpr size_t BIG_GSPEC = (size_t)230686720;
#define FFT_HD __device__ __forceinline__
typedef float cf2 __attribute__((ext_vector_type(2)));
FFT_HD cf2 mk2(float x, float y) { return (cf2){x, y}; }
FFT_HD void fft_sincos(float frac, float& s, float& c) { s = __builtin_amdgcn_sinf(frac); c = __builtin_amdgcn_cosf(frac); }
constexpr int FN = 16384;
#define PADI(n) ((n) + (((n) >> 6) << 1))
constexpr int FN_PAD = FN + (FN >> 6) * 2;
FFT_HD cf2 cmul(cf2 a, cf2 b) { return mk2(a.x * b.x - a.y * b.y, a.x * b.y + a.y * b.x); }
FFT_HD cf2 cmulc(cf2 a, cf2 b) { return mk2(a.x * b.x + a.y * b.y, a.y * b.x - a.x * b.y); }
FFT_HD cf2 cadd(cf2 a, cf2 b) { return mk2(a.x + b.x, a.y + b.y); }
FFT_HD cf2 csub(cf2 a, cf2 b) { return mk2(a.x - b.x, a.y - b.y); }
template <bool INV> FFT_HD void dft4(cf2& a, cf2& b, cf2& c, cf2& d) {
    const cf2 s0 = cadd(a, c), s1 = csub(a, c), s2 = cadd(b, d), s3 = csub(b, d);
    a = cadd(s0, s2); c = csub(s0, s2);
    const cf2 r = INV ? mk2(-s3.y, s3.x) : mk2(s3.y, -s3.x);
    b = cadd(s1, r); d = csub(s1, r);
}
template <bool INV> FFT_HD void dft16(cf2 (&x)[16]) {
    const float C1 = 0.9238795325112867f, S1 = 0.3826834323650898f, H = 0.7071067811865476f;
#pragma unroll
    for (int b = 0; b < 4; ++b) dft4<INV>(x[b], x[4 + b], x[8 + b], x[12 + b]);
    const float s = INV ? -1.f : 1.f;
    x[4 + 1] = cmul(x[4 + 1], mk2(C1, -s * S1)); x[8 + 1] = cmul(x[8 + 1], mk2(H, -s * H));   x[12 + 1] = cmul(x[12 + 1], mk2(S1, -s * C1));
    x[4 + 2] = cmul(x[4 + 2], mk2(H, -s * H));   x[8 + 2] = cmul(x[8 + 2], mk2(0.f, -s));     x[12 + 2] = cmul(x[12 + 2], mk2(-H, -s * H));
    x[4 + 3] = cmul(x[4 + 3], mk2(S1, -s * C1)); x[8 + 3] = cmul(x[8 + 3], mk2(-H, -s * H));  x[12 + 3] = cmul(x[12 + 3], mk2(-C1, s * S1));
#pragma unroll
    for (int c = 0; c < 4; ++c) dft4<INV>(x[4 * c], x[4 * c + 1], x[4 * c + 2], x[4 * c + 3]);
#pragma unroll
    for (int c = 0; c < 4; ++c)
#pragma unroll
        for (int d = c + 1; d < 4; ++d) { const cf2 t = x[4 * c + d]; x[4 * c + d] = x[4 * d + c]; x[4 * d + c] = t; }
}
FFT_HD void fft_gen_tw(float frac, cf2 (&tw)[16]) {
    float sn, cs; fft_sincos(frac, sn, cs);
    tw[1] = mk2(cs, -sn);
    tw[2] = cmul(tw[1], tw[1]); tw[3] = cmul(tw[2], tw[1]); tw[4] = cmul(tw[2], tw[2]); tw[5] = cmul(tw[4], tw[1]); tw[6] = cmul(tw[4], tw[2]); tw[7] = cmul(tw[4], tw[3]);
    tw[8] = cmul(tw[4], tw[4]);
#pragma unroll
    for (int j = 9; j < 16; ++j) tw[j] = cmul(tw[8], tw[j - 8]);
}
template <bool INV, int lS, class ZP> FFT_HD void fft_r16_pass(ZP z, int tid) {
    constexpr int S = 1 << lS, STEP = (S >= 64) ? S + S / 32 : S;
    constexpr float inv = 1.0f / (float)(16 * S);
    cf2 tw[16];
    if (lS != 10) {
        fft_gen_tw((float)(tid & (S - 1)) * inv, tw);
        const int w0 = tid, w1 = tid + 512;
        const int pb0 = PADI(((w0 >> lS) << (lS + 4)) + (w0 & (S - 1))), pb1 = PADI(((w1 >> lS) << (lS + 4)) + (w1 & (S - 1)));
        cf2 x[16], y[16];
#pragma unroll
        for (int j = 0; j < 16; ++j) x[j] = z[pb0 + j * STEP];
#pragma unroll
        for (int j = 0; j < 16; ++j) y[j] = z[pb1 + j * STEP];
        if (INV) {
#pragma unroll
            for (int j = 1; j < 16; ++j) x[j] = cmulc(x[j], tw[j]);
        }
        dft16<INV>(x);
        if (!INV) {
#pragma unroll
            for (int j = 1; j < 16; ++j) x[j] = cmul(x[j], tw[j]);
        }
#pragma unroll
        for (int j = 0; j < 16; ++j) z[pb0 + j * STEP] = x[j];
        if (INV) {
#pragma unroll
            for (int j = 1; j < 16; ++j) y[j] = cmulc(y[j], tw[j]);
        }
        dft16<INV>(y);
        if (!INV) {
#pragma unroll
            for (int j = 1; j < 16; ++j) y[j] = cmul(y[j], tw[j]);
        }
#pragma unroll
        for (int j = 0; j < 16; ++j) z[pb1 + j * STEP] = y[j];
    } else {
#pragma unroll 1
        for (int it = 0; it < 2; ++it) {
            const int w = tid + 512 * it;
            const int blk = w >> lS, p = w & (S - 1), pb = PADI((blk << (lS + 4)) + p);
            fft_gen_tw((float)p * inv, tw);
            cf2 x[16];
#pragma unroll
            for (int j = 0; j < 16; ++j) x[j] = z[pb + j * STEP];
            if (INV) {
#pragma unroll
                for (int j = 1; j < 16; ++j) x[j] = cmulc(x[j], tw[j]);
            }
            dft16<INV>(x);
            if (!INV) {
#pragma unroll
                for (int j = 1; j < 16; ++j) x[j] = cmul(x[j], tw[j]);
            }
#pragma unroll
            for (int j = 0; j < 16; ++j) z[pb + j * STEP] = x[j];
        }
    }
}
template <bool INV, class ZP> FFT_HD void fft_r4_pass(ZP z, int tid, int nthr) {
    for (int w = tid; w < FN / 4; w += nthr) {
        const int base = PADI(4 * w);
        cf2 a = z[base], b = z[base + 1], c = z[base + 2], d = z[base + 3];
        dft4<INV>(a, b, c, d);
        z[base] = a; z[base + 1] = b; z[base + 2] = c; z[base + 3] = d;
    }
}
FFT_HD int fpos(int k) { return ((k & 15) << 10) + (((k >> 4) & 15) << 6) + (((k >> 8) & 15) << 2) + (k >> 12); }

__device__ __forceinline__ void hy_filter_mlp(LAS float* sm, int bid, int G, const float* w0, const float* b0, const float* w1, const float* b1, const float* w2, const float* b2, const float* freq, float* a3) {
    const int tid = tid_fresh(), lane = tid & 63, wave = tid >> 6;
    LAS float* w0s = sm; LAS float* w1s = sm + 33 * 64; LAS float* w2s = w1s + 4096;
    __syncthreads();
    for (int i = tid; i < 33 * 64; i += NTHR) w0s[i] = w0[i];
    for (int i = tid; i < 4096; i += NTHR) { w1s[i] = w1[i]; w2s[i] = w2[i]; }
    __syncthreads();
    const float fr = freq[lane], bb0 = b0[lane], bb1 = b1[lane], bb2 = b2[lane];
    for (int row = bid * 8 + wave; row < T; row += G * 8) {
        const float tn = (float)row / (float)(T - 1);
        const float ang = 6.283185307179586f * (float)row / (float)T;
        float zi = 0.f;
        if (lane == 0) zi = tn;
        else if (lane <= 16) { const float band = 1e-4f + (float)(lane - 1) * ((15.f - 1e-4f) / 15.f); zi = cosf(ang * band); }
        else if (lane <= 32) { const float band = 1e-4f + (float)(lane - 17) * ((15.f - 1e-4f) / 15.f); zi = -sinf(ang * band); }
        float acc = bb0;
#pragma unroll 1
        for (int i = 0; i < 33; ++i) acc += __shfl(zi, i) * w0s[i * 64 + lane];
        float a = sinf(fr * acc);
        acc = bb1;
#pragma unroll 4
        for (int i = 0; i < 64; ++i) acc += __shfl(a, i) * w1s[i * 64 + lane];
        a = sinf(fr * acc);
        acc = bb2;
#pragma unroll 4
        for (int i = 0; i < 64; ++i) acc += __shfl(a, i) * w2s[i * 64 + lane];
        a = sinf(fr * acc);
        a3[(size_t)row * 64 + lane] = a;
    }
    __syncthreads();
}

__device__ __forceinline__ void hy_conv_phase(LAS unsigned char* lds, int bid, int G, const bf16_t* u, const float* cw, const float* cb, bf16_t* x0c, bf16_t* vgT) {
    LAS float* sm = (LAS float*)lds;
    const int tid = tid_fresh();
#define HC_LOAD(tile_, v_) do { const int t0_ = ((tile_) >> 5) * 64, c0_ = ((tile_) & 31) * 64; \
        _Pragma("unroll") for (int it = 0; it < 4; ++it) { const int id0 = tid + NTHR * it, id = id0 < 3 * 66 * 8 ? id0 : 3 * 66 * 8 - 1; \
            const int g = id / 528, r = id - g * 528, row = r >> 3, ch = r & 7, t1 = t0_ - 1 + row, t = t1 < 0 ? 0 : (t1 > T - 1 ? T - 1 : t1); \
            v_[it] = *(const u32x4*)(u + (size_t)t * 6144 + g * 2048 + c0_ + ch * 8); } } while (0)
    u32x4 pv[4];
    if (bid < 4096) HC_LOAD(bid, pv);
    float wa[8], wb[8], wc_[8], wd[8]; float p0 = 0.f, p1 = 0.f, p2 = 0.f, pb = 0.f, q0 = 0.f, q1 = 0.f, q2 = 0.f, qb = 0.f; int cwc0 = -1;
    for (int tile = bid; tile < 4096; tile += G) {
        const int t0 = (tile >> 5) * 64, c0 = (tile & 31) * 64;
        if (c0 != cwc0) { cwc0 = c0;
#pragma unroll
            for (int q = 0; q < 8; ++q) { const int cc = c0 + (tid & 7) * 8 + q; wa[q] = cw[cc]; wb[q] = cw[6144 + cc]; wc_[q] = cw[12288 + cc]; wd[q] = cb[cc]; }
            const int c1 = 2048 + c0 + (tid >> 3), c2 = 4096 + c0 + (tid >> 3);
            p0 = cw[c1]; p1 = cw[6144 + c1]; p2 = cw[12288 + c1]; pb = cb[c1]; q0 = cw[c2]; q1 = cw[6144 + c2]; q2 = cw[12288 + c2]; qb = cb[c2]; }
        __syncthreads();
#pragma unroll
        for (int it = 0; it < 4; ++it) { const int id = tid + NTHR * it;
            if (id < 3 * 66 * 8) { const int g = id / 528, r = id - g * 528, row = r >> 3, ch = r & 7; const u32x4 v = pv[it];
                const int tr = t0 - 1 + row; const float mk = (tr >= 0 && tr < T) ? 1.f : 0.f;
                LAS float* dp = sm + (g * 66 + row) * 65 + ch * 8;
                dp[0] = bf_lo(v.x) * mk; dp[1] = bf_hi(v.x) * mk; dp[2] = bf_lo(v.y) * mk; dp[3] = bf_hi(v.y) * mk; dp[4] = bf_lo(v.z) * mk; dp[5] = bf_hi(v.z) * mk; dp[6] = bf_lo(v.w) * mk; dp[7] = bf_hi(v.w) * mk; } }
        if (tile + G < 4096) HC_LOAD(tile + G, pv);
        __syncthreads();
        {   const int t = tid >> 3, ch = tid & 7; float o[8];
#pragma unroll
            for (int q = 0; q < 8; ++q) { const int c = ch * 8 + q;
                o[q] = sm[t * 65 + c] * wa[q] + sm[(t + 1) * 65 + c] * wb[q] + sm[(t + 2) * 65 + c] * wc_[q] + wd[q]; }
            u32x4 w; w.x = cvt_pk_bf16(o[0], o[1]); w.y = cvt_pk_bf16(o[2], o[3]); w.z = cvt_pk_bf16(o[4], o[5]); w.w = cvt_pk_bf16(o[6], o[7]);
            *(u32x4*)(x0c + (size_t)(t0 + t) * D + c0 + ch * 8) = w; }
        {   const int c = tid >> 3, tc = tid & 7;
            float o[8];
#pragma unroll
            for (int q = 0; q < 8; ++q) { const int t = tc * 8 + q;
                const float x1 = sm[(66 + t) * 65 + c] * p0 + sm[(66 + t + 1) * 65 + c] * p1 + sm[(66 + t + 2) * 65 + c] * p2 + pb;
                const float vv = sm[(132 + t) * 65 + c] * q0 + sm[(132 + t + 1) * 65 + c] * q1 + sm[(132 + t + 2) * 65 + c] * q2 + qb;
                o[q] = x1 * vv; }
            u32x4 w; w.x = cvt_pk_bf16(o[0], o[1]); w.y = cvt_pk_bf16(o[2], o[3]); w.z = cvt_pk_bf16(o[4], o[5]); w.w = cvt_pk_bf16(o[6], o[7]);
            *(u32x4*)(vgT + (size_t)(c0 + c) * T + t0 + tc * 8) = w; }
    }
#undef HC_LOAD
    __syncthreads();
}

#define SEG_LD32(dst, off, base) asm volatile("global_load_dword %0, %1, %2" : "=v"(dst) : "v"(off), "s"(base) : "memory")
#define SEG_LD64(dst, off, base) asm volatile("global_load_dwordx2 %0, %1, %2" : "=v"(dst) : "v"(off), "s"(base) : "memory")
#define SEG_WAIT() asm volatile("s_waitcnt vmcnt(32)\n\ts_nop 7" ::: "memory")
#define SEG_TIE8(a, o) "+v"(a[o + 0]), "+v"(a[o + 1]), "+v"(a[o + 2]), "+v"(a[o + 3]), "+v"(a[o + 4]), "+v"(a[o + 5]), "+v"(a[o + 6]), "+v"(a[o + 7])
constexpr int GS_LD = 8256;
__device__ __forceinline__ void hy_fft_phase(LAS unsigned char* lds, int bid, int G, const bf16_t* vgT, bf16_t* zT, const float* a3, const float* wout, const float* skip, float* filt, float4* gspec) {
    LAS cf2* z = (LAS cf2*)lds;
    bf16_t* F = (bf16_t*)filt + (size_t)bid * 8 * FN;
    u32x2* GS = (u32x2*)gspec + (size_t)bid * GS_LD;
    BgState bg; bg.st = 0; const int bgNW = G * 8; int bgwg, bglane;
    { const int t0_ = tid_fresh(); bgwg = __builtin_amdgcn_readfirstlane(bid * 8 + (t0_ >> 6)); bglane = t0_ & 63; }
#define BG_BEGIN(ns) bg_issue<ns>(bg, bgwg, bgNW, bglane)
#define BG_END(ns) bg_finish<ns>(bg, bgwg, bgNW, bglane)
#define BG_I(x) bg_issue1<x>(bg, bgwg, bgNW, bglane)
#define BG_F(y) bg_finish1<y, 32>(bg)
    const int nch = (D - bid + G - 1) / G;
    for (int g0 = 0; g0 < nch; g0 += 8) {
#pragma unroll 1
        for (int rept_ = 0; rept_ < REP_TAP; ++rept_)
        {
            const int tid = tid_fresh(), lane = tid & 63, wave = tid >> 6, col = lane & 15, kc = lane >> 4;
            const int ci = g0 + (col >> 1), c = bid + G * ci; const bool cok = ci < nch;
            bf16x8 bw[2];
#pragma unroll
            for (int ks = 0; ks < 2; ++ks) { float wv[8];
#pragma unroll
                for (int q = 0; q < 8; ++q) wv[q] = wout[(size_t)(ks * 32 + kc * 8 + q) * 4096 + (col & 1) * D + (cok ? c : bid)] * (cok ? 1.f : 0.f);
                u32x4 w; w.x = cvt_pk_bf16(wv[0], wv[1]); w.y = cvt_pk_bf16(wv[2], wv[3]); w.z = cvt_pk_bf16(wv[4], wv[5]); w.w = cvt_pk_bf16(wv[6], wv[7]);
                bw[ks] = __builtin_bit_cast(bf16x8, w); }
            const float dlo = -15.350567286626973f, dhi = -3.0701134573253946f;
            const float delta = fabsf(dlo + (float)c * ((dhi - dlo) / (float)(D - 1)));
            __syncthreads();
            auto tap_load = [&](int blk, float4 (&av)[4]) {
                const float* ap = a3 + (size_t)(blk * 16 + col) * 64 + kc * 8;
                av[0] = *(const float4*)(ap); av[1] = *(const float4*)(ap + 4); av[2] = *(const float4*)(ap + 32); av[3] = *(const float4*)(ap + 36);
            };
            auto tap_blk = [&](int blk, const float4 (&av)[4]) {
                f32x4 acc = (f32x4){0.f, 0.f, 0.f, 0.f};
#pragma unroll
                for (int ks = 0; ks < 2; ++ks) { const float4 a0 = av[ks * 2], a1 = av[ks * 2 + 1];
                    u32x4 w; w.x = cvt_pk_bf16(a0.x, a0.y); w.y = cvt_pk_bf16(a0.z, a0.w); w.z = cvt_pk_bf16(a1.x, a1.y); w.w = cvt_pk_bf16(a1.z, a1.w);
                    acc = __builtin_amdgcn_mfma_f32_16x16x32_bf16(__builtin_bit_cast(bf16x8, w), bw[ks], acc, 0, 0, 0); }
                const int tb = blk * 16 + kc * 4;
                float4 o;
                o.x = acc[0] * expf(-((float)(tb + 0) / (float)(T - 1)) * delta); o.y = acc[1] * expf(-((float)(tb + 1) / (float)(T - 1)) * delta);
                o.z = acc[2] * expf(-((float)(tb + 2) / (float)(T - 1)) * delta); o.w = acc[3] * expf(-((float)(tb + 3) / (float)(T - 1)) * delta);
                bf16_t* Arow = F + (size_t)(col >> 1) * FN;
                if ((col & 1) == 0) { u32x2 w; w.x = cvt_pk_bf16(o.x, o.y); w.y = cvt_pk_bf16(o.z, o.w); *(u32x2*)(Arow + tb) = w; }
                else {
                    Arow[FN - tb - 3] = (bf16_t)(cvt_pk_bf16(o.w, 0.f) & 0xffffu);
                    *(unsigned*)(Arow + FN - tb - 2) = cvt_pk_bf16(o.z, o.y);
                    if (tb > 0) Arow[FN - tb] = (bf16_t)(cvt_pk_bf16(o.x, 0.f) & 0xffffu); else Arow[T] = (bf16_t)0;
                }
            };
            BG_I(0);
#pragma unroll 1
            for (int ob = 0; ob < 8; ob += 2) {
                BG_I(1);
#define TAP_GROUP(b0) do { float4 av_[4][4]; \
                    _Pragma("unroll") for (int bi = 0; bi < 4; ++bi) tap_load(wave + 8 * ((b0) + bi), av_[bi]); \
                    _Pragma("unroll") for (int bi = 0; bi < 4; ++bi) tap_blk(wave + 8 * ((b0) + bi), av_[bi]); } while (0)
                TAP_GROUP(ob * 8); TAP_GROUP(ob * 8 + 4);
                BG_F(0);
                BG_I(0);
                TAP_GROUP((ob + 1) * 8); TAP_GROUP((ob + 1) * 8 + 4);
#undef TAP_GROUP
                BG_F(1);
            }
            __syncthreads();
        }
        int tid = tid_fresh();
#define FFT_FWD_ALL() do { tid = tid_fresh(); BG_I(0); fft_r16_pass<false, 10>(z, tid); __syncthreads(); BG_F(1); BG_I(1); fft_r16_pass<false, 6>(z, tid); __syncthreads(); BG_F(0); BG_I(0); fft_r16_pass<false, 2>(z, tid); __syncthreads(); BG_F(1); BG_I(1); fft_r4_pass<false>(z, tid, NTHR); __syncthreads(); BG_F(0); } while (0)
        for (int ci = g0; ci < g0 + 8 && ci < nch; ci += 2) {
            const bool has2 = (ci + 1 < nch);
            const int c1 = bid + G * ci, c2 = has2 ? bid + G * (ci + 1) : c1;
            const bf16_t* A1 = F + (size_t)(ci - g0) * FN; const bf16_t* A2 = has2 ? A1 + FN : A1;
            const bf16_t* v1 = vgT + (size_t)c1 * T; const bf16_t* v2 = vgT + (size_t)c2 * T;
            __syncthreads();
#pragma unroll 1
            for (int rep_ = 0; rep_ < REP_F1; ++rep_) {
            tid = tid_fresh();
            {   unsigned pa[16], pb[16]; float sk[2];
                const float* skp = skip; asm volatile("" : "+s"(skp));
#pragma unroll
                for (int i = 0; i < 16; ++i) { const unsigned off = 4u * tid + 2048u * i; SEG_LD32(pa[i], off, A1); SEG_LD32(pb[i], off, A2); }
                { const unsigned o1 = 4u * c1, o2 = 4u * c2; SEG_LD32(sk[0], o1, skp); SEG_LD32(sk[1], o2, skp); }
                BG_I(1);
                SEG_WAIT(); asm volatile("" : SEG_TIE8(pa, 0), SEG_TIE8(pa, 8), SEG_TIE8(pb, 0) :: "memory");
                asm volatile("" : SEG_TIE8(pb, 8), "+v"(sk[0]), "+v"(sk[1]) :: "memory");
                const float sk1 = (tid == 0) ? sk[0] : 0.f, sk2 = (tid == 0 && has2) ? sk[1] : 0.f;
#pragma unroll
                for (int i = 0; i < 16; ++i) { const int n = 2 * tid + 2 * NTHR * i;
                    f32x4 fv = (f32x4){bf_lo(pa[i]), has2 ? bf_lo(pb[i]) : 0.f, bf_hi(pa[i]), has2 ? bf_hi(pb[i]) : 0.f};
                    if (i == 0) { fv[0] += sk1; fv[1] += sk2; }
                    *(LAS f32x4*)&z[PADI(n)] = fv; }
                BG_F(0);
            }
            __syncthreads();
            FFT_FWD_ALL();
            tid = tid_fresh();
            BG_I(0);
#pragma unroll 4
            for (int k = tid; k <= FN / 2; k += NTHR) {
                const cf2 zk = z[PADI(fpos(k))], zm = z[PADI(fpos((FN - k) & (FN - 1)))];
                u32x2 g; g.x = cvt_pk_bf16(0.5f * (zk.x + zm.x), 0.5f * (zk.y - zm.y)); g.y = cvt_pk_bf16(0.5f * (zk.y + zm.y), -0.5f * (zk.x - zm.x)); GS[k] = g;
            }
            BG_F(1);
            __syncthreads();
            }
            tid = tid_fresh();
            {   unsigned pa[8], pb[8];
#pragma unroll
                for (int i = 0; i < 8; ++i) { const unsigned off = 4u * tid + 2048u * i; SEG_LD32(pa[i], off, v1); SEG_LD32(pb[i], off, v2); }
                BG_I(1);
                SEG_WAIT(); asm volatile("" : SEG_TIE8(pa, 0), SEG_TIE8(pb, 0) :: "memory");
#pragma unroll
                for (int i = 0; i < 8; ++i) { const int n = 2 * tid + 2 * NTHR * i;
                    *(LAS f32x4*)&z[PADI(n)] = (f32x4){bf_lo(pa[i]), has2 ? bf_lo(pb[i]) : 0.f, bf_hi(pa[i]), has2 ? bf_hi(pb[i]) : 0.f};
                    *(LAS f32x4*)&z[PADI(T + n)] = (f32x4){0.f, 0.f, 0.f, 0.f}; }
                BG_F(0);
            }
            __syncthreads();
            FFT_FWD_ALL();
            tid = tid_fresh();
            {   u32x2 gq[16], gh;
#pragma unroll
                for (int i = 0; i < 16; ++i) { const unsigned off = 8u * tid + 4096u * i; SEG_LD64(gq[i], off, GS); }
                { const unsigned off = 8u * (FN / 2); SEG_LD64(gh, off, GS); }
                BG_I(0);
                SEG_WAIT(); asm volatile("" : SEG_TIE8(gq, 0), SEG_TIE8(gq, 8), "+v"(gh) :: "memory");
#pragma unroll
                for (int i = 0; i < 16; ++i) { const int k = tid + NTHR * i;
                    const int p1 = PADI(fpos(k)), p2 = PADI(fpos((FN - k) & (FN - 1)));
                    const cf2 zk = z[p1], zm = z[p2];
                    const cf2 V1 = mk2(0.5f * (zk.x + zm.x), 0.5f * (zk.y - zm.y)), V2 = mk2(0.5f * (zk.y + zm.y), -0.5f * (zk.x - zm.x));
                    const cf2 Y1 = cmul(V1, mk2(bf_lo(gq[i].x), bf_hi(gq[i].x))), Y2 = cmul(V2, mk2(bf_lo(gq[i].y), bf_hi(gq[i].y)));
                    z[p1] = mk2(Y1.x - Y2.y, Y1.y + Y2.x); z[p2] = mk2(Y1.x + Y2.y, Y2.x - Y1.y); }
                if (tid == 0) { const int k = FN / 2, p1 = PADI(fpos(k)); const cf2 zk = z[p1]; const float4 g1 = make_float4(bf_lo(gh.x), bf_hi(gh.x), bf_lo(gh.y), bf_hi(gh.y));
                    z[p1] = mk2(zk.x * g1.x, zk.y * g1.z); }
                BG_F(1);
            }
            __syncthreads();
            tid = tid_fresh();
            BG_I(1); fft_r4_pass<true>(z, tid, NTHR); __syncthreads(); BG_F(0);
            BG_I(0); fft_r16_pass<true, 2>(z, tid); __syncthreads(); BG_F(1); BG_I(1); fft_r16_pass<true, 6>(z, tid); __syncthreads(); BG_F(0); BG_I(0); fft_r16_pass<true, 10>(z, tid); __syncthreads(); BG_F(1);
            tid = tid_fresh();
            bf16_t* o1 = zT + (size_t)c1 * T; bf16_t* o2 = zT + (size_t)c2 * T;

            {
#pragma unroll
                for (int i = 0; i < 8; ++i) { const int n = 2 * tid + 2 * NTHR * i; const f32x4 y = *(const LAS f32x4*)&z[PADI(n)];
                    *(unsigned*)(o1 + n) = cvt_pk_bf16(y[0] * (1.f / (float)FN), y[2] * (1.f / (float)FN));
                    if (has2) *(unsigned*)(o2 + n) = cvt_pk_bf16(y[1] * (1.f / (float)FN), y[3] * (1.f / (float)FN)); }
            }

        }
        bg_finish1<0, 0>(bg);
#undef FFT_FWD_ALL
    }
    { const int nst = (BG_STEPS + bgNW - 1) / bgNW;
#pragma unroll 1
      while (bg.st < nst) { BG_BEGIN(2); BG_END(2); } }
#undef BG_BEGIN
#undef BG_END
#undef BG_I
#undef BG_F
    __syncthreads();
}

__device__ __forceinline__ void hy_tr_phase(LAS unsigned char* lds, int bid, int G, const bf16_t* zT, const bf16_t* x0c, bf16_t* yA) {
    LAS float* sm = (LAS float*)lds;
    const int tid = tid_fresh();
    const int c = tid >> 3, tc = tid & 7, t = tid >> 3, ch = tid & 7;
#define HT_LOAD(tile_) do { const int t0_ = ((tile_) >> 5) * 64, c0_ = ((tile_) & 31) * 64; pz = *(const u32x4*)(zT + (size_t)(c0_ + c) * T + t0_ + tc * 8); px = *(const u32x4*)(x0c + (size_t)(t0_ + t) * D + c0_ + ch * 8); } while (0)
    u32x4 pz = (u32x4){0u, 0u, 0u, 0u}, px = (u32x4){0u, 0u, 0u, 0u};
    if (bid < 4096) HT_LOAD(bid);
    for (int tile = bid; tile < 4096; tile += G) {
        const int t0 = (tile >> 5) * 64, c0 = (tile & 31) * 64;
        __syncthreads();
        {   LAS float* dp = sm + c * 65 + tc * 8; dp[0] = bf_lo(pz.x); dp[1] = bf_hi(pz.x); dp[2] = bf_lo(pz.y); dp[3] = bf_hi(pz.y); dp[4] = bf_lo(pz.z); dp[5] = bf_hi(pz.z); dp[6] = bf_lo(pz.w); dp[7] = bf_hi(pz.w); }
        const u32x4 xv = px;
        if (tile + G < 4096) HT_LOAD(tile + G);
        __syncthreads();
        {   const size_t off = (size_t)(t0 + t) * D + c0 + ch * 8;
            const LAS float* sp = sm + (ch * 8) * 65 + t;
            u32x4 w; w.x = cvt_pk_bf16(sp[0] * bf_lo(xv.x), sp[65] * bf_hi(xv.x)); w.y = cvt_pk_bf16(sp[130] * bf_lo(xv.y), sp[195] * bf_hi(xv.y));
            w.z = cvt_pk_bf16(sp[260] * bf_lo(xv.z), sp[325] * bf_hi(xv.z)); w.w = cvt_pk_bf16(sp[390] * bf_lo(xv.w), sp[455] * bf_hi(xv.w));
            *(u32x4*)(yA + off) = w; }
    }
#undef HT_LOAD
    __syncthreads();
}

constexpr size_t BIG_GATES = (size_t)283115520;
constexpr size_t BIG_SLOC  = BIG_VGT;
constexpr size_t BIG_ZLOC  = BIG_SLOC + (size_t)2 * 8 * 32 * 256 * 128 * 4;
constexpr size_t BIG_GTOT  = BIG_ZLOC + (size_t)2 * 8 * 32 * 128 * 4;
constexpr int MLC = 256, MLNC = T / MLC;
typedef float f32x4v __attribute__((ext_vector_type(4)));

__device__ __forceinline__ float logsigf(float x) { return fminf(x, 0.f) - log1pf(expf(-fabsf(x))); }

__device__ __forceinline__ void ml_norm_gates_phase(LAS unsigned char* lds, int bid, int G, const float* x, const float* g, const float* sc, const float* sh,
                                                    const float* w_in, const float* gate_b, bf16_t* hbuf, float* gates) {
    LAS float* hfs = (LAS float*)lds;
    LAS float* part = (LAS float*)lds;
    const int tid = tid_fresh();
    const int lane = tid & 63, wave = tid >> 6;
    for (int r0 = bid * 16; r0 < T; r0 += G * 16) {
        __syncthreads();
#pragma unroll 1
        for (int rr = 0; rr < 2; ++rr) {
            const int row = r0 + wave * 2 + rr;
            float4 v[8];
#pragma unroll
            for (int i = 0; i < 8; ++i) v[i] = *(const float4*)(x + (size_t)row * D + (lane + 64 * i) * 4);
            row_norm_mod(v, lane, g, sc, sh);
#pragma unroll
            for (int i = 0; i < 8; ++i) { const int c = (lane + 64 * i) * 4;
                u32x2 w; w.x = cvt_pk_bf16(v[i].x, v[i].y); w.y = cvt_pk_bf16(v[i].z, v[i].w); *(u32x2*)(hbuf + (size_t)row * D + c) = w;
                LAS float* hp = hfs + (wave * 2 + rr) * HFS_LD + c; hp[0] = v[i].x; hp[1] = v[i].y; hp[2] = v[i].z; hp[3] = v[i].w; }
        }
        __syncthreads();
        f32x4 acc[2];
        rows16_matmul<2>(hfs, w_in, 6176, 6144, wave, lane, acc);
        __syncthreads();
#pragma unroll
        for (int jt = 0; jt < 2; ++jt)
#pragma unroll
            for (int r = 0; r < 4; ++r) part[(wave * 16 + (lane >> 4) * 4 + r) * 32 + jt * 16 + (lane & 15)] = acc[jt][r];
        __syncthreads();
        {   const int rl = wave * 2 + (lane >> 5), col = lane & 31;
            float sacc = gate_b[col];
#pragma unroll
            for (int w = 0; w < 8; ++w) sacc += part[(w * 16 + rl) * 32 + col];
            gates[(size_t)(r0 + rl) * 32 + col] = sacc; }
    }
    __syncthreads();
}

__device__ __forceinline__ void ml_conv8(const bf16_t* P, int t, int col, const float* cw, const float* cb, int cch, float scale, float (&o)[8]) {
    const u32x4 z4 = (u32x4){0u, 0u, 0u, 0u};
    const u32x4 v0 = *(const u32x4*)(P + (size_t)t * 6144 + col);
    const u32x4 vm = (t > 0) ? *(const u32x4*)(P + (size_t)(t - 1) * 6144 + col) : z4;
    const u32x4 vp = (t < T - 1) ? *(const u32x4*)(P + (size_t)(t + 1) * 6144 + col) : z4;
    const float m[8] = {bf_lo(vm.x), bf_hi(vm.x), bf_lo(vm.y), bf_hi(vm.y), bf_lo(vm.z), bf_hi(vm.z), bf_lo(vm.w), bf_hi(vm.w)};
    const float c[8] = {bf_lo(v0.x), bf_hi(v0.x), bf_lo(v0.y), bf_hi(v0.y), bf_lo(v0.z), bf_hi(v0.z), bf_lo(v0.w), bf_hi(v0.w)};
    const float p[8] = {bf_lo(vp.x), bf_hi(vp.x), bf_lo(vp.y), bf_hi(vp.y), bf_lo(vp.z), bf_hi(vp.z), bf_lo(vp.w), bf_hi(vp.w)};
#pragma unroll
    for (int q = 0; q < 8; ++q) { const float xv = cw[cch + q] * m[q] + cw[2048 + cch + q] * c[q] + cw[4096 + cch + q] * p[q] + cb[cch + q]; o[q] = xv / (1.f + __expf(-xv)) * scale; }
}

struct Row3 { u32x4 vm, v0, vp; float fm, fp; };
__device__ __forceinline__ Row3 ml_load3(const bf16_t* P, int t, int col) {
    Row3 r;
    const int tm = t > 0 ? t - 1 : 0, tp = t < T - 1 ? t + 1 : T - 1;
    r.v0 = *(const u32x4*)(P + (size_t)t * 6144 + col);
    r.vm = *(const u32x4*)(P + (size_t)tm * 6144 + col);
    r.vp = *(const u32x4*)(P + (size_t)tp * 6144 + col);
    r.fm = t > 0 ? 1.f : 0.f; r.fp = t < T - 1 ? 1.f : 0.f;
    return r;
}
struct Cw8 { float4 a[8]; };
__device__ __forceinline__ Cw8 ml_cw_load(const float* cw, const float* cb, int cch) {
    Cw8 w;
#pragma unroll
    for (int k = 0; k < 3; ++k) { w.a[2 * k] = *(const float4*)(cw + k * 2048 + cch); w.a[2 * k + 1] = *(const float4*)(cw + k * 2048 + cch + 4); }
    w.a[6] = *(const float4*)(cb + cch); w.a[7] = *(const float4*)(cb + cch + 4);
    return w;
}
__device__ __forceinline__ void ml_conv8c(const Row3& r, const Cw8& w, float scale, float (&o)[8]) {
    const float m[8] = {bf_lo(r.vm.x), bf_hi(r.vm.x), bf_lo(r.vm.y), bf_hi(r.vm.y), bf_lo(r.vm.z), bf_hi(r.vm.z), bf_lo(r.vm.w), bf_hi(r.vm.w)};
    const float c[8] = {bf_lo(r.v0.x), bf_hi(r.v0.x), bf_lo(r.v0.y), bf_hi(r.v0.y), bf_lo(r.v0.z), bf_hi(r.v0.z), bf_lo(r.v0.w), bf_hi(r.v0.w)};
    const float p[8] = {bf_lo(r.vp.x), bf_hi(r.vp.x), bf_lo(r.vp.y), bf_hi(r.vp.y), bf_lo(r.vp.z), bf_hi(r.vp.z), bf_lo(r.vp.w), bf_hi(r.vp.w)};
    const float w0[8] = {w.a[0].x, w.a[0].y, w.a[0].z, w.a[0].w, w.a[1].x, w.a[1].y, w.a[1].z, w.a[1].w};
    const float w1[8] = {w.a[2].x, w.a[2].y, w.a[2].z, w.a[2].w, w.a[3].x, w.a[3].y, w.a[3].z, w.a[3].w};
    const float w2[8] = {w.a[4].x, w.a[4].y, w.a[4].z, w.a[4].w, w.a[5].x, w.a[5].y, w.a[5].z, w.a[5].w};
    const float wb[8] = {w.a[6].x, w.a[6].y, w.a[6].z, w.a[6].w, w.a[7].x, w.a[7].y, w.a[7].z, w.a[7].w};
#pragma unroll
    for (int q = 0; q < 8; ++q) { const float xv = (w0[q] * r.fm) * m[q] + w1[q] * c[q] + (w2[q] * r.fp) * p[q] + wb[q]; o[q] = xv / (1.f + __expf(-xv)) * scale; }
}

__device__ __forceinline__ void ml_chunk_gates(int tid, const float* gates, int h, int t0, LAS float* bf, LAS float* cbs, LAS float* gif, LAS float* gib, LAS float* tmpf, LAS float* tmpb) {
    const int lane = tid & 63, wave = tid >> 6;
    float p = 0.f, q = 0.f;
    if (tid < MLC) { const float* gp = gates + (size_t)(t0 + tid) * 32; gif[tid] = gp[h]; gib[tid] = gp[16 + h]; p = logsigf(gp[8 + h]); q = logsigf(gp[24 + h]);
#pragma unroll
        for (int o = 1; o < 64; o <<= 1) { const float v = __shfl_up(p, o); const float w = __shfl_down(q, o); if (lane >= o) p += v; if (lane + o < 64) q += w; }
        if (lane == 63) tmpf[wave] = p;
        if (lane == 0) tmpb[wave] = q; }
    __syncthreads();
    if (tid < MLC) { float ap = 0.f, aq = 0.f;
#pragma unroll
        for (int w = 0; w < 4; ++w) { if (w < wave) ap += tmpf[w]; if (w > wave) aq += tmpb[w]; }
        bf[tid] = p + ap; cbs[tid] = q + aq; }
    __syncthreads();
}

__device__ __forceinline__ void ml_state_phase(LAS unsigned char* lds, int bid, int G, const bf16_t* P, const float* gates, const float* cw, const float* cb, bf16_t* Sloc, float* zloc, float* Gtot) {
    LAS bf16_t* kw = (LAS bf16_t*)lds;
    LAS bf16_t* vT = (LAS bf16_t*)(lds + 36864);
    LAS float* bf = (LAS float*)(lds + 73728); LAS float* cbs = bf + 256; LAS float* gif = bf + 512; LAS float* gib = bf + 768; LAS float* wf = bf + 1024; LAS float* wb = bf + 1280;
    for (int u = bid; u < 8 * MLNC; u += G) {
        const int h = u / MLNC, n = u - h * MLNC, t0 = n * MLC;
        int tid = tid_fresh();
        __syncthreads();
        ml_chunk_gates(tid, gates, h, t0, bf, cbs, gif, gib, wf, wb);
        float Gf = bf[MLC - 1], Gb = cbs[0];
        __syncthreads();
        if (tid < MLC) { wf[tid] = expf(Gf - bf[tid] + gif[tid]); wb[tid] = expf(Gb - cbs[tid] + gib[tid]); }
        if (tid == 0) { Gtot[(0 * 8 + h) * MLNC + n] = Gf; Gtot[(1 * 8 + h) * MLNC + n] = Gb; }
        f32x4v acc[8][4];
#pragma unroll
        for (int m = 0; m < 8; ++m)
#pragma unroll
            for (int q = 0; q < 4; ++q) acc[m][q] = (f32x4v){0.f, 0.f, 0.f, 0.f};
        float zacc = 0.f;
#pragma unroll 1
        for (int sb = 0; sb < 4; ++sb) {
            __syncthreads();
            tid = tid_fresh();
            {
                Row3 rk[2]; u32x4 vv[4]; Cw8 cwk[2];
#pragma unroll
                for (int it = 0; it < 2; ++it) { const int item = tid + NTHR * it, sl = (item >> 2) & 63, dc = (item & 3) + 4 * (item >> 8);
                    cwk[it] = ml_cw_load(cw, cb, 1024 + h * 128 + dc * 8); rk[it] = ml_load3(P, t0 + sb * 64 + sl, 1024 + h * 128 + dc * 8); }
#pragma unroll
                for (int it = 0; it < 4; ++it) { const int item = tid + NTHR * it, sl = (item >> 2) & 63, ec = (item & 3) + 4 * (item >> 8);
                    vv[it] = *(const u32x4*)(P + (size_t)(t0 + sb * 64 + sl) * 6144 + 2048 + h * 256 + ec * 8); }
#pragma unroll
                for (int it = 0; it < 2; ++it) { const int item = tid + NTHR * it, sl = (item >> 2) & 63, dc = (item & 3) + 4 * (item >> 8), sc_ = sb * 64 + sl;
                    float o[8]; ml_conv8c(rk[it], cwk[it], 0.08838834764831845f, o);
                    const float w0 = wf[sc_], w1 = wb[sc_];
#pragma unroll
                    for (int q = 0; q < 8; ++q) { kw[(dc * 8 + q) * 72 + sl] = (bf16_t)(cvt_pk_bf16(o[q] * w0, 0.f) & 0xffffu); kw[(128 + dc * 8 + q) * 72 + sl] = (bf16_t)(cvt_pk_bf16(o[q] * w1, 0.f) & 0xffffu); } }
#pragma unroll
                for (int it = 0; it < 4; ++it) { const int item = tid + NTHR * it, sl = (item >> 2) & 63, ec = (item & 3) + 4 * (item >> 8); const u32x4 v4 = vv[it];
                    LAS bf16_t* vp = vT + (ec * 8) * 72 + sl;
                    vp[0] = (bf16_t)(v4.x & 0xffffu); vp[72] = (bf16_t)(v4.x >> 16); vp[144] = (bf16_t)(v4.y & 0xffffu); vp[216] = (bf16_t)(v4.y >> 16);
                    vp[288] = (bf16_t)(v4.z & 0xffffu); vp[360] = (bf16_t)(v4.z >> 16); vp[432] = (bf16_t)(v4.w & 0xffffu); vp[504] = (bf16_t)(v4.w >> 16); }
            }
            __syncthreads();
            tid = tid_fresh();
            const int lane = tid & 63, wave = __builtin_amdgcn_readfirstlane(tid >> 6), wr = wave >> 2, wc = wave & 3, fr = lane & 15, fq = lane >> 4;
            if (tid < 256) { const LAS bf16_t* kp = kw + tid * 72; float s = 0.f;
#pragma unroll 8
                for (int q = 0; q < 64; ++q) s += __uint_as_float((unsigned)kp[q] << 16);
                zacc += s; }
            __builtin_amdgcn_sched_barrier(0);
#pragma unroll
            for (int ks = 0; ks < 2; ++ks) {
                bf16x8 bfr[4];
#pragma unroll
                for (int q = 0; q < 4; ++q) bfr[q] = *(const LAS bf16x8*)(kw + (wc * 64 + q * 16 + fr) * 72 + ks * 32 + fq * 8);
#pragma unroll
                for (int m = 0; m < 8; ++m) { const bf16x8 afr = *(const LAS bf16x8*)(vT + (wr * 128 + m * 16 + fr) * 72 + ks * 32 + fq * 8);
#pragma unroll
                    for (int q = 0; q < 4; ++q) acc[m][q] = __builtin_amdgcn_mfma_f32_16x16x32_bf16(bfr[q], afr, acc[m][q], 0, 0, 0);
                    if (m & 1) __builtin_amdgcn_sched_barrier(0); }
            }
        }
        tid = tid_fresh();
        const int lane = tid & 63, wave = __builtin_amdgcn_readfirstlane(tid >> 6), wr = wave >> 2, wc = wave & 3, fr = lane & 15, fq = lane >> 4;
#pragma unroll
        for (int m = 0; m < 8; ++m)
#pragma unroll
            for (int q = 0; q < 4; ++q) { const int c = wc * 64 + q * 16 + fq * 4, dir = c >> 7, d = c & 127, e = wr * 128 + m * 16 + fr;
                u32x2 w; w.x = cvt_pk_bf16(acc[m][q][0], acc[m][q][1]); w.y = cvt_pk_bf16(acc[m][q][2], acc[m][q][3]);
                *(u32x2*)(Sloc + ((((size_t)dir * 8 + h) * MLNC + n) * 256 + e) * 128 + d) = w;
                __builtin_amdgcn_sched_barrier(0); }
        if (tid < 256) zloc[(((size_t)(tid >> 7) * 8 + h) * MLNC + n) * 128 + (tid & 127)] = zacc;
    }
    __syncthreads();
}

__device__ __forceinline__ void ml_scan_phase(int bid, int G, bf16_t* Sloc, float* zloc, const float* Gtot) {
    const int tid = tid_fresh();
    for (int item = bid * NTHR + tid; item < 16 * 8192; item += G * NTHR) {
        const int dh = __builtin_amdgcn_readfirstlane(item >> 13), r = item & 8191, dir = dh >> 3;
        const float* gp = Gtot + dh * MLNC;
        bf16_t* base = Sloc + (size_t)dh * MLNC * 32768 + (size_t)r * 4;
        u32x2 loc[MLNC];
#pragma unroll
        for (int step = 0; step < MLNC; ++step) { const int n = dir ? (MLNC - 1 - step) : step; loc[step] = *(const u32x2*)(base + (size_t)n * 32768); }
        float dcy[MLNC];
#pragma unroll
        for (int step = 0; step < MLNC; ++step) { const int n = dir ? (MLNC - 1 - step) : step; dcy[step] = gp[n]; }
        float s0 = 0.f, s1 = 0.f, s2 = 0.f, s3 = 0.f;
#pragma unroll
        for (int step = 0; step < MLNC; ++step) { const int n = dir ? (MLNC - 1 - step) : step;
            u32x2 w; w.x = cvt_pk_bf16(s0, s1); w.y = cvt_pk_bf16(s2, s3); *(u32x2*)(base + (size_t)n * 32768) = w;
            const float dec = expf(dcy[step]);
            s0 = dec * s0 + bf_lo(loc[step].x); s1 = dec * s1 + bf_hi(loc[step].x); s2 = dec * s2 + bf_lo(loc[step].y); s3 = dec * s3 + bf_hi(loc[step].y); }
    }
    for (int item = bid * NTHR + tid; item < 16 * 128; item += G * NTHR) {
        const int dh = __builtin_amdgcn_readfirstlane(item >> 7), r = item & 127, dir = dh >> 3;
        const float* gp = Gtot + dh * MLNC;
        float* base = zloc + (size_t)dh * MLNC * 128 + r;
        float loc[MLNC];
#pragma unroll
        for (int step = 0; step < MLNC; ++step) { const int n = dir ? (MLNC - 1 - step) : step; loc[step] = base[(size_t)n * 128]; }
        float dcy[MLNC];
#pragma unroll
        for (int step = 0; step < MLNC; ++step) { const int n = dir ? (MLNC - 1 - step) : step; dcy[step] = gp[n]; }
        float st = 0.f;
#pragma unroll
        for (int step = 0; step < MLNC; ++step) { const int n = dir ? (MLNC - 1 - step) : step; base[(size_t)n * 128] = st; st = expf(dcy[step]) * st + loc[step]; }
    }
}

__device__ __forceinline__ void ml_out_phase(LAS unsigned char* lds, int bid, int G, const bf16_t* P, const float* gates, const float* cw, const float* cb,
                                             const bf16_t* Sst, const float* zst, const float* head_g, bf16_t* hs) {
    LAS bf16_t* Q  = (LAS bf16_t*)lds;
    LAS bf16_t* ST = (LAS bf16_t*)(lds + 34816);
    LAS bf16_t* Kb = (LAS bf16_t*)(lds + 34816);
    LAS bf16_t* VT = (LAS bf16_t*)(lds + 34816 + 17408);
    LAS bf16_t* PW = (LAS bf16_t*)(lds + 104448);
    LAS float* bf = (LAS float*)(lds + 122880); LAS float* cbs = bf + 256; LAS float* gif = bf + 512; LAS float* gib = bf + 768;
    LAS float* zs = bf + 1024;
    LAS float* tmp = bf + 1280;
#define ML_IDS() tid = tid_fresh(); const int lane = tid & 63, wave = __builtin_amdgcn_readfirstlane(tid >> 6), fr = lane & 15, fq = lane >> 4; const int trel = half * 128 + wave * 16 + fr; LAS bf16_t* pw = PW + wave * 16 * 72; (void)pw; (void)fq; (void)trel
    for (int u = bid; u < 8 * MLNC * 2; u += G) {
        const int half = u & 1, hn = u >> 1, h = hn / MLNC, n = hn - h * MLNC, t0 = n * MLC;
        int tid = tid_fresh();
        __syncthreads();
        ml_chunk_gates(tid, gates, h, t0, bf, cbs, gif, gib, tmp, tmp + 256);
        {   const int dc = tid & 15, tlb = tid >> 4;
            const Cw8 cwq = ml_cw_load(cw, cb, h * 128 + dc * 8);
            Row3 rq[4];
#pragma unroll
            for (int it = 0; it < 4; ++it) rq[it] = ml_load3(P, t0 + half * 128 + tlb + 32 * it, h * 128 + dc * 8);
#pragma unroll
            for (int it = 0; it < 4; ++it) { float o[8]; ml_conv8c(rq[it], cwq, 1.f, o);
                u32x4 w; w.x = cvt_pk_bf16(o[0], o[1]); w.y = cvt_pk_bf16(o[2], o[3]); w.z = cvt_pk_bf16(o[4], o[5]); w.w = cvt_pk_bf16(o[6], o[7]);
                *(LAS u32x4*)(Q + (tlb + 32 * it) * 136 + dc * 8) = w; }
        }
        f32x4v accf[16], accb[16];
#pragma unroll
        for (int q = 0; q < 16; ++q) { accf[q] = (f32x4v){0.f, 0.f, 0.f, 0.f}; accb[q] = (f32x4v){0.f, 0.f, 0.f, 0.f}; }
        Row3 rk[2]; u32x4 vv[4];
#define ML_LOADKV(sbx) do { const int t_ = tid_fresh(); const int dc_ = t_ & 15, slb_ = t_ >> 4; \
            _Pragma("unroll") for (int it = 0; it < 2; ++it) rk[it] = ml_load3(P, t0 + (sbx) * 64 + slb_ + 32 * it, 1024 + h * 128 + dc_ * 8); \
            _Pragma("unroll") for (int it = 0; it < 4; ++it) { const int item = t_ + NTHR * it, sl = (item >> 2) & 63, ec = (item & 3) + 4 * (item >> 8); \
                vv[it] = *(const u32x4*)(P + (size_t)(t0 + (sbx) * 64 + sl) * 6144 + 2048 + h * 256 + ec * 8); } } while (0)
        u32x4 sv[8];
#define ML_LOADS(dirx) do { const int t_ = tid_fresh(); const bf16_t* Sp = Sst + (((size_t)(dirx) * 8 + h) * MLNC + n) * 32768; \
            _Pragma("unroll") for (int it = 0; it < 8; ++it) { const int item = t_ + NTHR * it, e = item >> 4, dc_ = item & 15; sv[it] = *(const u32x4*)(Sp + (size_t)e * 128 + dc_ * 8); } } while (0)
        ML_LOADS(0);
#pragma unroll
        for (int dir = 0; dir < 2; ++dir) {
            __syncthreads();
            tid = tid_fresh();
#pragma unroll
            for (int it = 0; it < 8; ++it) { const int item = tid + NTHR * it, e = item >> 4, dc = item & 15; *(LAS u32x4*)(ST + e * 136 + dc * 8) = sv[it]; }
            if (tid < 128) zs[dir * 128 + tid] = zst[(((size_t)dir * 8 + h) * MLNC + n) * 128 + tid];
            __syncthreads();
            if (dir == 0) ML_LOADS(1); else ML_LOADKV(0);
            ML_IDS();
#pragma unroll 1
            for (int ks = 0; ks < 4; ++ks) {
                const bf16x8 qf = *(const LAS bf16x8*)(Q + (wave * 16 + fr) * 136 + ks * 32 + fq * 8);
#pragma unroll
                for (int q = 0; q < 16; ++q) { const bf16x8 sf = *(const LAS bf16x8*)(ST + (q * 16 + fr) * 136 + ks * 32 + fq * 8);
                    if (dir == 0) accf[q] = __builtin_amdgcn_mfma_f32_16x16x32_bf16(sf, qf, accf[q], 0, 0, 0);
                    else accb[q] = __builtin_amdgcn_mfma_f32_16x16x32_bf16(sf, qf, accb[q], 0, 0, 0);
                    if ((q & 3) == 3) __builtin_amdgcn_sched_barrier(0); }
            }
        }
        float denf, denb;
        {   ML_IDS();
            const float ebf = expf(bf[trel]), ebb = expf(cbs[trel]);
#pragma unroll
            for (int q = 0; q < 16; ++q) { accf[q] *= ebf; accb[q] *= ebb; }
            float pf = 0.f, pb = 0.f; const LAS bf16_t* qp = Q + (wave * 16 + fr) * 136 + fq * 32;
#pragma unroll 8
            for (int d = 0; d < 32; ++d) { const float qv = __uint_as_float((unsigned)qp[d] << 16); pf += qv * zs[fq * 32 + d]; pb += qv * zs[128 + fq * 32 + d]; }
            pf += __shfl_xor(pf, 16); pf += __shfl_xor(pf, 32); pb += __shfl_xor(pb, 16); pb += __shfl_xor(pb, 32);
            denf = ebf * pf; denb = ebb * pb; }
        float sumf = 0.f, sumb = 0.f;
#pragma unroll 1
        for (int sb = 0; sb < 4; ++sb) {
            const bool need_f = (sb * 64 <= half * 128 + 127), need_b = (sb * 64 + 63 >= half * 128);
            __syncthreads();
            tid = tid_fresh();
            {   const int dc = tid & 15, slb = tid >> 4;
                const Cw8 cwk = ml_cw_load(cw, cb, 1024 + h * 128 + dc * 8);
#pragma unroll
                for (int it = 0; it < 2; ++it) { float o[8]; ml_conv8c(rk[it], cwk, 0.08838834764831845f, o);
                    u32x4 w; w.x = cvt_pk_bf16(o[0], o[1]); w.y = cvt_pk_bf16(o[2], o[3]); w.z = cvt_pk_bf16(o[4], o[5]); w.w = cvt_pk_bf16(o[6], o[7]);
                    *(LAS u32x4*)(Kb + (slb + 32 * it) * 136 + dc * 8) = w; }
#pragma unroll
                for (int it = 0; it < 4; ++it) { const int item = tid + NTHR * it, sl = (item >> 2) & 63, ec = (item & 3) + 4 * (item >> 8); const u32x4 v4 = vv[it];
                    LAS bf16_t* vp = VT + (ec * 8) * 72 + sl;
                    vp[0] = (bf16_t)(v4.x & 0xffffu); vp[72] = (bf16_t)(v4.x >> 16); vp[144] = (bf16_t)(v4.y & 0xffffu); vp[216] = (bf16_t)(v4.y >> 16);
                    vp[288] = (bf16_t)(v4.z & 0xffffu); vp[360] = (bf16_t)(v4.z >> 16); vp[432] = (bf16_t)(v4.w & 0xffffu); vp[504] = (bf16_t)(v4.w >> 16); }
            }
            __syncthreads();
            if (sb < 3) ML_LOADKV(sb + 1);
            ML_IDS();
            f32x4v sc[4];
#pragma unroll
            for (int st = 0; st < 4; ++st) sc[st] = (f32x4v){0.f, 0.f, 0.f, 0.f};
#pragma unroll
            for (int ks = 0; ks < 4; ++ks) {
                const bf16x8 qf = *(const LAS bf16x8*)(Q + (wave * 16 + fr) * 136 + ks * 32 + fq * 8);
#pragma unroll
                for (int st = 0; st < 4; ++st) { const bf16x8 kf = *(const LAS bf16x8*)(Kb + (st * 16 + fr) * 136 + ks * 32 + fq * 8);
                    sc[st] = __builtin_amdgcn_mfma_f32_16x16x32_bf16(kf, qf, sc[st], 0, 0, 0); }
            }
#pragma unroll
            for (int dir = 0; dir < 2; ++dir) {
                if (dir == 0 ? !need_f : !need_b) continue;
                const float bt = dir == 0 ? bf[trel] : cbs[trel];
#pragma unroll
                for (int st = 0; st < 4; ++st) { float pv[4];
#pragma unroll
                    for (int r = 0; r < 4; ++r) { const int srel = sb * 64 + st * 16 + fq * 4 + r;
                        const float bs = dir == 0 ? bf[srel] : cbs[srel], gi = dir == 0 ? gif[srel] : gib[srel];
                        const bool ok = dir == 0 ? (srel <= trel) : (srel >= trel);
                        pv[r] = ok ? __expf(bt - bs + gi) * sc[st][r] : 0.f;
                        if (dir == 0) sumf += pv[r]; else sumb += pv[r]; }
                    u32x2 w; w.x = cvt_pk_bf16(pv[0], pv[1]); w.y = cvt_pk_bf16(pv[2], pv[3]);
                    *(LAS u32x2*)(pw + fr * 72 + st * 16 + fq * 4) = w; }
#pragma unroll 1
                for (int ks = 0; ks < 2; ++ks) {
                    const bf16x8 pf = *(const LAS bf16x8*)(pw + fr * 72 + ks * 32 + fq * 8);
#pragma unroll
                    for (int q = 0; q < 16; ++q) { const bf16x8 vf = *(const LAS bf16x8*)(VT + (q * 16 + fr) * 72 + ks * 32 + fq * 8);
                        if (dir == 0) accf[q] = __builtin_amdgcn_mfma_f32_16x16x32_bf16(vf, pf, accf[q], 0, 0, 0);
                        else accb[q] = __builtin_amdgcn_mfma_f32_16x16x32_bf16(vf, pf, accb[q], 0, 0, 0);
                        if ((q & 3) == 3) __builtin_amdgcn_sched_barrier(0); }
                }
            }
        }
        ML_IDS();
        sumf += __shfl_xor(sumf, 16); sumf += __shfl_xor(sumf, 32); sumb += __shfl_xor(sumb, 16); sumb += __shfl_xor(sumb, 32);
        const float invf = 1.f / fmaxf(fabsf(denf + sumf), 1.f), invb = 1.f / fmaxf(fabsf(denb + sumb), 1.f);
        float ss = 0.f;
#pragma unroll
        for (int q = 0; q < 16; ++q) { accf[q] = accf[q] * invf + accb[q] * invb; ss += accf[q][0] * accf[q][0] + accf[q][1] * accf[q][1] + accf[q][2] * accf[q][2] + accf[q][3] * accf[q][3]; }
        ss += __shfl_xor(ss, 16); ss += __shfl_xor(ss, 32);
        const float rn = rsqrtf(ss * (1.f / 256.f) + EPS);
        const size_t tabs = (size_t)t0 + trel;
#pragma unroll
        for (int qb = 0; qb < 16; qb += 8) {
            u32x2 ovv[8]; float4 hgv[8];
#pragma unroll
            for (int qq = 0; qq < 8; ++qq) { const int e = (qb + qq) * 16 + fq * 4; ovv[qq] = *(const u32x2*)(P + tabs * 6144 + 4096 + h * 256 + e); hgv[qq] = *(const float4*)(head_g + h * 256 + e); }
#pragma unroll
            for (int qq = 0; qq < 8; ++qq) { const int q = qb + qq, e = q * 16 + fq * 4; const u32x2 ov = ovv[qq]; const float4 hg = hgv[qq];
                const float o0 = bf_lo(ov.x), o1 = bf_hi(ov.x), o2 = bf_lo(ov.y), o3 = bf_hi(ov.y);
                const float r0 = accf[q][0] * rn * hg.x / (1.f + __expf(-o0)), r1 = accf[q][1] * rn * hg.y / (1.f + __expf(-o1)), r2 = accf[q][2] * rn * hg.z / (1.f + __expf(-o2)), r3 = accf[q][3] * rn * hg.w / (1.f + __expf(-o3));
                u32x2 w; w.x = cvt_pk_bf16(r0, r1); w.y = cvt_pk_bf16(r2, r3);
                *(u32x2*)(hs + tabs * D + h * 256 + e) = w; }
            __builtin_amdgcn_sched_barrier(0); }
    }
    __syncthreads();
#undef ML_IDS
}

__device__ __forceinline__ void norm_phase(int bid, int G, const float* x, const float* g, const float* sc, const float* sh, bf16_t* hbuf) {
    const int tid = tid_fresh(), lane = tid & 63, wave = tid >> 6;
    for (int row = bid * 8 + wave; row < T; row += G * 8) {
        float4 v[8];
#pragma unroll
        for (int i = 0; i < 8; ++i) v[i] = *(const float4*)(x + (size_t)row * D + (lane + 64 * i) * 4);
        row_norm_mod(v, lane, g, sc, sh);
#pragma unroll
        for (int i = 0; i < 8; ++i) { u32x2 w; w.x = cvt_pk_bf16(v[i].x, v[i].y); w.y = cvt_pk_bf16(v[i].z, v[i].w); *(u32x2*)(hbuf + (size_t)row * D + (lane + 64 * i) * 4) = w; }
    }
}

template <int L>
__device__ __forceinline__ void moe_layer(LAS unsigned char* lds, const XcdBarrier& bar, int bid, int G, int vcu, const float* xcur, float* xout) {
    {
        KP kp = kparams(); unsigned char* ws = kp->ws; const float* adl = (const float*)(ws + WS_ADA) + L * 12288;
        route_phase(lds, bid, G, xcur, kp->in[5] + L * D, adl + 4 * D, adl + 3 * D, kp->in[25] + (size_t)L * D * NE, kp->in[26] + L * NE,
                    (bf16_t*)(ws + WS_HBUF), (int*)(ws + WS_CTL + CTL_CNT) + L * 64, (int*)(ws + WS_LIST), (u32x2*)(ws + WS_REC));
    }
    xcd_barrier(bar);
    int ntiles;
    { KP kp = kparams(); ntiles = moe_tables(lds, (int*)(kp->ws + WS_CTL + CTL_CNT) + L * 64); }
    {
        KP kp = kparams(); unsigned char* ws = kp->ws;
        MoeGuOrder S{(const bf16_t*)(ws + WS_HBUF), (const bf16_t*)(ws + WS_WGU) + L * WGU_L, (const int*)(ws + WS_LIST), (const LAS int*)(lds + LDS_TSTART), (const LAS int*)(lds + LDS_TILEE), (const LAS int*)(lds + LDS_CNT), ntiles, G, vcu};
        EpiSwiglu E{(bf16_t*)(ws + WS_H)};
        _Pragma("unroll 1") for (int rep_ = 0; rep_ < REP_GEMM; ++rep_) gemm_phase<EpiSwiglu, MoeGuOrder>(lds, D, S, E);
    }
    xcd_barrier(bar);
    {
        KP kp = kparams(); unsigned char* ws = kp->ws;
        MoeDownOrder S{(const bf16_t*)(ws + WS_H), (const bf16_t*)(ws + WS_WD) + L * WD_L, (const LAS int*)(lds + LDS_TSTART), (const LAS int*)(lds + LDS_TILEE), ntiles, G, vcu};
        EpiF8 E{(unsigned char*)(ws + WS_BIG), D, Y8_SCALE};
        _Pragma("unroll 1") for (int rep_ = 0; rep_ < REP_GEMM; ++rep_) gemm_phase<EpiF8, MoeDownOrder>(lds, FF, S, E);
    }
    xcd_barrier(bar);
    {
        KP kp = kparams(); unsigned char* ws = kp->ws; const float* adl = (const float*)(ws + WS_ADA) + L * 12288;
#pragma unroll 1
        for (int rep_ = 0; rep_ < REP_COMB; ++rep_)
        if (L == 0) combine_phase<0>(lds, bid, G, xcur, adl + 5 * D, (const bf16_t*)(ws + WS_BIG), (const u32x2*)(ws + WS_REC), xout, nullptr, nullptr, nullptr, nullptr);
        else combine_phase<1>(lds, bid, G, xcur, adl + 5 * D, (const bf16_t*)(ws + WS_BIG), (const u32x2*)(ws + WS_REC), kp->out, kp->in[33], nullptr, nullptr, nullptr);
    }
}

__device__ __forceinline__ void hyena_layer(LAS unsigned char* lds, const XcdBarrier& bar, int bid, int G, int vcu) {
    { KP kp = kparams(); unsigned char* ws = kp->ws; const float* adl = (const float*)(ws + WS_ADA);
      for (int rep_ = 0; rep_ < REP_HCT; ++rep_) norm_phase(bid, G, kp->in[0], kp->in[4], adl + 1 * D, adl + 0 * D, (bf16_t*)(ws + WS_HBUF)); }
    xcd_barrier(bar);
    { KP kp = kparams(); unsigned char* ws = kp->ws;
      DenseOrder S; S.init((const bf16_t*)(ws + WS_HBUF), (const bf16_t*)(ws + WS_WHYIN), T, 6144, D, G, vcu);
      EpiBf16 E{(bf16_t*)(ws + WS_BIG + BIG_U), 6144};
      _Pragma("unroll 1") for (int rep_ = 0; rep_ < REP_GEMM; ++rep_) gemm_phase<EpiBf16, DenseOrder>(lds, D, S, E); }
    xcd_barrier(bar);
    { KP kp = kparams(); unsigned char* ws = kp->ws;
      for (int rep_ = 0; rep_ < REP_HCT; ++rep_) hy_conv_phase(lds, bid, G, (const bf16_t*)(ws + WS_BIG + BIG_U), kp->in[7], kp->in[8], (bf16_t*)(ws + WS_BIG + BIG_X0C), (bf16_t*)(ws + WS_BIG + BIG_VGT)); }
    xcd_barrier(bar);
#pragma unroll 1
    for (int rep_ = 0; rep_ < REP_HYF; ++rep_)
    { KP kp = kparams(); unsigned char* ws = kp->ws;
      hy_fft_phase(lds, bid, G, (const bf16_t*)(ws + WS_BIG + BIG_VGT), (bf16_t*)(ws + WS_BIG + BIG_U), (const float*)(ws + WS_BIG + BIG_A3), kp->in[16], kp->in[17], (float*)(ws + WS_XB), (float4*)(ws + WS_BIG + BIG_GSPEC)); }
    xcd_barrier(bar);
    { KP kp = kparams(); unsigned char* ws = kp->ws;
      for (int rep_ = 0; rep_ < REP_HCT; ++rep_) hy_tr_phase(lds, bid, G, (const bf16_t*)(ws + WS_BIG + BIG_U), (const bf16_t*)(ws + WS_BIG + BIG_X0C), (bf16_t*)(ws + WS_HBUF)); }
    xcd_barrier(bar);
    { KP kp = kparams(); unsigned char* ws = kp->ws; const float* adl = (const float*)(ws + WS_ADA);
      DenseOrder S; S.init((const bf16_t*)(ws + WS_HBUF), (const bf16_t*)(ws + WS_WHYOUT), T, D, D, G, vcu);
      EpiResid E{kp->in[0], (float*)(ws + WS_XA), adl + 2 * D};
      _Pragma("unroll 1") for (int rep_ = 0; rep_ < REP_GEMM; ++rep_) gemm_phase<EpiResid, DenseOrder>(lds, D, S, E); }
    xcd_barrier(bar);
}

__device__ __forceinline__ void mlstm_layer(LAS unsigned char* lds, const XcdBarrier& bar, int bid, int G, int vcu) {
    { KP kp = kparams(); unsigned char* ws = kp->ws; const float* adl = (const float*)(ws + WS_ADA) + 12288;
      ml_norm_gates_phase(lds, bid, G, (const float*)(ws + WS_XB), kp->in[4] + D, adl + 1 * D, adl + 0 * D, kp->in[19], kp->in[22], (bf16_t*)(ws + WS_HBUF), (float*)(ws + WS_BIG + BIG_GATES)); }
    xcd_barrier(bar);
    { KP kp = kparams(); unsigned char* ws = kp->ws;
      DenseOrder S; S.init((const bf16_t*)(ws + WS_HBUF), (const bf16_t*)(ws + WS_WMLIN), T, 6144, D, G, vcu);
      EpiBf16 E{(bf16_t*)(ws + WS_BIG + BIG_U), 6144};
      _Pragma("unroll 1") for (int rep_ = 0; rep_ < REP_GEMM; ++rep_) gemm_phase<EpiBf16, DenseOrder>(lds, D, S, E); }
    xcd_barrier(bar);
#pragma unroll 1
    for (int rep_ = 0; rep_ < REP_MLS; ++rep_) {
    { KP kp = kparams(); unsigned char* ws = kp->ws;
      ml_state_phase(lds, bid, G, (const bf16_t*)(ws + WS_BIG + BIG_U), (const float*)(ws + WS_BIG + BIG_GATES), kp->in[20], kp->in[21],
                     (bf16_t*)(ws + WS_BIG + BIG_SLOC), (float*)(ws + WS_BIG + BIG_ZLOC), (float*)(ws + WS_BIG + BIG_GTOT)); }
    xcd_barrier(bar);
    { KP kp = kparams(); unsigned char* ws = kp->ws;
      ml_scan_phase(bid, G, (bf16_t*)(ws + WS_BIG + BIG_SLOC), (float*)(ws + WS_BIG + BIG_ZLOC), (const float*)(ws + WS_BIG + BIG_GTOT)); }
    xcd_barrier(bar);
    { KP kp = kparams(); unsigned char* ws = kp->ws;
      ml_out_phase(lds, bid, G, (const bf16_t*)(ws + WS_BIG + BIG_U), (const float*)(ws + WS_BIG + BIG_GATES), kp->in[20], kp->in[21],
                   (const bf16_t*)(ws + WS_BIG + BIG_SLOC), (const float*)(ws + WS_BIG + BIG_ZLOC), kp->in[23], (bf16_t*)(ws + WS_HBUF)); }
    xcd_barrier(bar);
    }
    { KP kp = kparams(); unsigned char* ws = kp->ws; const float* adl = (const float*)(ws + WS_ADA) + 12288;
      DenseOrder S; S.init((const bf16_t*)(ws + WS_HBUF), (const bf16_t*)(ws + WS_WMLOUT), T, D, D, G, vcu);
      EpiResid E{(const float*)(ws + WS_XB), (float*)(ws + WS_XA), adl + 2 * D};
      _Pragma("unroll 1") for (int rep_ = 0; rep_ < REP_GEMM; ++rep_) gemm_phase<EpiResid, DenseOrder>(lds, D, S, E); }
    xcd_barrier(bar);
}

__global__ void __launch_bounds__(NTHR, 2) fwd(Params p_unused) {
    extern __shared__ __attribute__((aligned(16))) unsigned char lds_raw[];
    LAS unsigned char* lds = (LAS unsigned char*)lds_raw;
    const int G = gridDim.x, bid = blockIdx.x;
    const int vcu = (G % 8 == 0) ? (bid % 8) * (G / 8) + bid / 8 : bid;
    if (threadIdx.x < 4) ((LAS unsigned*)(lds + LDS_MISC))[threadIdx.x] = 0u;
    __syncthreads();
    XcdBarrier bar;
    { KP kp = kparams(); bar = xcd_barrier_post((unsigned*)(kp->ws + WS_CTL), (volatile LAS unsigned*)(lds + LDS_MISC)); }

#pragma unroll 1
    for (int repp_ = 0; repp_ < REP_PRO; ++repp_) {
    { KP kp = kparams(); ada_phase((LAS float*)lds, bid, G, kp->in[1], kp->in[2], kp->in[3], (float*)(kp->ws + WS_ADA)); }
    { KP kp = kparams(); hy_filter_mlp((LAS float*)lds, bid, G, kp->in[9], kp->in[10], kp->in[11], kp->in[12], kp->in[13], kp->in[14], kp->in[15], (float*)(kp->ws + WS_BIG + BIG_A3)); }
    {
        LAS float* tile = (LAS float*)lds;
        { KP kp = kparams(); cvt_group(tile, bid, G, kp->in[6], 0, 6144, D, 6144, (bf16_t*)(kp->ws + WS_WHYIN), 0, 0, 1); }
        { KP kp = kparams(); cvt_group(tile, bid, G, kp->in[18], 0, D, D, D, (bf16_t*)(kp->ws + WS_WHYOUT), 0, 0, 1); }
        { KP kp = kparams(); cvt_group(tile, bid, G, kp->in[19], 0, 6176, D, 6144, (bf16_t*)(kp->ws + WS_WMLIN), 0, 0, 1); }
        { KP kp = kparams(); cvt_group(tile, bid, G, kp->in[24], 0, D, D, D, (bf16_t*)(kp->ws + WS_WMLOUT), 0, 0, 1); }
#pragma unroll 1
        for (int l2 = 0; l2 < 2 * REP_CVT; ++l2) { const int l = l2 & 1;
            KP kp = kparams(); bf16_t* Wgu = (bf16_t*)(kp->ws + WS_WGU) + l * WGU_L; bf16_t* Wd = (bf16_t*)(kp->ws + WS_WD) + l * WD_L;
            cvt_group(tile, bid, G, kp->in[30] + (size_t)l * D * FF, 0, FF, D, FF, Wgu + (size_t)NE * 1024 * D, 0, 1, 1, 1024);
            cvt_group(tile, bid, G, kp->in[31] + (size_t)l * D * FF, 0, FF, D, FF, Wgu + (size_t)NE * 1024 * D, 0, 2, 1, 1024);
            cvt_group(tile, bid, G, kp->in[32] + (size_t)l * FF * D, 0, D, FF, D, Wd + (size_t)NE * D * FF, 0, 0, 1, D);
        }
    }
    }
    xcd_barrier(bar);

    hyena_layer(lds, bar, bid, G, vcu);
    { KP kp = kparams(); moe_layer<0>(lds, bar, bid, G, vcu, (const float*)(kp->ws + WS_XA), (float*)(kp->ws + WS_XB)); }
    asm volatile("s_waitcnt vmcnt(0)" ::: "memory"); __syncthreads();
    mlstm_layer(lds, bar, bid, G, vcu);
    { KP kp = kparams(); moe_layer<1>(lds, bar, bid, G, vcu, (const float*)(kp->ws + WS_XA), nullptr); }
}

extern "C" void kernel_launch(void* const* d_in, const int* in_sizes, int n_in, void* d_out, int out_size, void* d_ws, size_t ws_size, hipStream_t stream) {
    static int grid = 0;
    if (grid == 0) {
        if (n_in != 34 || ws_size < WS_END) { fprintf(stderr, "kernel_launch: n_in %d ws %zu need %zu\n", n_in, ws_size, (size_t)WS_END); grid = -1; return; }
        int dev = 0, cus = 0, per_cu = 0;
        hipGetDevice(&dev); hipDeviceGetAttribute(&cus, hipDeviceAttributeMultiprocessorCount, dev);
        hipFuncSetAttribute((const void*)fwd, hipFuncAttributeMaxDynamicSharedMemorySize, LDS_BYTES);
        hipOccupancyMaxActiveBlocksPerMultiprocessor(&per_cu, (const void*)fwd, NTHR, LDS_BYTES);
        (void)hipGetLastError();
        grid = (per_cu >= 1) ? (cus < 256 ? cus : 256) : -1;
        if (grid < 0) fprintf(stderr, "kernel_launch: occupancy query says 0 blocks per CU\n");
    }
    if (grid < 0) return;
    hipMemsetAsync((char*)d_ws + WS_CTL, 0, CTL_BYTES, stream);
    Params p{};
    for (int i = 0; i < 34; ++i) p.in[i] = (const float*)d_in[i];
    p.out = (float*)d_out; p.ws = (unsigned char*)d_ws;
    hipLaunchKernelGGL(fwd, dim3(grid), dim3(NTHR), LDS_BYTES, stream, p);
}
```

```cpp
#include <hip/hip_runtime.h>
#include <stdint.h>
#include <stdio.h>

#define LAS __attribute__((address_space(3)))
typedef unsigned short bf16_t;
typedef short bf16x8 __attribute__((ext_vector_type(8)));
typedef float f32x4 __attribute__((ext_vector_type(4)));
typedef unsigned u32x4 __attribute__((ext_vector_type(4)));
typedef unsigned u32x2 __attribute__((ext_vector_type(2)));

constexpr int T = 8192, D = 2048, NE = 64, FF = 512, TOPK = 6;
constexpr int NTHR = 512;
constexpr float EPS = 1e-6f;
#define REP_GEMM 1
#define REP_CVT 1
#define REP_MLS 1
#define REP_HYF 1
#define REP_F1 1
#define REP_TAP 1
#define REP_COMB 1
#define REP_PRO 1
#define REP_HCT 1

#define XB_TMO      128
#define XB_XCNT(j)  (256  + 64 * (j))
#define XB_XSUB(j)  (1280 + 64 * (j))
#define XB_XGEN(j)  (2304 + 64 * (j))
#define XB_TOP      3328
#define XB_TOPGEN   3392
#define XCD_BAR_WORDS 3456
#define XB_SPIN_CAP (1u << 18)

__device__ __forceinline__ unsigned xb_ld(unsigned* p)              { return __hip_atomic_load(p, __ATOMIC_RELAXED, __HIP_MEMORY_SCOPE_AGENT); }
__device__ __forceinline__ unsigned xb_add(unsigned* p, unsigned v) { return __hip_atomic_fetch_add(p, v, __ATOMIC_RELAXED, __HIP_MEMORY_SCOPE_AGENT); }
__device__ __forceinline__ unsigned xb_xcc_id() { return (unsigned)__builtin_amdgcn_s_getreg((3 << 11) | 20) & 0xFu; }
#define XB_SPIN(cond, bar) do { unsigned _sp = 0; while (cond) { __builtin_amdgcn_s_sleep(1); \
    if ((++_sp & 255u) == 0u) { if (xb_ld(&(bar)[XB_TMO])) break; if (_sp > XB_SPIN_CAP) { atomicAdd(&(bar)[XB_TMO], 1u); break; } } } } while (0)

struct XcdBarrier { unsigned* bar; unsigned x; volatile LAS unsigned* st; };

__device__ __forceinline__ XcdBarrier xcd_barrier_post(unsigned* bar, volatile LAS unsigned* st) {
    XcdBarrier b; b.bar = bar; b.x = xb_xcc_id(); b.st = st;
    if (threadIdx.x == 0) (void)xb_add(&bar[XB_XCNT(b.x)], 1u);
    return b;
}
__device__ __forceinline__ void xcd_barrier_complete(unsigned* bar, unsigned x, unsigned& nloc, unsigned& nx) {
    const unsigned G = gridDim.x * gridDim.y * gridDim.z;
    unsigned sum, cnt, mine, sp = 0u;
    for (;;) {
        sum = 0u; cnt = 0u; mine = 0u;
#pragma unroll
        for (unsigned j = 0; j < 16; ++j) { const unsigned c = xb_ld(&bar[XB_XCNT(j)]); sum += c; cnt += (c > 0u) ? 1u : 0u; mine = (j == x) ? c : mine; }
        if (sum == G) break;
        __builtin_amdgcn_s_sleep(1);
        if ((++sp & 255u) == 0u) { if (xb_ld(&bar[XB_TMO])) break; if (sp > XB_SPIN_CAP) { atomicAdd(&bar[XB_TMO], 1u); break; } }
    }
    nloc = mine > 0u ? mine : 1u; nx = cnt > 0u ? cnt : 1u;
}
__device__ __forceinline__ void xcd_barrier(const XcdBarrier& b) {
    asm volatile("s_waitcnt vmcnt(0)" ::: "memory");
    __syncthreads();
    if (threadIdx.x == 0) {
        unsigned* bar = b.bar;
        __builtin_amdgcn_s_waitcnt(0);
        unsigned nloc = b.st[0], nx = b.st[1];
        if (nloc == 0u) { xcd_barrier_complete(bar, b.x, nloc, nx); b.st[0] = nloc; b.st[1] = nx; }
        const unsigned old = xb_add(&bar[XB_XSUB(b.x)], 1u);
        const unsigned gen = old / nloc;
        if (old + 1u == (gen + 1u) * nloc) {
            __builtin_amdgcn_fence(__ATOMIC_RELEASE, "agent");
            asm volatile("s_waitcnt vmcnt(0)" ::: "memory");
            const unsigned og = xb_add(&bar[XB_TOP], 1u);
            const unsigned tg = og / nx;
            if (og + 1u == (tg + 1u) * nx) xb_add(&bar[XB_TOPGEN], 1u);
            else XB_SPIN(xb_ld(&bar[XB_TOPGEN]) == tg, bar);
            __builtin_amdgcn_fence(__ATOMIC_ACQUIRE, "agent");
            xb_add(&bar[XB_XGEN(b.x)], 1u);
            asm volatile("s_waitcnt vmcnt(0)" ::: "memory");
        } else {
            XB_SPIN(xb_ld(&bar[XB_XGEN(b.x)]) == gen, bar);
            __builtin_amdgcn_fence(__ATOMIC_ACQUIRE, "agent");
            asm volatile("s_waitcnt vmcnt(0)" ::: "memory");
        }
    }
    __syncthreads();
}

constexpr size_t WS_CTL   = 0;
constexpr size_t CTL_BYTES = 65536;
constexpr size_t CTL_CNT  = 16384;
constexpr size_t WS_ADA   = WS_CTL + CTL_BYTES;
constexpr size_t WS_WHYIN = WS_ADA + 131072;
constexpr size_t WS_WHYOUT= WS_WHYIN + (size_t)6144 * 2048 * 2;
constexpr size_t WS_WMLIN = WS_WHYOUT + (size_t)2048 * 2048 * 2;
constexpr size_t WS_WMLOUT= WS_WMLIN + (size_t)6144 * 2048 * 2;
constexpr size_t WS_WGU   = WS_WMLOUT + (size_t)2048 * 2048 * 2;
constexpr size_t WGU_L    = (size_t)65 * 1024 * 2048;
constexpr size_t WS_WD    = WS_WGU + 2 * WGU_L * 2;
constexpr size_t WD_L     = (size_t)65 * 2048 * 512;
constexpr size_t WS_HBUF  = WS_WD + 2 * WD_L * 2;
constexpr size_t WS_XA    = WS_HBUF + (size_t)T * D * 2;
constexpr size_t WS_XB    = WS_XA + (size_t)T * D * 4;
constexpr size_t WS_LIST  = WS_XB + (size_t)T * D * 4;
constexpr size_t WS_REC   = WS_LIST + (size_t)NE * T * 4;
constexpr int    SLOT_SH  = 65280;
constexpr int    NSLOT    = SLOT_SH + T;
constexpr size_t WS_H     = WS_REC + (size_t)T * TOPK * 8;
constexpr size_t WS_BIG   = WS_H + (size_t)NSLOT * FF * 2;
constexpr size_t WS_END   = WS_BIG + (size_t)NSLOT * D * 2;

constexpr int LDS_STAGE = 131072;
constexpr int LDS_MISC  = 135168;
constexpr int LDS_TSTART = LDS_MISC + 64;
constexpr int LDS_TILEE  = LDS_TSTART + 72 * 4;
constexpr int LDS_CNT    = LDS_TILEE + 320 * 4;
constexpr int LDS_BYTES  = LDS_MISC + 8192;

struct Params { const float* in[34]; float* out; unsigned char* ws; };
typedef const Params __attribute__((address_space(4)))* KP;
__device__ __forceinline__ int tid_fresh() { int t = threadIdx.x; asm volatile("" : "+v"(t)); return t; }
__device__ __forceinline__ KP kparams() { KP q = (KP)__builtin_amdgcn_kernarg_segment_ptr(); asm volatile("" : "+s"(q)); return q; }

__device__ __forceinline__ unsigned cvt_pk_bf16(float lo, float hi) { unsigned r; asm volatile("v_cvt_pk_bf16_f32 %0, %1, %2" : "=v"(r) : "v"(lo), "v"(hi)); return r; }
__device__ __forceinline__ float bf_lo(unsigned w) { return __uint_as_float(w << 16); }
__device__ __forceinline__ float bf_hi(unsigned w) { return __uint_as_float(w & 0xffff0000u); }
__device__ __forceinline__ float wave_sum(float v) {
#pragma unroll
    for (int o = 32; o > 0; o >>= 1) v += __shfl_xor(v, o);
    return v;
}
__device__ __forceinline__ float siluf(float v) { return v / (1.f + expf(-v)); }
__device__ __forceinline__ float fdivf(float a, float b) { return a * __builtin_amdgcn_rcpf(b); }

constexpr int BM = 256, BK = 64, HALF = 128, HTB = HALF * BK * 2, NXCD = 8, WGM = 8;
__device__ __forceinline__ int lds_byte(int r, int c) { const int st = (r >> 4) * 2 + (c >> 5), rr = r & 15, cc = c & 31, ob = rr * 64 + cc * 2; return st * 1024 + (ob ^ (((ob >> 9) & 1) << 5)); }
__device__ __forceinline__ void stage_rc(int b, int& R, int& C) { const int st = b / 1024, sb = b % 1024, swz = sb ^ (((sb >> 9) & 1) << 5); R = (st >> 1) * 16 + swz / 64; C = (st & 1) * 32 + (swz % 64) / 2; }
__device__ __forceinline__ int perm32(int rho) { const int n = rho >> 4, i = rho & 15; return 8 * (i >> 2) + 4 * n + (i & 3); }

struct Unit { int pm, pn, e, rbase; };

template <class Epi, class Sched>
__device__ __forceinline__ void gemm_phase(LAS unsigned char* lds, const int K, const Sched& S, const Epi& E) {
    const int tid = tid_fresh(), wid = __builtin_amdgcn_readfirstlane(tid >> 6), lane = tid & 63, wr = wid >> 2, wc = wid & 3, fr = lane & 15, fq = lane >> 4;
    const int nt = K / BK;
    int R0, C0, R1, C1; stage_rc(tid * 16, R0, C0); stage_rc(tid * 16 + 8192, R1, C1);
    const int Rb0 = Epi::PERM ? ((R0 & ~31) + perm32(R0 & 31)) : R0, Rb1 = Epi::PERM ? ((R1 & ~31) + perm32(R1 & 31)) : R1;
    const unsigned voffB0 = S.b_off(Rb0, C0), voffB1 = S.b_off(Rb1, C1);
    const size_t kstep = (size_t)(BK * 2);
    const size_t kstepB = S.b_kstep(), hstep = S.b_hstep();
    const unsigned ldsw = (unsigned)wid * 1024u;
    const int aoff = lds_byte(wr * 64 + fr, fq * 8), boff = lds_byte(wc * 32 + fr, fq * 8);
#define PG8_SA(b, h) (((b) * 2 + (h)) * HTB)
#define PG8_SB(b, h) ((4 + (b) * 2 + (h)) * HTB)
#define PG8_STAGE(bufoff, gbase, v0, v1) do { \
        __builtin_amdgcn_global_load_lds((const unsigned*)((const char*)(gbase) + (v0)), (LAS unsigned*)(lds + (bufoff) + ldsw), 16, 0, 0); \
        __builtin_amdgcn_global_load_lds((const unsigned*)((const char*)(gbase) + (v1)), (LAS unsigned*)(lds + (bufoff) + ldsw + 8192), 16, 0, 0); } while (0)
#define PG8_LDA(dst, b, h) do { _Pragma("unroll") for (int m = 0; m < 4; ++m) _Pragma("unroll") for (int k = 0; k < 2; ++k) dst[m][k] = *(const LAS bf16x8*)(lds + PG8_SA(b, h) + aoff + m * 2048 + k * 1024); } while (0)
#define PG8_LDB(dst, b, h) do { _Pragma("unroll") for (int n = 0; n < 2; ++n) _Pragma("unroll") for (int k = 0; k < 2; ++k) dst[n][k] = *(const LAS bf16x8*)(lds + PG8_SB(b, h) + boff + n * 2048 + k * 1024); } while (0)
#define PG8_MMA(ai, bj, At, Bt) do { __builtin_amdgcn_s_setprio(1); _Pragma("unroll") for (int m = 0; m < 4; ++m) _Pragma("unroll") for (int n = 0; n < 2; ++n) _Pragma("unroll") for (int k = 0; k < 2; ++k) \
        acc[ai][bj][m][n] = __builtin_amdgcn_mfma_f32_16x16x32_bf16(Bt[n][k], At[m][k], acc[ai][bj][m][n], 0, 0, 0); __builtin_amdgcn_s_setprio(0); } while (0)
#define PG8_WAIT_V(n) asm volatile("s_waitcnt vmcnt(" #n ")" ::: "memory")
#define PG8_WAIT_L(n) asm volatile("s_waitcnt lgkmcnt(" #n ")" ::: "memory")
#define PG8_BAR __builtin_amdgcn_s_barrier()
#define PG8_SCHED __builtin_amdgcn_sched_barrier(0)
#define PG8_AOFFS(u, o00, o01, o10, o11) do { S.a_off4(u, R0, R1, o00, o01, o10, o11); o00 += (unsigned)C0 * 2u; o01 += (unsigned)C1 * 2u; o10 += (unsigned)C0 * 2u; o11 += (unsigned)C1 * 2u; } while (0)
    Unit cur, nxt; int ui = 0;
    if (!S.next(0, cur)) return;
    f32x4 acc[2][2][4][2];
#pragma unroll
    for (int a = 0; a < 2; ++a)
#pragma unroll
        for (int b = 0; b < 2; ++b)
#pragma unroll
            for (int m = 0; m < 4; ++m)
#pragma unroll
                for (int n = 0; n < 2; ++n) acc[a][b][m][n] = (f32x4){0.f, 0.f, 0.f, 0.f};
    bf16x8 At[4][2], B0[2][2], B1[2][2];
    const char* const gA = S.a_base();
    unsigned c00, c01, c10, c11, n00, n01, n10, n11;
    PG8_AOFFS(cur, c00, c01, c10, c11);
    const char* cB = S.b_ptr(cur);
    PG8_STAGE(PG8_SB(0, 0), cB, voffB0, voffB1); PG8_STAGE(PG8_SA(0, 0), gA, c00, c01); PG8_STAGE(PG8_SB(0, 1), cB + hstep, voffB0, voffB1); PG8_STAGE(PG8_SA(0, 1), gA, c10, c11);
    if (wr == 1) PG8_BAR;
    PG8_WAIT_V(4); PG8_BAR;
    PG8_STAGE(PG8_SB(1, 0), cB + kstepB, voffB0, voffB1); PG8_STAGE(PG8_SA(1, 0), gA + kstep, c00, c01); PG8_STAGE(PG8_SB(1, 1), cB + hstep + kstepB, voffB0, voffB1);
    PG8_WAIT_V(6); PG8_BAR;
    for (;;) {
        const bool has_next = S.next(ui + 1, nxt);
        const char* nB = cB;
        if (has_next) { PG8_AOFFS(nxt, n00, n01, n10, n11); nB = S.b_ptr(nxt); } else { n00 = c00; n01 = c01; n10 = c10; n11 = c11; }
        for (int t = 0; t < nt; t += 2) {
            const bool last = (t == nt - 2);
            const char* a1 = gA + (size_t)(t + 1) * kstep;
            const char* a2 = last ? gA : gA + (size_t)(t + 2) * kstep; const char* b2 = last ? nB : cB + (size_t)(t + 2) * kstepB;
            const char* a3 = a2 + kstep; const char* b3 = b2 + kstepB;
            const unsigned x00 = last ? n00 : c00, x01 = last ? n01 : c01, x10 = last ? n10 : c10, x11 = last ? n11 : c11;
            PG8_LDB(B0, 0, 0); PG8_SCHED; PG8_LDA(At, 0, 0); PG8_STAGE(PG8_SA(1, 1), a1, c10, c11);
            PG8_WAIT_L(8); PG8_BAR; PG8_WAIT_L(0); PG8_MMA(0, 0, At, B0); PG8_BAR; PG8_SCHED;
            PG8_LDB(B1, 0, 1); PG8_STAGE(PG8_SB(0, 0), b2, voffB0, voffB1);
            PG8_BAR; PG8_WAIT_L(0); PG8_MMA(0, 1, At, B1); PG8_BAR;
            PG8_LDA(At, 0, 1); PG8_STAGE(PG8_SA(0, 0), a2, x00, x01);
            PG8_BAR; PG8_WAIT_L(0); PG8_MMA(1, 0, At, B0); PG8_BAR; PG8_SCHED;
            PG8_STAGE(PG8_SB(0, 1), b2 + hstep, voffB0, voffB1);
            PG8_WAIT_V(6); PG8_BAR; PG8_MMA(1, 1, At, B1); PG8_BAR;
            PG8_LDB(B0, 1, 0); PG8_SCHED; PG8_LDA(At, 1, 0); PG8_STAGE(PG8_SA(0, 1), a2, x10, x11);
            PG8_WAIT_L(8); PG8_BAR; PG8_WAIT_L(0); PG8_MMA(0, 0, At, B0); PG8_BAR; PG8_SCHED;
            PG8_LDB(B1, 1, 1); PG8_STAGE(PG8_SB(1, 0), b3, voffB0, voffB1);
            PG8_BAR; PG8_WAIT_L(0); PG8_MMA(0, 1, At, B1); PG8_BAR;
            PG8_LDA(At, 1, 1); PG8_STAGE(PG8_SA(1, 0), a3, x00, x01);
            PG8_BAR; PG8_WAIT_L(0); PG8_MMA(1, 0, At, B0); PG8_BAR; PG8_SCHED;
            PG8_STAGE(PG8_SB(1, 1), b3 + hstep, voffB0, voffB1);
            PG8_WAIT_V(6); PG8_BAR; PG8_MMA(1, 1, At, B1); PG8_BAR;
        }
        E(acc, cur, wr, wc, fr, fq);
        if (!has_next) break;
#pragma unroll
        for (int a = 0; a < 2; ++a)
#pragma unroll
            for (int b = 0; b < 2; ++b)
#pragma unroll
                for (int m = 0; m < 4; ++m)
#pragma unroll
                    for (int n = 0; n < 2; ++n) acc[a][b][m][n] = (f32x4){0.f, 0.f, 0.f, 0.f};
        cur = nxt; cB = nB; c00 = n00; c01 = n01; c10 = n10; c11 = n11; ++ui;
    }
    PG8_WAIT_V(0);
    if (wr == 0) PG8_BAR;
    PG8_BAR;
#undef PG8_SA
#undef PG8_SB
#undef PG8_STAGE
#undef PG8_LDA
#undef PG8_LDB
#undef PG8_MMA
#undef PG8_WAIT_V
#undef PG8_WAIT_L
#undef PG8_BAR
#undef PG8_SCHED
#undef PG8_AOFFS
}

struct DenseOrder {
    const bf16_t* A; const bf16_t* Bt; int K, nM, nN, nwg, G, c;
    __device__ __forceinline__ void init(const bf16_t* A_, const bf16_t* Bt_, int M, int N, int K_, int G_, int c_) { A = A_; Bt = Bt_; K = K_; nM = M / BM; nN = N / BM; nwg = nM * nN; G = G_; c = c_; }
    __device__ __forceinline__ bool next(int i, Unit& u) const {
        const long L = (long)i * G + c; if (L >= nwg) return false;
        int wgid = (int)L; { const int q = nwg / NXCD, r = nwg % NXCD, xcd = wgid % NXCD, off = wgid / NXCD; wgid = (xcd < r ? xcd * (q + 1) : r * (q + 1) + (xcd - r) * q) + off; }
        const int nig = WGM * nN, gid = wgid / nig, fm = gid * WGM, gsz = (nM - fm) < WGM ? (nM - fm) : WGM;
        u.pm = fm + ((wgid % nig) % gsz); u.pn = (wgid % nig) / gsz; u.e = 0; u.rbase = u.pm * BM; return true;
    }
    __device__ __forceinline__ const char* a_base() const { return (const char*)A; }
    __device__ __forceinline__ unsigned a_off(const Unit& u, int r) const { return (unsigned)((u.pm * BM + r) * K) * 2u; }
    __device__ __forceinline__ void a_off4(const Unit& u, int r0, int r1, unsigned& o00, unsigned& o01, unsigned& o10, unsigned& o11) const { o00 = a_off(u, r0); o01 = a_off(u, r1); o10 = a_off(u, HALF + r0); o11 = a_off(u, HALF + r1); }
    __device__ __forceinline__ const char* b_ptr(const Unit& u) const { return (const char*)(Bt + (size_t)u.pn * BM * K); }
    __device__ __forceinline__ unsigned b_off(int R, int C) const { return (unsigned)(R * K + C) * 2u; }
    __device__ __forceinline__ size_t b_kstep() const { return (size_t)(BK * 2); }
    __device__ __forceinline__ size_t b_hstep() const { return (size_t)HALF * K * 2; }
};
struct MoeGuOrder {
    const bf16_t* A; const bf16_t* W; const int* list; const LAS int* tstart; const LAS int* tile_e; const LAS int* cnt; int ntiles, G, c;
    __device__ __forceinline__ bool next(int i, Unit& u) const {
        const int L = i * G + c; if (L >= ntiles * 4) return false;
        const int rt = L >> 2; u.pn = L & 3; u.e = tile_e[rt]; u.pm = rt - tstart[u.e]; u.rbase = (u.e < NE) ? rt * BM : SLOT_SH + u.pm * BM; return true;
    }
    __device__ __forceinline__ const char* a_base() const { return (const char*)A; }
    __device__ __forceinline__ unsigned a_off(const Unit& u, int r) const {
        const int pos = u.pm * BM + r; int tok = pos;
        if (u.e < NE) { tok = 0; if (pos < cnt[u.e]) tok = list[u.e * T + pos]; }
        return (unsigned)tok * (unsigned)(D * 2);
    }
    __device__ __forceinline__ void a_off4(const Unit& u, int r0, int r1, unsigned& o00, unsigned& o01, unsigned& o10, unsigned& o11) const {
        const int p0 = u.pm * BM + r0, p1 = u.pm * BM + r1, p2 = p0 + HALF, p3 = p1 + HALF;
        if (u.e >= NE) { o00 = (unsigned)p0 * (unsigned)(D * 2); o01 = (unsigned)p1 * (unsigned)(D * 2); o10 = (unsigned)p2 * (unsigned)(D * 2); o11 = (unsigned)p3 * (unsigned)(D * 2); return; }
        const int* lp = list + u.e * T;
        int v0 = lp[p0], v1 = lp[p1], v2 = lp[p2], v3 = lp[p3];
        asm volatile("" : "+v"(v0), "+v"(v1), "+v"(v2), "+v"(v3));
        const int c = cnt[u.e];
        o00 = p0 < c ? (unsigned)v0 * (unsigned)(D * 2) : 0u; o01 = p1 < c ? (unsigned)v1 * (unsigned)(D * 2) : 0u;
        o10 = p2 < c ? (unsigned)v2 * (unsigned)(D * 2) : 0u; o11 = p3 < c ? (unsigned)v3 * (unsigned)(D * 2) : 0u;
    }
    __device__ __forceinline__ const char* b_ptr(const Unit& u) const { return (const char*)(W + (size_t)u.e * 1024 * D + (size_t)u.pn * BM * 8); }
    __device__ __forceinline__ unsigned b_off(int R, int C) const { return (unsigned)((C >> 3) * 1024 + R) * 16u; }
    __device__ __forceinline__ size_t b_kstep() const { return (size_t)8 * 1024 * 16; }
    __device__ __forceinline__ size_t b_hstep() const { return (size_t)HALF * 16; }
};
struct MoeDownOrder {
    const bf16_t* A; const bf16_t* W; const LAS int* tstart; const LAS int* tile_e; int ntiles, G, c;
    __device__ __forceinline__ bool next(int i, Unit& u) const {
        const int L = i * G + c; if (L >= ntiles * 8) return false;
        const int rt = L >> 3; u.pn = L & 7; u.e = tile_e[rt]; u.pm = rt - tstart[u.e]; u.rbase = (u.e < NE) ? rt * BM : SLOT_SH + u.pm * BM; return true;
    }
    __device__ __forceinline__ const char* a_base() const { return (const char*)A; }
    __device__ __forceinline__ unsigned a_off(const Unit& u, int r) const { return (unsigned)((u.rbase + r) * FF) * 2u; }
    __device__ __forceinline__ void a_off4(const Unit& u, int r0, int r1, unsigned& o00, unsigned& o01, unsigned& o10, unsigned& o11) const { o00 = a_off(u, r0); o01 = a_off(u, r1); o10 = a_off(u, HALF + r0); o11 = a_off(u, HALF + r1); }
    __device__ __forceinline__ const char* b_ptr(const Unit& u) const { return (const char*)(W + (size_t)u.e * D * FF + (size_t)u.pn * BM * 8); }
    __device__ __forceinline__ unsigned b_off(int R, int C) const { return (unsigned)((C >> 3) * D + R) * 16u; }
    __device__ __forceinline__ size_t b_kstep() const { return (size_t)8 * D * 16; }
    __device__ __forceinline__ size_t b_hstep() const { return (size_t)HALF * 16; }
};

struct EpiBf16 {
    static constexpr bool PERM = true;
    bf16_t* O; int ldc;
    __device__ __forceinline__ void operator()(const f32x4 (&acc)[2][2][4][2], const Unit& u, int wr, int wc, int fr, int fq) const {
        const int row0 = u.rbase + wr * 64 + fr, col0 = u.pn * BM + wc * 32 + 8 * fq;
#pragma unroll
        for (int ai = 0; ai < 2; ++ai)
#pragma unroll
            for (int m = 0; m < 4; ++m) { bf16_t* rowp = O + (size_t)(row0 + ai * HALF + m * 16) * ldc + col0;
#pragma unroll
                for (int bj = 0; bj < 2; ++bj) { const f32x4 v0 = acc[ai][bj][m][0], v1 = acc[ai][bj][m][1];
                    u32x4 w; w.x = cvt_pk_bf16(v0[0], v0[1]); w.y = cvt_pk_bf16(v0[2], v0[3]); w.z = cvt_pk_bf16(v1[0], v1[1]); w.w = cvt_pk_bf16(v1[2], v1[3]);
                    *(u32x4*)(rowp + bj * HALF) = w; } }
    }
};
__device__ __forceinline__ unsigned pk4_fp8(float a, float b, float c, float d) { int w = 0; w = __builtin_amdgcn_cvt_pk_fp8_f32(a, b, w, false); w = __builtin_amdgcn_cvt_pk_fp8_f32(c, d, w, true); return (unsigned)w; }
typedef float f32x2v __attribute__((ext_vector_type(2)));
constexpr float Y8_SCALE = 16.f, Y8_INV = 1.f / 16.f;
struct EpiF8 {
    static constexpr bool PERM = true;
    unsigned char* O; int ldc; float scale;
    __device__ __forceinline__ void operator()(const f32x4 (&acc)[2][2][4][2], const Unit& u, int wr, int wc, int fr, int fq) const {
        const int row0 = u.rbase + wr * 64 + fr, col0 = u.pn * BM + wc * 32 + 8 * fq;
#pragma unroll
        for (int ai = 0; ai < 2; ++ai)
#pragma unroll
            for (int m = 0; m < 4; ++m) { unsigned char* rowp = O + (size_t)(row0 + ai * HALF + m * 16) * ldc + col0;
#pragma unroll
                for (int bj = 0; bj < 2; ++bj) { const f32x4 v0 = acc[ai][bj][m][0] * scale, v1 = acc[ai][bj][m][1] * scale;
                    u32x2 w; w.x = pk4_fp8(v0[0], v0[1], v0[2], v0[3]); w.y = pk4_fp8(v1[0], v1[1], v1[2], v1[3]);
                    *(u32x2*)(rowp + bj * HALF) = w; } }
    }
};
struct EpiSwiglu {
    static constexpr bool PERM = true;
    bf16_t* O;
    __device__ __forceinline__ void operator()(const f32x4 (&acc)[2][2][4][2], const Unit& u, int wr, int wc, int fr, int fq) const {
        const int row0 = u.rbase + wr * 64 + fr, col0 = u.pn * HALF + wc * 32 + 8 * fq;
#pragma unroll
        for (int ai = 0; ai < 2; ++ai)
#pragma unroll
            for (int m = 0; m < 4; ++m) { bf16_t* rowp = O + (size_t)(row0 + ai * HALF + m * 16) * FF + col0;
                float h[8];
#pragma unroll
                for (int n = 0; n < 2; ++n)
#pragma unroll
                    for (int j = 0; j < 4; ++j) { const float g = acc[ai][0][m][n][j], up = acc[ai][1][m][n][j]; h[n * 4 + j] = fdivf(g, 1.f + __expf(-g)) * up; }
                u32x4 w; w.x = cvt_pk_bf16(h[0], h[1]); w.y = cvt_pk_bf16(h[2], h[3]); w.z = cvt_pk_bf16(h[4], h[5]); w.w = cvt_pk_bf16(h[6], h[7]);
                *(u32x4*)rowp = w; }
    }
};
struct EpiResid {
    static constexpr bool PERM = false;
    const float* xin; float* out; const float* gate;
    __device__ __forceinline__ void operator()(const f32x4 (&acc)[2][2][4][2], const Unit& u, int wr, int wc, int fr, int fq) const {
        const int row0 = u.rbase + wr * 64 + fr, col0 = u.pn * BM + wc * 32 + 4 * fq;
        f32x4 gv[2][2];
#pragma unroll
        for (int bj = 0; bj < 2; ++bj)
#pragma unroll
            for (int n = 0; n < 2; ++n) gv[bj][n] = *(const f32x4*)(gate + col0 + bj * HALF + n * 16);
#pragma unroll
        for (int ai = 0; ai < 2; ++ai) {
            f32x4 xv[4][2][2];
#pragma unroll
            for (int m = 0; m < 4; ++m) { const size_t ro = (size_t)(row0 + ai * HALF + m * 16) * D + col0;
#pragma unroll
                for (int bj = 0; bj < 2; ++bj)
#pragma unroll
                    for (int n = 0; n < 2; ++n) xv[m][bj][n] = *(const f32x4*)(xin + ro + bj * HALF + n * 16); }
#pragma unroll
            for (int m = 0; m < 4; ++m) { const size_t ro = (size_t)(row0 + ai * HALF + m * 16) * D + col0;
#pragma unroll
                for (int bj = 0; bj < 2; ++bj)
#pragma unroll
                    for (int n = 0; n < 2; ++n) *(f32x4*)(out + ro + bj * HALF + n * 16) = xv[m][bj][n] + gv[bj][n] * acc[ai][bj][m][n]; }
        }
    }
};

__device__ __forceinline__ void cvt_group(LAS float* tile, int bid, int G, const float* src, size_t sbs, int ldS, int K, int N, bf16_t* dst, size_t dbs, int mode, int nbatch, int nrimg = 0) {
    const int tid = tid_fresh();
    const int tk = K / 64, tn = N / 256, per = tk * tn, total = per * nbatch;
    const int kr = tid >> 6, c4 = tid & 63;
#define CVT_LOAD(jx) do { const int b_ = (jx) / per, r_ = (jx) - b_ * per, kt_ = r_ / tn, nt_ = r_ - kt_ * tn; \
        const float* s_ = src + (size_t)b_ * sbs + (size_t)(kt_ * 64) * ldS + nt_ * 256; \
        _Pragma("unroll") for (int q = 0; q < 8; ++q) v[q] = *(const float4*)(s_ + (size_t)(kr + 8 * q) * ldS + c4 * 4); } while (0)
    float4 v[8];
    if (bid < total) CVT_LOAD(bid);
    for (int j = bid; j < total; j += G) {
        const int b = j / per, r = j - b * per, kt = r / tn, ntile = r - kt * tn;
        __syncthreads();
#pragma unroll
        for (int q = 0; q < 8; ++q) { LAS float* tp = tile + (kr + 8 * q) * 257 + c4 * 4; tp[0] = v[q].x; tp[1] = v[q].y; tp[2] = v[q].z; tp[3] = v[q].w; }
        if (j + G < total) CVT_LOAD(j + G);
        __syncthreads();
        bf16_t* dmat = dst + (size_t)b * dbs;
#pragma unroll
        for (int q = 0; q < 4; ++q) {
            const int id = tid + NTHR * q, nr = id >> 3, kc = id & 7;
            const int n = ntile * 256 + nr;
            const int drow = (mode == 0) ? n : ((n >> 7) * 256 + (mode == 2 ? 128 : 0) + (n & 127));
            const LAS float* tp = tile + (kc * 8) * 257 + nr;
            u32x4 w; w.x = cvt_pk_bf16(tp[0], tp[257]); w.y = cvt_pk_bf16(tp[2 * 257], tp[3 * 257]); w.z = cvt_pk_bf16(tp[4 * 257], tp[5 * 257]); w.w = cvt_pk_bf16(tp[6 * 257], tp[7 * 257]);
            if (nrimg) *(u32x4*)(dmat + ((size_t)(kt * 8 + kc) * nrimg + drow) * 8) = w;
            else *(u32x4*)(dmat + (size_t)drow * K + kt * 64 + kc * 8) = w;
        }
    }
#undef CVT_LOAD
    __syncthreads();
}

__device__ __forceinline__ void ada_phase(LAS float* sm, int bid, int G, const float* c, const float* ada_w, const float* ada_b, float* ada) {
    const int tid = tid_fresh();
    LAS float* cs = sm; LAS float* red = sm + 2048;
    for (int i = tid; i < D; i += NTHR) cs[i] = siluf(c[i]);
    __syncthreads();
    const int kg = tid >> 5, c4 = tid & 31;
    for (int j = bid; j < 192; j += G) {
        const int l = j / 96, cb = j - l * 96;
        const float* w = ada_w + (size_t)l * D * 12288 + (size_t)(kg * 128) * 12288 + cb * 128 + c4 * 4;
        float4 a = make_float4(0.f, 0.f, 0.f, 0.f);
#pragma unroll 8
        for (int k = 0; k < 128; ++k) { const float4 wv = *(const float4*)(w + (size_t)k * 12288); const float s = cs[kg * 128 + k]; a.x += s * wv.x; a.y += s * wv.y; a.z += s * wv.z; a.w += s * wv.w; }
        __syncthreads();
        LAS float* rp = red + kg * 128 + c4 * 4; rp[0] = a.x; rp[1] = a.y; rp[2] = a.z; rp[3] = a.w;
        __syncthreads();
        if (tid < 128) { float s = 0.f;
#pragma unroll
            for (int q = 0; q < 16; ++q) s += red[q * 128 + tid];
            ada[l * 12288 + cb * 128 + tid] = s + ada_b[l * 12288 + cb * 128 + tid]; }
    }
    __syncthreads();
}

__device__ __forceinline__ void row_norm_mod(float4 (&v)[8], int lane, const float* g, const float* sc, const float* sh) {
    float4 ga[8], s1a[8], s0a[8];
#pragma unroll
    for (int i = 0; i < 8; ++i) { const int c = (lane + 64 * i) * 4; ga[i] = *(const float4*)(g + c); s1a[i] = *(const float4*)(sc + c); s0a[i] = *(const float4*)(sh + c); }
    float ss = 0.f;
#pragma unroll
    for (int i = 0; i < 8; ++i) ss += v[i].x * v[i].x + v[i].y * v[i].y + v[i].z * v[i].z + v[i].w * v[i].w;
    ss = wave_sum(ss);
    const float r = rsqrtf(ss * (1.f / D) + EPS);
#pragma unroll
    for (int i = 0; i < 8; ++i) { const float4 gg = ga[i], s1 = s1a[i], s0 = s0a[i];
        v[i].x = v[i].x * r * gg.x * (1.f + s1.x) + s0.x; v[i].y = v[i].y * r * gg.y * (1.f + s1.y) + s0.y; v[i].z = v[i].z * r * gg.z * (1.f + s1.z) + s0.z; v[i].w = v[i].w * r * gg.w * (1.f + s1.w) + s0.w; }
}

__device__ __forceinline__ void row_norm_mod2(float4 (&v0)[8], float4 (&v1)[8], int lane, const float* g, const float* sc, const float* sh) {
    float4 ga[8], s1a[8];
#pragma unroll
    for (int i = 0; i < 8; ++i) { const int c = (lane + 64 * i) * 4; ga[i] = *(const float4*)(g + c); s1a[i] = *(const float4*)(sc + c); }
    float ssa = 0.f, ssb = 0.f;
#pragma unroll
    for (int i = 0; i < 8; ++i) { ssa += v0[i].x * v0[i].x + v0[i].y * v0[i].y + v0[i].z * v0[i].z + v0[i].w * v0[i].w; ssb += v1[i].x * v1[i].x + v1[i].y * v1[i].y + v1[i].z * v1[i].z + v1[i].w * v1[i].w; }
    ssa = wave_sum(ssa); ssb = wave_sum(ssb);
    const float ra = rsqrtf(ssa * (1.f / D) + EPS), rb = rsqrtf(ssb * (1.f / D) + EPS);
#pragma unroll
    for (int i = 0; i < 8; ++i) { const int c = (lane + 64 * i) * 4; const float4 gg = ga[i], s1 = s1a[i], s0 = *(const float4*)(sh + c);
        v0[i].x = v0[i].x * ra * gg.x * (1.f + s1.x) + s0.x; v0[i].y = v0[i].y * ra * gg.y * (1.f + s1.y) + s0.y; v0[i].z = v0[i].z * ra * gg.z * (1.f + s1.z) + s0.z; v0[i].w = v0[i].w * ra * gg.w * (1.f + s1.w) + s0.w;
        v1[i].x = v1[i].x * rb * gg.x * (1.f + s1.x) + s0.x; v1[i].y = v1[i].y * rb * gg.y * (1.f + s1.y) + s0.y; v1[i].z = v1[i].z * rb * gg.z * (1.f + s1.z) + s0.z; v1[i].w = v1[i].w * rb * gg.w * (1.f + s1.w) + s0.w; }
}

constexpr int HFS_LD = 2050;
template <int NT>
__device__ __forceinline__ void rows16_matmul(const LAS float* hfs, const float* W, int ldw, int col0, int wave, int lane, f32x4 (&acc)[NT]) {
#pragma unroll
    for (int jt = 0; jt < NT; ++jt) acc[jt] = (f32x4){0.f, 0.f, 0.f, 0.f};
    const LAS float* ap = hfs + (lane & 15) * HFS_LD + wave * 256 + (lane >> 4);
    const float* bp = W + (size_t)(wave * 256 + (lane >> 4)) * ldw + col0 + (lane & 15);
#pragma unroll 8
    for (int s4 = 0; s4 < 64; ++s4) {
        const float a = ap[s4 * 4];
        float b[NT];
#pragma unroll
        for (int jt = 0; jt < NT; ++jt) b[jt] = bp[(size_t)(s4 * 4) * ldw + jt * 16];
#pragma unroll
        for (int jt = 0; jt < NT; ++jt) acc[jt] = __builtin_amdgcn_mfma_f32_16x16x4f32(a, b[jt], acc[jt], 0, 0, 0);
    }
}

__device__ __forceinline__ void route_phase(LAS unsigned char* lds, int bid, int G, const float* x, const float* g, const float* sc, const float* sh,
                                            const float* rw, const float* rbias, bf16_t* hbuf, int* cnt, int* list, u32x2* rec) {
    LAS float* hfs = (LAS float*)lds;
    LAS float* part = (LAS float*)lds;
    for (int r0 = bid * 16; r0 < T; r0 += G * 16) {
        const int tid = tid_fresh();
        const int lane = tid & 63, wave = tid >> 6;
        __syncthreads();
        {   const int row = r0 + wave * 2;
            float4 va[8], vb[8];
#pragma unroll
            for (int i = 0; i < 8; ++i) { va[i] = *(const float4*)(x + (size_t)row * D + (lane + 64 * i) * 4); vb[i] = *(const float4*)(x + (size_t)(row + 1) * D + (lane + 64 * i) * 4); }
            row_norm_mod2(va, vb, lane, g, sc, sh);
#pragma unroll
            for (int i = 0; i < 8; ++i) { const int c = (lane + 64 * i) * 4;
                u32x2 w; w.x = cvt_pk_bf16(va[i].x, va[i].y); w.y = cvt_pk_bf16(va[i].z, va[i].w); *(u32x2*)(hbuf + (size_t)row * D + c) = w;
                u32x2 w2; w2.x = cvt_pk_bf16(vb[i].x, vb[i].y); w2.y = cvt_pk_bf16(vb[i].z, vb[i].w); *(u32x2*)(hbuf + (size_t)(row + 1) * D + c) = w2;
                LAS float* hp = hfs + (wave * 2) * HFS_LD + c; hp[0] = va[i].x; hp[1] = va[i].y; hp[2] = va[i].z; hp[3] = va[i].w;
                hp[HFS_LD] = vb[i].x; hp[HFS_LD + 1] = vb[i].y; hp[HFS_LD + 2] = vb[i].z; hp[HFS_LD + 3] = vb[i].w; }
        }
        __syncthreads();
        f32x4 acc[4];
        rows16_matmul<4>(hfs, rw, NE, 0, wave, lane, acc);
        __syncthreads();
#pragma unroll
        for (int jt = 0; jt < 4; ++jt)
#pragma unroll
            for (int r = 0; r < 4; ++r) part[(wave * 16 + (lane >> 4) * 4 + r) * 64 + jt * 16 + (lane & 15)] = acc[jt][r];
        __syncthreads();
#pragma unroll 1
        for (int rr = 0; rr < 2; ++rr) {
            const int rl = wave * 2 + rr, row = r0 + rl;
            float logit = 0.f;
#pragma unroll
            for (int w = 0; w < 8; ++w) logit += part[(w * 16 + rl) * 64 + lane];
            const float score = 1.f / (1.f + expf(-logit));
            const float sel = score + rbias[lane];
            float m1 = sel; m1 = fmaxf(m1, __shfl_xor(m1, 1)); m1 = fmaxf(m1, __shfl_xor(m1, 2)); m1 = fmaxf(m1, __shfl_xor(m1, 4));
            const unsigned long long bal = __ballot(sel == m1);
            const unsigned gbits = (unsigned)(bal >> (lane & ~7)) & 0xffu;
            const int idx1 = (lane & ~7) + __ffs(gbits) - 1;
            float m2 = (lane == idx1) ? -INFINITY : sel; m2 = fmaxf(m2, __shfl_xor(m2, 1)); m2 = fmaxf(m2, __shfl_xor(m2, 2)); m2 = fmaxf(m2, __shfl_xor(m2, 4));
            const float gs = m1 + m2;
            const int grp = lane >> 3; int grank = 0;
#pragma unroll
            for (int gp = 0; gp < 8; ++gp) { const float o = __shfl(gs, gp * 8); grank += ((o > gs) || (o == gs && gp < grp)) ? 1 : 0; }
            const bool elig = grank < 4;
            const float sm = elig ? sel : -INFINITY;
            int rank = 0;
            for (int j = 0; j < 64; ++j) { const float o = __shfl(sm, j); rank += ((o > sm) || (o == sm && j < lane)) ? 1 : 0; }
            const bool chosen = elig && rank < TOPK;
            const float wsum = wave_sum(chosen ? score : 0.f);
            const float wgt = score / wsum * 2.5f;
            const unsigned long long cb = __ballot(chosen);
            if (chosen) {
                const int pos = atomicAdd(&cnt[lane], 1);
                list[lane * T + pos] = row;
                const int j = __popcll(cb & ((1ull << lane) - 1ull));
                u32x2 rr2; rr2.x = (unsigned)(lane * T + pos); rr2.y = __float_as_uint(wgt);
                rec[row * TOPK + j] = rr2;
            }
        }
    }
    __syncthreads();
}

__device__ __forceinline__ int moe_tables(LAS unsigned char* ldsb, int* cnt_g) {
    const int tid = tid_fresh();
    LAS int* tstart = (LAS int*)(ldsb + LDS_TSTART); LAS int* tile_e = (LAS int*)(ldsb + LDS_TILEE); LAS int* cl = (LAS int*)(ldsb + LDS_CNT);
    __syncthreads();
    if (tid < NE) {
        const int c = (int)__hip_atomic_load((unsigned*)cnt_g + tid, __ATOMIC_RELAXED, __HIP_MEMORY_SCOPE_AGENT);
        cl[tid] = c;
        const int nt = (c + BM - 1) / BM; int inc = nt;
#pragma unroll
        for (int o = 1; o < 64; o <<= 1) { const int v = __shfl_up(inc, o); if (tid >= o) inc += v; }
        tstart[tid] = inc - nt;
        if (tid == NE - 1) { tstart[NE] = inc; tstart[NE + 1] = inc + T / BM; }
    }
    __syncthreads();
    const int ntiles = tstart[NE + 1];
    for (int i = tid; i < ntiles; i += NTHR) {
        int lo = 0, hi = NE;
#pragma unroll
        for (int it = 0; it < 7; ++it) { const int mid = (lo + hi + 1) >> 1; if (lo < hi) { if (tstart[mid] <= i) lo = mid; else hi = mid - 1; } }
        tile_e[i] = lo; }
    __syncthreads();
    return ntiles;
}

template <int MODE>
__device__ __forceinline__ void combine_phase(LAS unsigned char* ldsb, int bid, int G, const float* x, const float* gf, const bf16_t* Y, const u32x2* rec,
                                              float* xout, const float* ng, const float* sc, const float* sh, bf16_t* hbuf) {
    const LAS int* tstart = (const LAS int*)(ldsb + LDS_TSTART);
    const int wave0 = tid_fresh() >> 6;
    for (int rowi = bid * 16 + wave0 * 2; rowi < T; rowi += ((rowi & 1) ? (G * 16 - 1) : 1)) {
        const int row = rowi;
        const int lane = tid_fresh() & 63;
        float a[4][8];
#pragma unroll
        for (int i = 0; i < 4; ++i)
#pragma unroll
            for (int q = 0; q < 8; ++q) a[i][q] = 0.f;
        u32x2 rr[TOPK];
#pragma unroll
        for (int j = 0; j < TOPK; ++j) rr[j] = rec[row * TOPK + j];
        float4 xr[4][2];
#pragma unroll
        for (int i = 0; i < 4; ++i) { const int c = lane * 8 + i * 512; xr[i][0] = *(const float4*)(x + (size_t)row * D + c); xr[i][1] = *(const float4*)(x + (size_t)row * D + c + 4); }
#pragma unroll
        for (int jb = 0; jb <= TOPK; jb += 8) {
            u32x2 yv[7][4]; float wj[7];
#pragma unroll
            for (int jj = 0; jj < 7; ++jj) { const int j = jb + jj; if (j > TOPK) break;
                size_t slot = (size_t)SLOT_SH + row; wj[jj] = Y8_INV;
                if (j < TOPK) { const int e = (int)(rr[j].x >> 13), pos = (int)(rr[j].x & 8191u); wj[jj] = __uint_as_float(rr[j].y) * Y8_INV; slot = (size_t)tstart[e] * BM + pos; }
                const unsigned char* yp = (const unsigned char*)Y + slot * D + lane * 8;
#pragma unroll
                for (int i = 0; i < 4; ++i) yv[jj][i] = *(const u32x2*)(yp + i * 512);
            }
#pragma unroll
            for (int jj = 0; jj < 7; ++jj) { const int j = jb + jj; if (j > TOPK) break; const float w = wj[jj];
#pragma unroll
                for (int i = 0; i < 4; ++i) { const u32x2 y2 = yv[jj][i];
                    const f32x2v p0 = __builtin_amdgcn_cvt_pk_f32_fp8((int)y2.x, false), p1 = __builtin_amdgcn_cvt_pk_f32_fp8((int)y2.x, true), p2 = __builtin_amdgcn_cvt_pk_f32_fp8((int)y2.y, false), p3 = __builtin_amdgcn_cvt_pk_f32_fp8((int)y2.y, true);
                    a[i][0] += w * p0.x; a[i][1] += w * p0.y; a[i][2] += w * p1.x; a[i][3] += w * p1.y;
                    a[i][4] += w * p2.x; a[i][5] += w * p2.y; a[i][6] += w * p3.x; a[i][7] += w * p3.y; }
            }
            asm volatile("" ::: "memory");
        }
        float ss = 0.f;
#pragma unroll
        for (int i = 0; i < 4; ++i) { const int c = lane * 8 + i * 512;
#pragma unroll
            for (int h = 0; h < 2; ++h) { const float4 xv = xr[i][h], gv = *(const float4*)(gf + c + h * 4);
                a[i][h * 4 + 0] = xv.x + gv.x * a[i][h * 4 + 0]; a[i][h * 4 + 1] = xv.y + gv.y * a[i][h * 4 + 1]; a[i][h * 4 + 2] = xv.z + gv.z * a[i][h * 4 + 2]; a[i][h * 4 + 3] = xv.w + gv.w * a[i][h * 4 + 3]; }
#pragma unroll
            for (int q = 0; q < 8; ++q) ss += a[i][q] * a[i][q]; }
        if (MODE == 0 || MODE == 2) {
#pragma unroll
            for (int i = 0; i < 4; ++i) { float* op = xout + (size_t)row * D + lane * 8 + i * 512; *(float4*)op = make_float4(a[i][0], a[i][1], a[i][2], a[i][3]); *(float4*)(op + 4) = make_float4(a[i][4], a[i][5], a[i][6], a[i][7]); }
        }
        if (MODE == 1 || MODE == 2) {
            ss = wave_sum(ss);
            const float r = rsqrtf(ss * (1.f / D) + EPS);
            asm volatile("" ::: "memory");
            float4 g4[4][2];
#pragma unroll
            for (int i = 0; i < 4; ++i) { const int c = lane * 8 + i * 512; g4[i][0] = *(const float4*)(ng + c); g4[i][1] = *(const float4*)(ng + c + 4); }
#pragma unroll
            for (int i = 0; i < 4; ++i) { const int c = lane * 8 + i * 512; float o[8];
                const float gq[8] = {g4[i][0].x, g4[i][0].y, g4[i][0].z, g4[i][0].w, g4[i][1].x, g4[i][1].y, g4[i][1].z, g4[i][1].w};
#pragma unroll
                for (int q = 0; q < 8; ++q) { o[q] = a[i][q] * r * gq[q]; if (MODE == 2) o[q] = o[q] * (1.f + sc[c + q]) + sh[c + q]; }
                if (MODE == 1) { float* op = xout + (size_t)row * D + c; *(float4*)op = make_float4(o[0], o[1], o[2], o[3]); *(float4*)(op + 4) = make_float4(o[4], o[5], o[6], o[7]); }
                else { u32x4 w; w.x = cvt_pk_bf16(o[0], o[1]); w.y = cvt_pk_bf16(o[2], o[3]); w.z = cvt_pk_bf16(o[4], o[5]); w.w = cvt_pk_bf16(o[6], o[7]); *(u32x4*)(hbuf + (size_t)row * D + c) = w; } }
        }
    }
}

constexpr int BG_STEPS = 2 * 3 * 4096 * 8;
struct BgState { float r[64]; bf16_t* dst[2]; int o2[2]; int st; };
__device__ __forceinline__ bool bg_decode(int st, int wg, int NW, int lane, KP kp, const float*& src, int& ldS, bf16_t*& dst, int& o2) {
    const int g = st * NW + wg;
    if (g >= BG_STEPS) { src = kp->in[27] + lane; ldS = 0; dst = nullptr; o2 = 0; return false; }
    const int l = g / 98304, r = g - l * 98304;
    unsigned char* ws = kp->ws;
    if (r < 65536) {
        const int e = r >> 10, kc = (r >> 2) & 255, kind = (r >> 1) & 1, cc = r & 1, n = cc * 256 + lane;
        ldS = FF; o2 = 256 * 8;
        src = kp->in[27 + kind] + ((size_t)(l * NE + e) * D + kc * 8) * FF + n;
        const int drow = (n >> 7) * 256 + kind * 128 + (n & 127);
        dst = (bf16_t*)(ws + WS_WGU) + l * WGU_L + (size_t)e * 1024 * D + ((size_t)kc * 1024 + drow) * 8;
    } else {
        const int r2 = r - 65536, e = r2 >> 9, kc = (r2 >> 3) & 63, cc = r2 & 7, n = cc * 256 + lane;
        ldS = D; o2 = 128 * 8;
        src = kp->in[29] + ((size_t)(l * NE + e) * FF + kc * 8) * D + n;
        dst = (bf16_t*)(ws + WS_WD) + l * WD_L + (size_t)e * D * FF + ((size_t)kc * D + n) * 8;
    }
    return true;
}
template <int NS> __device__ __forceinline__ void bg_issue(BgState& b, int wg, int NW, int lane) {
    KP kp = kparams();
#pragma unroll
    for (int s = 0; s < NS; ++s) { const float* src; int ldS; bf16_t* dst; int o2;
        bg_decode(b.st + s, wg, NW, lane, kp, src, ldS, dst, o2);
        b.dst[s] = dst; b.o2[s] = o2;
#pragma unroll
        for (int i = 0; i < 8; ++i) { const float* p = src + (size_t)i * ldS;
            asm volatile("global_load_dword %0, %4, off\n\tglobal_load_dword %1, %4, off offset:256\n\tglobal_load_dword %2, %4, off offset:512\n\tglobal_load_dword %3, %4, off offset:768"
                         : "=&v"(b.r[(s * 8 + i) * 4 + 0]), "=&v"(b.r[(s * 8 + i) * 4 + 1]), "=&v"(b.r[(s * 8 + i) * 4 + 2]), "=&v"(b.r[(s * 8 + i) * 4 + 3]) : "v"(p) : "memory"); }
    }
}
#define BG_TIE16(o) "+v"(b.r[o + 0]), "+v"(b.r[o + 1]), "+v"(b.r[o + 2]), "+v"(b.r[o + 3]), "+v"(b.r[o + 4]), "+v"(b.r[o + 5]), "+v"(b.r[o + 6]), "+v"(b.r[o + 7]), "+v"(b.r[o + 8]), "+v"(b.r[o + 9]), "+v"(b.r[o + 10]), "+v"(b.r[o + 11]), "+v"(b.r[o + 12]), "+v"(b.r[o + 13]), "+v"(b.r[o + 14]), "+v"(b.r[o + 15])
template <int NS> __device__ __forceinline__ void bg_finish(BgState& b, int wg, int NW, int lane) {
    asm volatile("s_waitcnt vmcnt(0)" ::: "memory");
    asm volatile("" : BG_TIE16(0) :: "memory");
    asm volatile("" : BG_TIE16(16) :: "memory");
    if (NS == 2) { asm volatile("" : BG_TIE16(32) :: "memory"); asm volatile("" : BG_TIE16(48) :: "memory"); }
#pragma unroll
    for (int s = 0; s < NS; ++s) { bf16_t* dst = b.dst[s];
        if (dst != nullptr) {
#pragma unroll
            for (int c = 0; c < 4; ++c) { u32x4 w;
                w.x = cvt_pk_bf16(b.r[(s * 8 + 0) * 4 + c], b.r[(s * 8 + 1) * 4 + c]); w.y = cvt_pk_bf16(b.r[(s * 8 + 2) * 4 + c], b.r[(s * 8 + 3) * 4 + c]);
                w.z = cvt_pk_bf16(b.r[(s * 8 + 4) * 4 + c], b.r[(s * 8 + 5) * 4 + c]); w.w = cvt_pk_bf16(b.r[(s * 8 + 6) * 4 + c], b.r[(s * 8 + 7) * 4 + c]);
                bf16_t* dp = dst + (c & 1) * 512 + (c >> 1) * b.o2[s];
                asm volatile("global_store_dwordx4 %0, %1, off\n\ts_nop 1" :: "v"(dp), "v"(w) : "memory"); }
        } }
    b.st += NS;
}
template <int BANK> __device__ __forceinline__ void bg_issue1(BgState& b, int wg, int NW, int lane) {
    KP kp = kparams();
    const float* src; int ldS; bf16_t* dst; int o2;
    bg_decode(b.st, wg, NW, lane, kp, src, ldS, dst, o2);
    b.dst[BANK] = dst; b.o2[BANK] = o2;
    asm volatile("s_nop 6" ::: "memory");
#pragma unroll
    for (int i = 0; i < 8; ++i) { const float* p = src + (size_t)i * ldS;
        asm volatile("global_load_dword %0, %4, off\n\tglobal_load_dword %1, %4, off offset:256\n\tglobal_load_dword %2, %4, off offset:512\n\tglobal_load_dword %3, %4, off offset:768"
                     : "=&v"(b.r[(BANK * 8 + i) * 4 + 0]), "=&v"(b.r[(BANK * 8 + i) * 4 + 1]), "=&v"(b.r[(BANK * 8 + i) * 4 + 2]), "=&v"(b.r[(BANK * 8 + i) * 4 + 3]) : "v"(p) : "memory"); }
    b.st += 1;
}
template <int BANK, int WAITN> __device__ __forceinline__ void bg_finish1(BgState& b) {
    if (WAITN == 32) asm volatile("s_waitcnt vmcnt(32)" ::: "memory"); else asm volatile("s_waitcnt vmcnt(0)" ::: "memory");
    asm volatile("" : BG_TIE16(BANK * 32) :: "memory");
    asm volatile("" : BG_TIE16(BANK * 32 + 16) :: "memory");
    bf16_t* dst = b.dst[BANK];
    if (dst != nullptr) {
#pragma unroll
        for (int c = 0; c < 4; ++c) { u32x4 w;
            w.x = cvt_pk_bf16(b.r[(BANK * 8 + 0) * 4 + c], b.r[(BANK * 8 + 1) * 4 + c]); w.y = cvt_pk_bf16(b.r[(BANK * 8 + 2) * 4 + c], b.r[(BANK * 8 + 3) * 4 + c]);
            w.z = cvt_pk_bf16(b.r[(BANK * 8 + 4) * 4 + c], b.r[(BANK * 8 + 5) * 4 + c]); w.w = cvt_pk_bf16(b.r[(BANK * 8 + 6) * 4 + c], b.r[(BANK * 8 + 7) * 4 + c]);
            bf16_t* dp = dst + (c & 1) * 512 + (c >> 1) * b.o2[BANK];
            asm volatile("global_store_dwordx4 %0, %1, off\n\ts_nop 1" :: "v"(dp), "v"(w) : "memory"); }
    }
}
#undef BG_TIE16

constexpr size_t BIG_U    = 0;
constexpr size_t BIG_X0C  = (size_t)104857600;
constexpr size_t BIG_VGT  = (size_t)146800640;
constexpr size_t BIG_A3   = (size_t)220200960;
constexpr size_t BIG_GSPEC = (size_t)230686720;
#define FFT_HD __device__ __forceinline__
typedef float cf2 __attribute__((ext_vector_type(2)));
FFT_HD cf2 mk2(float x, float y) { return (cf2){x, y}; }
FFT_HD void fft_sincos(float frac, float& s, float& c) { s = __builtin_amdgcn_sinf(frac); c = __builtin_amdgcn_cosf(frac); }
constexpr int FN = 16384;
#define PADI(n) ((n) + (((n) >> 6) << 1))
constexpr int FN_PAD = FN + (FN >> 6) * 2;
FFT_HD cf2 cmul(cf2 a, cf2 b) { return mk2(a.x * b.x - a.y * b.y, a.x * b.y + a.y * b.x); }
FFT_HD cf2 cmulc(cf2 a, cf2 b) { return mk2(a.x * b.x + a.y * b.y, a.y * b.x - a.x * b.y); }
FFT_HD cf2 cadd(cf2 a, cf2 b) { return mk2(a.x + b.x, a.y + b.y); }
FFT_HD cf2 csub(cf2 a, cf2 b) { return mk2(a.x - b.x, a.y - b.y); }
template <bool INV> FFT_HD void dft4(cf2& a, cf2& b, cf2& c, cf2& d) {
    const cf2 s0 = cadd(a, c), s1 = csub(a, c), s2 = cadd(b, d), s3 = csub(b, d);
    a = cadd(s0, s2); c = csub(s0, s2);
    const cf2 r = INV ? mk2(-s3.y, s3.x) : mk2(s3.y, -s3.x);
    b = cadd(s1, r); d = csub(s1, r);
}
template <bool INV> FFT_HD void dft16(cf2 (&x)[16]) {
    const float C1 = 0.9238795325112867f, S1 = 0.3826834323650898f, H = 0.7071067811865476f;
#pragma unroll
    for (int b = 0; b < 4; ++b) dft4<INV>(x[b], x[4 + b], x[8 + b], x[12 + b]);
    const float s = INV ? -1.f : 1.f;
    x[4 + 1] = cmul(x[4 + 1], mk2(C1, -s * S1)); x[8 + 1] = cmul(x[8 + 1], mk2(H, -s * H));   x[12 + 1] = cmul(x[12 + 1], mk2(S1, -s * C1));
    x[4 + 2] = cmul(x[4 + 2], mk2(H, -s * H));   x[8 + 2] = cmul(x[8 + 2], mk2(0.f, -s));     x[12 + 2] = cmul(x[12 + 2], mk2(-H, -s * H));
    x[4 + 3] = cmul(x[4 + 3], mk2(S1, -s * C1)); x[8 + 3] = cmul(x[8 + 3], mk2(-H, -s * H));  x[12 + 3] = cmul(x[12 + 3], mk2(-C1, s * S1));
#pragma unroll
    for (int c = 0; c < 4; ++c) dft4<INV>(x[4 * c], x[4 * c + 1], x[4 * c + 2], x[4 * c + 3]);
#pragma unroll
    for (int c = 0; c < 4; ++c)
#pragma unroll
        for (int d = c + 1; d < 4; ++d) { const cf2 t = x[4 * c + d]; x[4 * c + d] = x[4 * d + c]; x[4 * d + c] = t; }
}
FFT_HD void fft_gen_tw(float frac, cf2 (&tw)[16]) {
    float sn, cs; fft_sincos(frac, sn, cs);
    tw[1] = mk2(cs, -sn);
    tw[2] = cmul(tw[1], tw[1]); tw[3] = cmul(tw[2], tw[1]); tw[4] = cmul(tw[2], tw[2]); tw[5] = cmul(tw[4], tw[1]); tw[6] = cmul(tw[4], tw[2]); tw[7] = cmul(tw[4], tw[3]);
    tw[8] = cmul(tw[4], tw[4]);
#pragma unroll
    for (int j = 9; j < 16; ++j) tw[j] = cmul(tw[8], tw[j - 8]);
}
template <bool INV, int lS, class ZP> FFT_HD void fft_r16_pass(ZP z, int tid) {
    constexpr int S = 1 << lS, STEP = (S >= 64) ? S + S / 32 : S;
    constexpr float inv = 1.0f / (float)(16 * S);
    cf2 tw[16];
    if (lS != 10) {
        fft_gen_tw((float)(tid & (S - 1)) * inv, tw);
        const int w0 = tid, w1 = tid + 512;
        const int pb0 = PADI(((w0 >> lS) << (lS + 4)) + (w0 & (S - 1))), pb1 = PADI(((w1 >> lS) << (lS + 4)) + (w1 & (S - 1)));
        cf2 x[16], y[16];
#pragma unroll
        for (int j = 0; j < 16; ++j) x[j] = z[pb0 + j * STEP];
#pragma unroll
        for (int j = 0; j < 16; ++j) y[j] = z[pb1 + j * STEP];
        if (INV) {
#pragma unroll
            for (int j = 1; j < 16; ++j) x[j] = cmulc(x[j], tw[j]);
        }
        dft16<INV>(x);
        if (!INV) {
#pragma unroll
            for (int j = 1; j < 16; ++j) x[j] = cmul(x[j], tw[j]);
        }
#pragma unroll
        for (int j = 0; j < 16; ++j) z[pb0 + j * STEP] = x[j];
        if (INV) {
#pragma unroll
            for (int j = 1; j < 16; ++j) y[j] = cmulc(y[j], tw[j]);
        }
        dft16<INV>(y);
        if (!INV) {
#pragma unroll
            for (int j = 1; j < 16; ++j) y[j] = cmul(y[j], tw[j]);
        }
#pragma unroll
        for (int j = 0; j < 16; ++j) z[pb1 + j * STEP] = y[j];
    } else {
#pragma unroll 1
        for (int it = 0; it < 2; ++it) {
            const int w = tid + 512 * it;
            const int blk = w >> lS, p = w & (S - 1), pb = PADI((blk << (lS + 4)) + p);
            fft_gen_tw((float)p * inv, tw);
            cf2 x[16];
#pragma unroll
            for (int j = 0; j < 16; ++j) x[j] = z[pb + j * STEP];
            if (INV) {
#pragma unroll
                for (int j = 1; j < 16; ++j) x[j] = cmulc(x[j], tw[j]);
            }
            dft16<INV>(x);
            if (!INV) {
#pragma unroll
                for (int j = 1; j < 16; ++j) x[j] = cmul(x[j], tw[j]);
            }
#pragma unroll
            for (int j = 0; j < 16; ++j) z[pb + j * STEP] = x[j];
        }
    }
}
template <bool INV, class ZP> FFT_HD void fft_r4_pass(ZP z, int tid, int nthr) {
    for (int w = tid; w < FN / 4; w += nthr) {
        const int base = PADI(4 * w);
        cf2 a = z[base], b = z[base + 1], c = z[base + 2], d = z[base + 3];
        dft4<INV>(a, b, c, d);
        z[base] = a; z[base + 1] = b; z[base + 2] = c; z[base + 3] = d;
    }
}
FFT_HD int fpos(int k) { return ((k & 15) << 10) + (((k >> 4) & 15) << 6) + (((k >> 8) & 15) << 2) + (k >> 12); }

__device__ __forceinline__ void hy_filter_mlp(LAS float* sm, int bid, int G, const float* w0, const float* b0, const float* w1, const float* b1, const float* w2, const float* b2, const float* freq, float* a3) {
    const int tid = tid_fresh(), lane = tid & 63, wave = tid >> 6;
    LAS float* w0s = sm; LAS float* w1s = sm + 33 * 64; LAS float* w2s = w1s + 4096;
    __syncthreads();
    for (int i = tid; i < 33 * 64; i += NTHR) w0s[i] = w0[i];
    for (int i = tid; i < 4096; i += NTHR) { w1s[i] = w1[i]; w2s[i] = w2[i]; }
    __syncthreads();
    const float fr = freq[lane], bb0 = b0[lane], bb1 = b1[lane], bb2 = b2[lane];
    for (int row = bid * 8 + wave; row < T; row += G * 8) {
        const float tn = (float)row / (float)(T - 1);
        const float ang = 6.283185307179586f * (float)row / (float)T;
        float zi = 0.f;
        if (lane == 0) zi = tn;
        else if (lane <= 16) { const float band = 1e-4f + (float)(lane - 1) * ((15.f - 1e-4f) / 15.f); zi = cosf(ang * band); }
        else if (lane <= 32) { const float band = 1e-4f + (float)(lane - 17) * ((15.f - 1e-4f) / 15.f); zi = -sinf(ang * band); }
        float acc = bb0;
#pragma unroll 1
        for (int i = 0; i < 33; ++i) acc += __shfl(zi, i) * w0s[i * 64 + lane];
        float a = sinf(fr * acc);
        acc = bb1;
#pragma unroll 4
        for (int i = 0; i < 64; ++i) acc += __shfl(a, i) * w1s[i * 64 + lane];
        a = sinf(fr * acc);
        acc = bb2;
#pragma unroll 4
        for (int i = 0; i < 64; ++i) acc += __shfl(a, i) * w2s[i * 64 + lane];
        a = sinf(fr * acc);
        a3[(size_t)row * 64 + lane] = a;
    }
    __syncthreads();
}

__device__ __forceinline__ void hy_conv_phase(LAS unsigned char* lds, int bid, int G, const bf16_t* u, const float* cw, const float* cb, bf16_t* x0c, bf16_t* vgT) {
    LAS float* sm = (LAS float*)lds;
    const int tid = tid_fresh();
#define HC_LOAD(tile_, v_) do { const int t0_ = ((tile_) >> 5) * 64, c0_ = ((tile_) & 31) * 64; \
        _Pragma("unroll") for (int it = 0; it < 4; ++it) { const int id0 = tid + NTHR * it, id = id0 < 3 * 66 * 8 ? id0 : 3 * 66 * 8 - 1; \
            const int g = id / 528, r = id - g * 528, row = r >> 3, ch = r & 7, t1 = t0_ - 1 + row, t = t1 < 0 ? 0 : (t1 > T - 1 ? T - 1 : t1); \
            v_[it] = *(const u32x4*)(u + (size_t)t * 6144 + g * 2048 + c0_ + ch * 8); } } while (0)
    u32x4 pv[4];
    if (bid < 4096) HC_LOAD(bid, pv);
    float wa[8], wb[8], wc_[8], wd[8]; float p0 = 0.f, p1 = 0.f, p2 = 0.f, pb = 0.f, q0 = 0.f, q1 = 0.f, q2 = 0.f, qb = 0.f; int cwc0 = -1;
    for (int tile = bid; tile < 4096; tile += G) {
        const int t0 = (tile >> 5) * 64, c0 = (tile & 31) * 64;
        if (c0 != cwc0) { cwc0 = c0;
#pragma unroll
            for (int q = 0; q < 8; ++q) { const int cc = c0 + (tid & 7) * 8 + q; wa[q] = cw[cc]; wb[q] = cw[6144 + cc]; wc_[q] = cw[12288 + cc]; wd[q] = cb[cc]; }
            const int c1 = 2048 + c0 + (tid >> 3), c2 = 4096 + c0 + (tid >> 3);
            p0 = cw[c1]; p1 = cw[6144 + c1]; p2 = cw[12288 + c1]; pb = cb[c1]; q0 = cw[c2]; q1 = cw[6144 + c2]; q2 = cw[12288 + c2]; qb = cb[c2]; }
        __syncthreads();
#pragma unroll
        for (int it = 0; it < 4; ++it) { const int id = tid + NTHR * it;
            if (id < 3 * 66 * 8) { const int g = id / 528, r = id - g * 528, row = r >> 3, ch = r & 7; const u32x4 v = pv[it];
                const int tr = t0 - 1 + row; const float mk = (tr >= 0 && tr < T) ? 1.f : 0.f;
                LAS float* dp = sm + (g * 66 + row) * 65 + ch * 8;
                dp[0] = bf_lo(v.x) * mk; dp[1] = bf_hi(v.x) * mk; dp[2] = bf_lo(v.y) * mk; dp[3] = bf_hi(v.y) * mk; dp[4] = bf_lo(v.z) * mk; dp[5] = bf_hi(v.z) * mk; dp[6] = bf_lo(v.w) * mk; dp[7] = bf_hi(v.w) * mk; } }
        if (tile + G < 4096) HC_LOAD(tile + G, pv);
        __syncthreads();
        {   const int t = tid >> 3, ch = tid & 7; float o[8];
#pragma unroll
            for (int q = 0; q < 8; ++q) { const int c = ch * 8 + q;
                o[q] = sm[t * 65 + c] * wa[q] + sm[(t + 1) * 65 + c] * wb[q] + sm[(t + 2) * 65 + c] * wc_[q] + wd[q]; }
            u32x4 w; w.x = cvt_pk_bf16(o[0], o[1]); w.y = cvt_pk_bf16(o[2], o[3]); w.z = cvt_pk_bf16(o[4], o[5]); w.w = cvt_pk_bf16(o[6], o[7]);
            *(u32x4*)(x0c + (size_t)(t0 + t) * D + c0 + ch * 8) = w; }
        {   const int c = tid >> 3, tc = tid & 7;
            float o[8];
#pragma unroll
            for (int q = 0; q < 8; ++q) { const int t = tc * 8 + q;
                const float x1 = sm[(66 + t) * 65 + c] * p0 + sm[(66 + t + 1) * 65 + c] * p1 + sm[(66 + t + 2) * 65 + c] * p2 + pb;
                const float vv = sm[(132 + t) * 65 + c] * q0 + sm[(132 + t + 1) * 65 + c] * q1 + sm[(132 + t + 2) * 65 + c] * q2 + qb;
                o[q] = x1 * vv; }
            u32x4 w; w.x = cvt_pk_bf16(o[0], o[1]); w.y = cvt_pk_bf16(o[2], o[3]); w.z = cvt_pk_bf16(o[4], o[5]); w.w = cvt_pk_bf16(o[6], o[7]);
            *(u32x4*)(vgT + (size_t)(c0 + c) * T + t0 + tc * 8) = w; }
    }
#undef HC_LOAD
    __syncthreads();
}

#define SEG_LD32(dst, off, base) asm volatile("global_load_dword %0, %1, %2" : "=v"(dst) : "v"(off), "s"(base) : "memory")
#define SEG_LD64(dst, off, base) asm volatile("global_load_dwordx2 %0, %1, %2" : "=v"(dst) : "v"(off), "s"(base) : "memory")
#define SEG_WAIT() asm volatile("s_waitcnt vmcnt(32)\n\ts_nop 7" ::: "memory")
#define SEG_TIE8(a, o) "+v"(a[o + 0]), "+v"(a[o + 1]), "+v"(a[o + 2]), "+v"(a[o + 3]), "+v"(a[o + 4]), "+v"(a[o + 5]), "+v"(a[o + 6]), "+v"(a[o + 7])
constexpr int GS_LD = 8256;
__device__ __forceinline__ void hy_fft_phase(LAS unsigned char* lds, int bid, int G, const bf16_t* vgT, bf16_t* zT, const float* a3, const float* wout, const float* skip, float* filt, float4* gspec) {
    LAS cf2* z = (LAS cf2*)lds;
    bf16_t* F = (bf16_t*)filt + (size_t)bid * 8 * FN;
    u32x2* GS = (u32x2*)gspec + (size_t)bid * GS_LD;
    BgState bg; bg.st = 0; const int bgNW = G * 8; int bgwg, bglane;
    { const int t0_ = tid_fresh(); bgwg = __builtin_amdgcn_readfirstlane(bid * 8 + (t0_ >> 6)); bglane = t0_ & 63; }
#define BG_BEGIN(ns) bg_issue<ns>(bg, bgwg, bgNW, bglane)
#define BG_END(ns) bg_finish<ns>(bg, bgwg, bgNW, bglane)
#define BG_I(x) bg_issue1<x>(bg, bgwg, bgNW, bglane)
#define BG_F(y) bg_finish1<y, 32>(bg)
    const int nch = (D - bid + G - 1) / G;
    for (int g0 = 0; g0 < nch; g0 += 8) {
#pragma unroll 1
        for (int rept_ = 0; rept_ < REP_TAP; ++rept_)
        {
            const int tid = tid_fresh(), lane = tid & 63, wave = tid >> 6, col = lane & 15, kc = lane >> 4;
            const int ci = g0 + (col >> 1), c = bid + G * ci; const bool cok = ci < nch;
            bf16x8 bw[2];
#pragma unroll
            for (int ks = 0; ks < 2; ++ks) { float wv[8];
#pragma unroll
                for (int q = 0; q < 8; ++q) wv[q] = wout[(size_t)(ks * 32 + kc * 8 + q) * 4096 + (col & 1) * D + (cok ? c : bid)] * (cok ? 1.f : 0.f);
                u32x4 w; w.x = cvt_pk_bf16(wv[0], wv[1]); w.y = cvt_pk_bf16(wv[2], wv[3]); w.z = cvt_pk_bf16(wv[4], wv[5]); w.w = cvt_pk_bf16(wv[6], wv[7]);
                bw[ks] = __builtin_bit_cast(bf16x8, w); }
            const float dlo = -15.350567286626973f, dhi = -3.0701134573253946f;
            const float delta = fabsf(dlo + (float)c * ((dhi - dlo) / (float)(D - 1)));
            __syncthreads();
            auto tap_load = [&](int blk, float4 (&av)[4]) {
                const float* ap = a3 + (size_t)(blk * 16 + col) * 64 + kc * 8;
                av[0] = *(const float4*)(ap); av[1] = *(const float4*)(ap + 4); av[2] = *(const float4*)(ap + 32); av[3] = *(const float4*)(ap + 36);
            };
            auto tap_blk = [&](int blk, const float4 (&av)[4]) {
                f32x4 acc = (f32x4){0.f, 0.f, 0.f, 0.f};
#pragma unroll
                for (int ks = 0; ks < 2; ++ks) { const float4 a0 = av[ks * 2], a1 = av[ks * 2 + 1];
                    u32x4 w; w.x = cvt_pk_bf16(a0.x, a0.y); w.y = cvt_pk_bf16(a0.z, a0.w); w.z = cvt_pk_bf16(a1.x, a1.y); w.w = cvt_pk_bf16(a1.z, a1.w);
                    acc = __builtin_amdgcn_mfma_f32_16x16x32_bf16(__builtin_bit_cast(bf16x8, w), bw[ks], acc, 0, 0, 0); }
                const int tb = blk * 16 + kc * 4;
                float4 o;
                const float dsc = -delta * (1.f / (float)(T - 1));
                o.x = acc[0] * __expf((float)(tb + 0) * dsc); o.y = acc[1] * __expf((float)(tb + 1) * dsc);
                o.z = acc[2] * __expf((float)(tb + 2) * dsc); o.w = acc[3] * __expf((float)(tb + 3) * dsc);
                bf16_t* Arow = F + (size_t)(col >> 1) * FN;
                if ((col & 1) == 0) { u32x2 w; w.x = cvt_pk_bf16(o.x, o.y); w.y = cvt_pk_bf16(o.z, o.w); *(u32x2*)(Arow + tb) = w; }
                else {
                    Arow[FN - tb - 3] = (bf16_t)(cvt_pk_bf16(o.w, 0.f) & 0xffffu);
                    *(unsigned*)(Arow + FN - tb - 2) = cvt_pk_bf16(o.z, o.y);
                    if (tb > 0) Arow[FN - tb] = (bf16_t)(cvt_pk_bf16(o.x, 0.f) & 0xffffu); else Arow[T] = (bf16_t)0;
                }
            };
            BG_I(0);
#pragma unroll 1
            for (int ob = 0; ob < 8; ob += 2) {
                BG_I(1);
#define TAP_GROUP(b0) do { float4 av_[4][4]; \
                    _Pragma("unroll") for (int bi = 0; bi < 4; ++bi) tap_load(wave + 8 * ((b0) + bi), av_[bi]); \
                    _Pragma("unroll") for (int bi = 0; bi < 4; ++bi) tap_blk(wave + 8 * ((b0) + bi), av_[bi]); } while (0)
                TAP_GROUP(ob * 8); TAP_GROUP(ob * 8 + 4);
                BG_F(0);
                BG_I(0);
                TAP_GROUP((ob + 1) * 8); TAP_GROUP((ob + 1) * 8 + 4);
#undef TAP_GROUP
                BG_F(1);
            }
            __syncthreads();
        }
        int tid = tid_fresh();
#define FFT_FWD_ALL() do { tid = tid_fresh(); BG_I(0); fft_r16_pass<false, 10>(z, tid); __syncthreads(); BG_F(1); BG_I(1); fft_r16_pass<false, 6>(z, tid); __syncthreads(); BG_F(0); BG_I(0); fft_r16_pass<false, 2>(z, tid); __syncthreads(); BG_F(1); BG_I(1); fft_r4_pass<false>(z, tid, NTHR); __syncthreads(); BG_F(0); } while (0)
        for (int ci = g0; ci < g0 + 8 && ci < nch; ci += 2) {
            const bool has2 = (ci + 1 < nch);
            const int c1 = bid + G * ci, c2 = has2 ? bid + G * (ci + 1) : c1;
            const bf16_t* A1 = F + (size_t)(ci - g0) * FN; const bf16_t* A2 = has2 ? A1 + FN : A1;
            const bf16_t* v1 = vgT + (size_t)c1 * T; const bf16_t* v2 = vgT + (size_t)c2 * T;
            __syncthreads();
#pragma unroll 1
            for (int rep_ = 0; rep_ < REP_F1; ++rep_) {
            tid = tid_fresh();
            {   unsigned pa[16], pb[16]; float sk[2];
                const float* skp = skip; asm volatile("" : "+s"(skp));
#pragma unroll
                for (int i = 0; i < 16; ++i) { const unsigned off = 4u * tid + 2048u * i; SEG_LD32(pa[i], off, A1); SEG_LD32(pb[i], off, A2); }
                { const unsigned o1 = 4u * c1, o2 = 4u * c2; SEG_LD32(sk[0], o1, skp); SEG_LD32(sk[1], o2, skp); }
                BG_I(1);
                SEG_WAIT(); asm volatile("" : SEG_TIE8(pa, 0), SEG_TIE8(pa, 8), SEG_TIE8(pb, 0) :: "memory");
                asm volatile("" : SEG_TIE8(pb, 8), "+v"(sk[0]), "+v"(sk[1]) :: "memory");
                const float sk1 = (tid == 0) ? sk[0] : 0.f, sk2 = (tid == 0 && has2) ? sk[1] : 0.f;
#pragma unroll
                for (int i = 0; i < 16; ++i) { const int n = 2 * tid + 2 * NTHR * i;
                    f32x4 fv = (f32x4){bf_lo(pa[i]), has2 ? bf_lo(pb[i]) : 0.f, bf_hi(pa[i]), has2 ? bf_hi(pb[i]) : 0.f};
                    if (i == 0) { fv[0] += sk1; fv[1] += sk2; }
                    *(LAS f32x4*)&z[PADI(n)] = fv; }
                BG_F(0);
            }
            __syncthreads();
            FFT_FWD_ALL();
            tid = tid_fresh();
            BG_I(0);
#pragma unroll 4
            for (int k = tid; k <= FN / 2; k += NTHR) {
                const cf2 zk = z[PADI(fpos(k))], zm = z[PADI(fpos((FN - k) & (FN - 1)))];
                u32x2 g; g.x = cvt_pk_bf16(0.5f * (zk.x + zm.x), 0.5f * (zk.y - zm.y)); g.y = cvt_pk_bf16(0.5f * (zk.y + zm.y), -0.5f * (zk.x - zm.x)); GS[k] = g;
            }
            BG_F(1);
            __syncthreads();
            }
            tid = tid_fresh();
            {   unsigned pa[8], pb[8];
#pragma unroll
                for (int i = 0; i < 8; ++i) { const unsigned off = 4u * tid + 2048u * i; SEG_LD32(pa[i], off, v1); SEG_LD32(pb[i], off, v2); }
                BG_I(1);
                SEG_WAIT(); asm volatile("" : SEG_TIE8(pa, 0), SEG_TIE8(pb, 0) :: "memory");
#pragma unroll
                for (int i = 0; i < 8; ++i) { const int n = 2 * tid + 2 * NTHR * i;
                    *(LAS f32x4*)&z[PADI(n)] = (f32x4){bf_lo(pa[i]), has2 ? bf_lo(pb[i]) : 0.f, bf_hi(pa[i]), has2 ? bf_hi(pb[i]) : 0.f};
                    *(LAS f32x4*)&z[PADI(T + n)] = (f32x4){0.f, 0.f, 0.f, 0.f}; }
                BG_F(0);
            }
            __syncthreads();
            FFT_FWD_ALL();
            tid = tid_fresh();
            {   u32x2 gq[16], gh;
#pragma unroll
                for (int i = 0; i < 16; ++i) { const unsigned off = 8u * tid + 4096u * i; SEG_LD64(gq[i], off, GS); }
                { const unsigned off = 8u * (FN / 2); SEG_LD64(gh, off, GS); }
                BG_I(0);
                SEG_WAIT(); asm volatile("" : SEG_TIE8(gq, 0), SEG_TIE8(gq, 8), "+v"(gh) :: "memory");
#pragma unroll
                for (int i = 0; i < 16; ++i) { const int k = tid + NTHR * i;
                    const int p1 = PADI(fpos(k)), p2 = PADI(fpos((FN - k) & (FN - 1)));
                    const cf2 zk = z[p1], zm = z[p2];
                    const cf2 V1 = mk2(0.5f * (zk.x + zm.x), 0.5f * (zk.y - zm.y)), V2 = mk2(0.5f * (zk.y + zm.y), -0.5f * (zk.x - zm.x));
                    const cf2 Y1 = cmul(V1, mk2(bf_lo(gq[i].x), bf_hi(gq[i].x))), Y2 = cmul(V2, mk2(bf_lo(gq[i].y), bf_hi(gq[i].y)));
                    z[p1] = mk2(Y1.x - Y2.y, Y1.y + Y2.x); z[p2] = mk2(Y1.x + Y2.y, Y2.x - Y1.y); }
                if (tid == 0) { const int k = FN / 2, p1 = PADI(fpos(k)); const cf2 zk = z[p1]; const float4 g1 = make_float4(bf_lo(gh.x), bf_hi(gh.x), bf_lo(gh.y), bf_hi(gh.y));
                    z[p1] = mk2(zk.x * g1.x, zk.y * g1.z); }
                BG_F(1);
            }
            __syncthreads();
            tid = tid_fresh();
            BG_I(1); fft_r4_pass<true>(z, tid, NTHR); __syncthreads(); BG_F(0);
            BG_I(0); fft_r16_pass<true, 2>(z, tid); __syncthreads(); BG_F(1); BG_I(1); fft_r16_pass<true, 6>(z, tid); __syncthreads(); BG_F(0); BG_I(0); fft_r16_pass<true, 10>(z, tid); __syncthreads(); BG_F(1);
            tid = tid_fresh();
            bf16_t* o1 = zT + (size_t)c1 * T; bf16_t* o2 = zT + (size_t)c2 * T;

            {
#pragma unroll
                for (int i = 0; i < 8; ++i) { const int n = 2 * tid + 2 * NTHR * i; const f32x4 y = *(const LAS f32x4*)&z[PADI(n)];
                    *(unsigned*)(o1 + n) = cvt_pk_bf16(y[0] * (1.f / (float)FN), y[2] * (1.f / (float)FN));
                    if (has2) *(unsigned*)(o2 + n) = cvt_pk_bf16(y[1] * (1.f / (float)FN), y[3] * (1.f / (float)FN)); }
            }

        }
        bg_finish1<0, 0>(bg);
#undef FFT_FWD_ALL
    }
    { const int nst = (BG_STEPS + bgNW - 1) / bgNW;
#pragma unroll 1
      while (bg.st < nst) { BG_BEGIN(2); BG_END(2); } }
#undef BG_BEGIN
#undef BG_END
#undef BG_I
#undef BG_F
    __syncthreads();
}

__device__ __forceinline__ void hy_tr_phase(LAS unsigned char* lds, int bid, int G, const bf16_t* zT, const bf16_t* x0c, bf16_t* yA) {
    LAS float* sm = (LAS float*)lds;
    const int tid = tid_fresh();
    const int c = tid >> 3, tc = tid & 7, t = tid >> 3, ch = tid & 7;
#define HT_LOAD(tile_) do { const int t0_ = ((tile_) >> 5) * 64, c0_ = ((tile_) & 31) * 64; pz = *(const u32x4*)(zT + (size_t)(c0_ + c) * T + t0_ + tc * 8); px = *(const u32x4*)(x0c + (size_t)(t0_ + t) * D + c0_ + ch * 8); } while (0)
    u32x4 pz = (u32x4){0u, 0u, 0u, 0u}, px = (u32x4){0u, 0u, 0u, 0u};
    if (bid < 4096) HT_LOAD(bid);
    for (int tile = bid; tile < 4096; tile += G) {
        const int t0 = (tile >> 5) * 64, c0 = (tile & 31) * 64;
        __syncthreads();
        {   LAS float* dp = sm + c * 65 + tc * 8; dp[0] = bf_lo(pz.x); dp[1] = bf_hi(pz.x); dp[2] = bf_lo(pz.y); dp[3] = bf_hi(pz.y); dp[4] = bf_lo(pz.z); dp[5] = bf_hi(pz.z); dp[6] = bf_lo(pz.w); dp[7] = bf_hi(pz.w); }
        const u32x4 xv = px;
        if (tile + G < 4096) HT_LOAD(tile + G);
        __syncthreads();
        {   const size_t off = (size_t)(t0 + t) * D + c0 + ch * 8;
            const LAS float* sp = sm + (ch * 8) * 65 + t;
            u32x4 w; w.x = cvt_pk_bf16(sp[0] * bf_lo(xv.x), sp[65] * bf_hi(xv.x)); w.y = cvt_pk_bf16(sp[130] * bf_lo(xv.y), sp[195] * bf_hi(xv.y));
            w.z = cvt_pk_bf16(sp[260] * bf_lo(xv.z), sp[325] * bf_hi(xv.z)); w.w = cvt_pk_bf16(sp[390] * bf_lo(xv.w), sp[455] * bf_hi(xv.w));
            *(u32x4*)(yA + off) = w; }
    }
#undef HT_LOAD
    __syncthreads();
}

constexpr size_t BIG_GATES = (size_t)283115520;
constexpr size_t BIG_SLOC  = BIG_VGT;
constexpr size_t BIG_ZLOC  = BIG_SLOC + (size_t)2 * 8 * 32 * 256 * 128 * 4;
constexpr size_t BIG_GTOT  = BIG_ZLOC + (size_t)2 * 8 * 32 * 128 * 4;
constexpr int MLC = 256, MLNC = T / MLC;
typedef float f32x4v __attribute__((ext_vector_type(4)));

__device__ __forceinline__ float logsigf(float x) { return fminf(x, 0.f) - log1pf(expf(-fabsf(x))); }

__device__ __forceinline__ void ml_norm_gates_phase(LAS unsigned char* lds, int bid, int G, const float* x, const float* g, const float* sc, const float* sh,
                                                    const float* w_in, const float* gate_b, bf16_t* hbuf, float* gates) {
    LAS float* hfs = (LAS float*)lds;
    LAS float* part = (LAS float*)lds;
    const int tid = tid_fresh();
    const int lane = tid & 63, wave = tid >> 6;
    for (int r0 = bid * 16; r0 < T; r0 += G * 16) {
        __syncthreads();
#pragma unroll 1
        for (int rr = 0; rr < 2; ++rr) {
            const int row = r0 + wave * 2 + rr;
            float4 v[8];
#pragma unroll
            for (int i = 0; i < 8; ++i) v[i] = *(const float4*)(x + (size_t)row * D + (lane + 64 * i) * 4);
            row_norm_mod(v, lane, g, sc, sh);
#pragma unroll
            for (int i = 0; i < 8; ++i) { const int c = (lane + 64 * i) * 4;
                u32x2 w; w.x = cvt_pk_bf16(v[i].x, v[i].y); w.y = cvt_pk_bf16(v[i].z, v[i].w); *(u32x2*)(hbuf + (size_t)row * D + c) = w;
                LAS float* hp = hfs + (wave * 2 + rr) * HFS_LD + c; hp[0] = v[i].x; hp[1] = v[i].y; hp[2] = v[i].z; hp[3] = v[i].w; }
        }
        __syncthreads();
        f32x4 acc[2];
        rows16_matmul<2>(hfs, w_in, 6176, 6144, wave, lane, acc);
        __syncthreads();
#pragma unroll
        for (int jt = 0; jt < 2; ++jt)
#pragma unroll
            for (int r = 0; r < 4; ++r) part[(wave * 16 + (lane >> 4) * 4 + r) * 32 + jt * 16 + (lane & 15)] = acc[jt][r];
        __syncthreads();
        {   const int rl = wave * 2 + (lane >> 5), col = lane & 31;
            float sacc = gate_b[col];
#pragma unroll
            for (int w = 0; w < 8; ++w) sacc += part[(w * 16 + rl) * 32 + col];
            gates[(size_t)(r0 + rl) * 32 + col] = sacc; }
    }
    __syncthreads();
}

__device__ __forceinline__ void ml_conv8(const bf16_t* P, int t, int col, const float* cw, const float* cb, int cch, float scale, float (&o)[8]) {
    const u32x4 z4 = (u32x4){0u, 0u, 0u, 0u};
    const u32x4 v0 = *(const u32x4*)(P + (size_t)t * 6144 + col);
    const u32x4 vm = (t > 0) ? *(const u32x4*)(P + (size_t)(t - 1) * 6144 + col) : z4;
    const u32x4 vp = (t < T - 1) ? *(const u32x4*)(P + (size_t)(t + 1) * 6144 + col) : z4;
    const float m[8] = {bf_lo(vm.x), bf_hi(vm.x), bf_lo(vm.y), bf_hi(vm.y), bf_lo(vm.z), bf_hi(vm.z), bf_lo(vm.w), bf_hi(vm.w)};
    const float c[8] = {bf_lo(v0.x), bf_hi(v0.x), bf_lo(v0.y), bf_hi(v0.y), bf_lo(v0.z), bf_hi(v0.z), bf_lo(v0.w), bf_hi(v0.w)};
    const float p[8] = {bf_lo(vp.x), bf_hi(vp.x), bf_lo(vp.y), bf_hi(vp.y), bf_lo(vp.z), bf_hi(vp.z), bf_lo(vp.w), bf_hi(vp.w)};
#pragma unroll
    for (int q = 0; q < 8; ++q) { const float xv = cw[cch + q] * m[q] + cw[2048 + cch + q] * c[q] + cw[4096 + cch + q] * p[q] + cb[cch + q]; o[q] = fdivf(xv, 1.f + __expf(-xv)) * scale; }
}

struct Row3 { u32x4 vm, v0, vp; float fm, fp; };
__device__ __forceinline__ Row3 ml_load3(const bf16_t* P, int t, int col) {
    Row3 r;
    const int tm = t > 0 ? t - 1 : 0, tp = t < T - 1 ? t + 1 : T - 1;
    r.v0 = *(const u32x4*)(P + (size_t)t * 6144 + col);
    r.vm = *(const u32x4*)(P + (size_t)tm * 6144 + col);
    r.vp = *(const u32x4*)(P + (size_t)tp * 6144 + col);
    r.fm = t > 0 ? 1.f : 0.f; r.fp = t < T - 1 ? 1.f : 0.f;
    return r;
}
struct Cw8 { float4 a[8]; };
__device__ __forceinline__ Cw8 ml_cw_load(const float* cw, const float* cb, int cch) {
    Cw8 w;
#pragma unroll
    for (int k = 0; k < 3; ++k) { w.a[2 * k] = *(const float4*)(cw + k * 2048 + cch); w.a[2 * k + 1] = *(const float4*)(cw + k * 2048 + cch + 4); }
    w.a[6] = *(const float4*)(cb + cch); w.a[7] = *(const float4*)(cb + cch + 4);
    return w;
}
__device__ __forceinline__ void ml_conv8c(const Row3& r, const Cw8& w, float scale, float (&o)[8]) {
    const float m[8] = {bf_lo(r.vm.x), bf_hi(r.vm.x), bf_lo(r.vm.y), bf_hi(r.vm.y), bf_lo(r.vm.z), bf_hi(r.vm.z), bf_lo(r.vm.w), bf_hi(r.vm.w)};
    const float c[8] = {bf_lo(r.v0.x), bf_hi(r.v0.x), bf_lo(r.v0.y), bf_hi(r.v0.y), bf_lo(r.v0.z), bf_hi(r.v0.z), bf_lo(r.v0.w), bf_hi(r.v0.w)};
    const float p[8] = {bf_lo(r.vp.x), bf_hi(r.vp.x), bf_lo(r.vp.y), bf_hi(r.vp.y), bf_lo(r.vp.z), bf_hi(r.vp.z), bf_lo(r.vp.w), bf_hi(r.vp.w)};
    const float w0[8] = {w.a[0].x, w.a[0].y, w.a[0].z, w.a[0].w, w.a[1].x, w.a[1].y, w.a[1].z, w.a[1].w};
    const float w1[8] = {w.a[2].x, w.a[2].y, w.a[2].z, w.a[2].w, w.a[3].x, w.a[3].y, w.a[3].z, w.a[3].w};
    const float w2[8] = {w.a[4].x, w.a[4].y, w.a[4].z, w.a[4].w, w.a[5].x, w.a[5].y, w.a[5].z, w.a[5].w};
    const float wb[8] = {w.a[6].x, w.a[6].y, w.a[6].z, w.a[6].w, w.a[7].x, w.a[7].y, w.a[7].z, w.a[7].w};
#pragma unroll
    for (int q = 0; q < 8; ++q) { const float xv = (w0[q] * r.fm) * m[q] + w1[q] * c[q] + (w2[q] * r.fp) * p[q] + wb[q]; o[q] = fdivf(xv, 1.f + __expf(-xv)) * scale; }
}

__device__ __forceinline__ void ml_chunk_gates(int tid, const float* gates, int h, int t0, LAS float* bf, LAS float* cbs, LAS float* gif, LAS float* gib, LAS float* tmpf, LAS float* tmpb) {
    const int lane = tid & 63, wave = tid >> 6;
    float p = 0.f, q = 0.f;
    if (tid < MLC) { const float* gp = gates + (size_t)(t0 + tid) * 32; gif[tid] = gp[h]; gib[tid] = gp[16 + h]; p = logsigf(gp[8 + h]); q = logsigf(gp[24 + h]);
#pragma unroll
        for (int o = 1; o < 64; o <<= 1) { const float v = __shfl_up(p, o); const float w = __shfl_down(q, o); if (lane >= o) p += v; if (lane + o < 64) q += w; }
        if (lane == 63) tmpf[wave] = p;
        if (lane == 0) tmpb[wave] = q; }
    __syncthreads();
    if (tid < MLC) { float ap = 0.f, aq = 0.f;
#pragma unroll
        for (int w = 0; w < 4; ++w) { if (w < wave) ap += tmpf[w]; if (w > wave) aq += tmpb[w]; }
        bf[tid] = p + ap; cbs[tid] = q + aq; }
    __syncthreads();
}

__device__ __forceinline__ void ml_state_phase(LAS unsigned char* lds, int bid, int G, const bf16_t* P, const float* gates, const float* cw, const float* cb, bf16_t* Sloc, float* zloc, float* Gtot) {
    LAS bf16_t* kw = (LAS bf16_t*)lds;
    LAS bf16_t* vT = (LAS bf16_t*)(lds + 36864);
    LAS float* bf = (LAS float*)(lds + 73728); LAS float* cbs = bf + 256; LAS float* gif = bf + 512; LAS float* gib = bf + 768; LAS float* wf = bf + 1024; LAS float* wb = bf + 1280;
    for (int u = bid; u < 8 * MLNC; u += G) {
        const int h = u / MLNC, n = u - h * MLNC, t0 = n * MLC;
        int tid = tid_fresh();
        __syncthreads();
        ml_chunk_gates(tid, gates, h, t0, bf, cbs, gif, gib, wf, wb);
        float Gf = bf[MLC - 1], Gb = cbs[0];
        __syncthreads();
        if (tid < MLC) { wf[tid] = expf(Gf - bf[tid] + gif[tid]); wb[tid] = expf(Gb - cbs[tid] + gib[tid]); }
        if (tid == 0) { Gtot[(0 * 8 + h) * MLNC + n] = Gf; Gtot[(1 * 8 + h) * MLNC + n] = Gb; }
        f32x4v acc[8][4];
#pragma unroll
        for (int m = 0; m < 8; ++m)
#pragma unroll
            for (int q = 0; q < 4; ++q) acc[m][q] = (f32x4v){0.f, 0.f, 0.f, 0.f};
        float zacc = 0.f;
#pragma unroll 1
        for (int sb = 0; sb < 4; ++sb) {
            __syncthreads();
            tid = tid_fresh();
            {
                Row3 rk[2]; u32x4 vv[4]; Cw8 cwk[2];
#pragma unroll
                for (int it = 0; it < 2; ++it) { const int item = tid + NTHR * it, sl = (item >> 2) & 63, dc = (item & 3) + 4 * (item >> 8);
                    cwk[it] = ml_cw_load(cw, cb, 1024 + h * 128 + dc * 8); rk[it] = ml_load3(P, t0 + sb * 64 + sl, 1024 + h * 128 + dc * 8); }
#pragma unroll
                for (int it = 0; it < 4; ++it) { const int item = tid + NTHR * it, sl = (item >> 2) & 63, ec = (item & 3) + 4 * (item >> 8);
                    vv[it] = *(const u32x4*)(P + (size_t)(t0 + sb * 64 + sl) * 6144 + 2048 + h * 256 + ec * 8); }
#pragma unroll
                for (int it = 0; it < 2; ++it) { const int item = tid + NTHR * it, sl = (item >> 2) & 63, dc = (item & 3) + 4 * (item >> 8), sc_ = sb * 64 + sl;
                    float o[8]; ml_conv8c(rk[it], cwk[it], 0.08838834764831845f, o);
                    const float w0 = wf[sc_], w1 = wb[sc_];
#pragma unroll
                    for (int q = 0; q < 8; ++q) { kw[(dc * 8 + q) * 72 + sl] = (bf16_t)(cvt_pk_bf16(o[q] * w0, 0.f) & 0xffffu); kw[(128 + dc * 8 + q) * 72 + sl] = (bf16_t)(cvt_pk_bf16(o[q] * w1, 0.f) & 0xffffu); } }
#pragma unroll
                for (int it = 0; it < 4; ++it) { const int item = tid + NTHR * it, sl = (item >> 2) & 63, ec = (item & 3) + 4 * (item >> 8); const u32x4 v4 = vv[it];
                    LAS bf16_t* vp = vT + (ec * 8) * 72 + sl;
                    vp[0] = (bf16_t)(v4.x & 0xffffu); vp[72] = (bf16_t)(v4.x >> 16); vp[144] = (bf16_t)(v4.y & 0xffffu); vp[216] = (bf16_t)(v4.y >> 16);
                    vp[288] = (bf16_t)(v4.z & 0xffffu); vp[360] = (bf16_t)(v4.z >> 16); vp[432] = (bf16_t)(v4.w & 0xffffu); vp[504] = (bf16_t)(v4.w >> 16); }
            }
            __syncthreads();
            tid = tid_fresh();
            const int lane = tid & 63, wave = __builtin_amdgcn_readfirstlane(tid >> 6), wr = wave >> 2, wc = wave & 3, fr = lane & 15, fq = lane >> 4;
            if (tid < 256) { const LAS bf16_t* kp = kw + tid * 72; float s = 0.f;
#pragma unroll 8
                for (int q = 0; q < 64; ++q) s += __uint_as_float((unsigned)kp[q] << 16);
                zacc += s; }
            __builtin_amdgcn_sched_barrier(0);
#pragma unroll
            for (int ks = 0; ks < 2; ++ks) {
                bf16x8 bfr[4];
#pragma unroll
                for (int q = 0; q < 4; ++q) bfr[q] = *(const LAS bf16x8*)(kw + (wc * 64 + q * 16 + fr) * 72 + ks * 32 + fq * 8);
#pragma unroll
                for (int m = 0; m < 8; ++m) { const bf16x8 afr = *(const LAS bf16x8*)(vT + (wr * 128 + m * 16 + fr) * 72 + ks * 32 + fq * 8);
#pragma unroll
                    for (int q = 0; q < 4; ++q) acc[m][q] = __builtin_amdgcn_mfma_f32_16x16x32_bf16(bfr[q], afr, acc[m][q], 0, 0, 0);
                    if (m & 1) __builtin_amdgcn_sched_barrier(0); }
            }
        }
        tid = tid_fresh();
        const int lane = tid & 63, wave = __builtin_amdgcn_readfirstlane(tid >> 6), wr = wave >> 2, wc = wave & 3, fr = lane & 15, fq = lane >> 4;
#pragma unroll
        for (int m = 0; m < 8; ++m)
#pragma unroll
            for (int q = 0; q < 4; ++q) { const int c = wc * 64 + q * 16 + fq * 4, dir = c >> 7, d = c & 127, e = wr * 128 + m * 16 + fr;
                u32x2 w; w.x = cvt_pk_bf16(acc[m][q][0], acc[m][q][1]); w.y = cvt_pk_bf16(acc[m][q][2], acc[m][q][3]);
                *(u32x2*)(Sloc + ((((size_t)dir * 8 + h) * MLNC + n) * 256 + e) * 128 + d) = w;
                __builtin_amdgcn_sched_barrier(0); }
        if (tid < 256) zloc[(((size_t)(tid >> 7) * 8 + h) * MLNC + n) * 128 + (tid & 127)] = zacc;
    }
    __syncthreads();
}

__device__ __forceinline__ void ml_scan_phase(int bid, int G, bf16_t* Sloc, float* zloc, const float* Gtot) {
    const int tid = tid_fresh();
    for (int item = bid * NTHR + tid; item < 16 * 8192; item += G * NTHR) {
        const int dh = __builtin_amdgcn_readfirstlane(item >> 13), r = item & 8191, dir = dh >> 3;
        const float* gp = Gtot + dh * MLNC;
        bf16_t* base = Sloc + (size_t)dh * MLNC * 32768 + (size_t)r * 4;
        u32x2 loc[MLNC];
#pragma unroll
        for (int step = 0; step < MLNC; ++step) { const int n = dir ? (MLNC - 1 - step) : step; loc[step] = *(const u32x2*)(base + (size_t)n * 32768); }
        float dcy[MLNC];
#pragma unroll
        for (int step = 0; step < MLNC; ++step) { const int n = dir ? (MLNC - 1 - step) : step; dcy[step] = gp[n]; }
        float s0 = 0.f, s1 = 0.f, s2 = 0.f, s3 = 0.f;
#pragma unroll
        for (int step = 0; step < MLNC; ++step) { const int n = dir ? (MLNC - 1 - step) : step;
            u32x2 w; w.x = cvt_pk_bf16(s0, s1); w.y = cvt_pk_bf16(s2, s3); *(u32x2*)(base + (size_t)n * 32768) = w;
            const float dec = expf(dcy[step]);
            s0 = dec * s0 + bf_lo(loc[step].x); s1 = dec * s1 + bf_hi(loc[step].x); s2 = dec * s2 + bf_lo(loc[step].y); s3 = dec * s3 + bf_hi(loc[step].y); }
    }
    for (int item = bid * NTHR + tid; item < 16 * 128; item += G * NTHR) {
        const int dh = __builtin_amdgcn_readfirstlane(item >> 7), r = item & 127, dir = dh >> 3;
        const float* gp = Gtot + dh * MLNC;
        float* base = zloc + (size_t)dh * MLNC * 128 + r;
        float loc[MLNC];
#pragma unroll
        for (int step = 0; step < MLNC; ++step) { const int n = dir ? (MLNC - 1 - step) : step; loc[step] = base[(size_t)n * 128]; }
        float dcy[MLNC];
#pragma unroll
        for (int step = 0; step < MLNC; ++step) { const int n = dir ? (MLNC - 1 - step) : step; dcy[step] = gp[n]; }
        float st = 0.f;
#pragma unroll
        for (int step = 0; step < MLNC; ++step) { const int n = dir ? (MLNC - 1 - step) : step; base[(size_t)n * 128] = st; st = expf(dcy[step]) * st + loc[step]; }
    }
}

__device__ __forceinline__ void ml_out_phase(LAS unsigned char* lds, int bid, int G, const bf16_t* P, const float* gates, const float* cw, const float* cb,
                                             const bf16_t* Sst, const float* zst, const float* head_g, bf16_t* hs) {
    LAS bf16_t* Q  = (LAS bf16_t*)lds;
    LAS bf16_t* ST = (LAS bf16_t*)(lds + 34816);
    LAS bf16_t* Kb = (LAS bf16_t*)(lds + 34816);
    LAS bf16_t* VT = (LAS bf16_t*)(lds + 34816 + 17408);
    LAS bf16_t* PW = (LAS bf16_t*)(lds + 104448);
    LAS float* bf = (LAS float*)(lds + 122880); LAS float* cbs = bf + 256; LAS float* gif = bf + 512; LAS float* gib = bf + 768;
    LAS float* zs = bf + 1024;
    LAS float* tmp = bf + 1280;
#define ML_IDS() tid = tid_fresh(); const int lane = tid & 63, wave = __builtin_amdgcn_readfirstlane(tid >> 6), fr = lane & 15, fq = lane >> 4; const int trel = half * 128 + wave * 16 + fr; LAS bf16_t* pw = PW + wave * 16 * 72; (void)pw; (void)fq; (void)trel
    for (int u = bid; u < 8 * MLNC * 2; u += G) {
        const int half = u & 1, hn = u >> 1, h = hn / MLNC, n = hn - h * MLNC, t0 = n * MLC;
        int tid = tid_fresh();
        __syncthreads();
        ml_chunk_gates(tid, gates, h, t0, bf, cbs, gif, gib, tmp, tmp + 256);
        {   const int dc = tid & 15, tlb = tid >> 4;
            const Cw8 cwq = ml_cw_load(cw, cb, h * 128 + dc * 8);
            Row3 rq[4];
#pragma unroll
            for (int it = 0; it < 4; ++it) rq[it] = ml_load3(P, t0 + half * 128 + tlb + 32 * it, h * 128 + dc * 8);
#pragma unroll
            for (int it = 0; it < 4; ++it) { float o[8]; ml_conv8c(rq[it], cwq, 1.f, o);
                u32x4 w; w.x = cvt_pk_bf16(o[0], o[1]); w.y = cvt_pk_bf16(o[2], o[3]); w.z = cvt_pk_bf16(o[4], o[5]); w.w = cvt_pk_bf16(o[6], o[7]);
                *(LAS u32x4*)(Q + (tlb + 32 * it) * 136 + dc * 8) = w; }
        }
        f32x4v accf[16], accb[16];
#pragma unroll
        for (int q = 0; q < 16; ++q) { accf[q] = (f32x4v){0.f, 0.f, 0.f, 0.f}; accb[q] = (f32x4v){0.f, 0.f, 0.f, 0.f}; }
        Row3 rk[2]; u32x4 vv[4];
#define ML_LOADKV(sbx) do { const int t_ = tid_fresh(); const int dc_ = t_ & 15, slb_ = t_ >> 4; \
            _Pragma("unroll") for (int it = 0; it < 2; ++it) rk[it] = ml_load3(P, t0 + (sbx) * 64 + slb_ + 32 * it, 1024 + h * 128 + dc_ * 8); \
            _Pragma("unroll") for (int it = 0; it < 4; ++it) { const int item = t_ + NTHR * it, sl = (item >> 2) & 63, ec = (item & 3) + 4 * (item >> 8); \
                vv[it] = *(const u32x4*)(P + (size_t)(t0 + (sbx) * 64 + sl) * 6144 + 2048 + h * 256 + ec * 8); } } while (0)
        u32x4 sv[8];
#define ML_LOADS(dirx) do { const int t_ = tid_fresh(); const bf16_t* Sp = Sst + (((size_t)(dirx) * 8 + h) * MLNC + n) * 32768; \
            _Pragma("unroll") for (int it = 0; it < 8; ++it) { const int item = t_ + NTHR * it, e = item >> 4, dc_ = item & 15; sv[it] = *(const u32x4*)(Sp + (size_t)e * 128 + dc_ * 8); } } while (0)
        ML_LOADS(0);
#pragma unroll
        for (int dir = 0; dir < 2; ++dir) {
            __syncthreads();
            tid = tid_fresh();
#pragma unroll
            for (int it = 0; it < 8; ++it) { const int item = tid + NTHR * it, e = item >> 4, dc = item & 15; *(LAS u32x4*)(ST + e * 136 + dc * 8) = sv[it]; }
            if (tid < 128) zs[dir * 128 + tid] = zst[(((size_t)dir * 8 + h) * MLNC + n) * 128 + tid];
            __syncthreads();
            if (dir == 0) ML_LOADS(1); else ML_LOADKV(0);
            ML_IDS();
#pragma unroll 1
            for (int ks = 0; ks < 4; ++ks) {
                const bf16x8 qf = *(const LAS bf16x8*)(Q + (wave * 16 + fr) * 136 + ks * 32 + fq * 8);
#pragma unroll
                for (int q = 0; q < 16; ++q) { const bf16x8 sf = *(const LAS bf16x8*)(ST + (q * 16 + fr) * 136 + ks * 32 + fq * 8);
                    if (dir == 0) accf[q] = __builtin_amdgcn_mfma_f32_16x16x32_bf16(sf, qf, accf[q], 0, 0, 0);
                    else accb[q] = __builtin_amdgcn_mfma_f32_16x16x32_bf16(sf, qf, accb[q], 0, 0, 0);
                    if ((q & 3) == 3) __builtin_amdgcn_sched_barrier(0); }
            }
        }
        float denf, denb;
        {   ML_IDS();
            const float ebf = expf(bf[trel]), ebb = expf(cbs[trel]);
#pragma unroll
            for (int q = 0; q < 16; ++q) { accf[q] *= ebf; accb[q] *= ebb; }
            float pf = 0.f, pb = 0.f; const LAS bf16_t* qp = Q + (wave * 16 + fr) * 136 + fq * 32;
#pragma unroll 8
            for (int d = 0; d < 32; ++d) { const float qv = __uint_as_float((unsigned)qp[d] << 16); pf += qv * zs[fq * 32 + d]; pb += qv * zs[128 + fq * 32 + d]; }
            pf += __shfl_xor(pf, 16); pf += __shfl_xor(pf, 32); pb += __shfl_xor(pb, 16); pb += __shfl_xor(pb, 32);
            denf = ebf * pf; denb = ebb * pb; }
        float sumf = 0.f, sumb = 0.f;
#pragma unroll 1
        for (int sb = 0; sb < 4; ++sb) {
            const bool need_f = (sb * 64 <= half * 128 + 127), need_b = (sb * 64 + 63 >= half * 128);
            __syncthreads();
            tid = tid_fresh();
            {   const int dc = tid & 15, slb = tid >> 4;
                const Cw8 cwk = ml_cw_load(cw, cb, 1024 + h * 128 + dc * 8);
#pragma unroll
                for (int it = 0; it < 2; ++it) { float o[8]; ml_conv8c(rk[it], cwk, 0.08838834764831845f, o);
                    u32x4 w; w.x = cvt_pk_bf16(o[0], o[1]); w.y = cvt_pk_bf16(o[2], o[3]); w.z = cvt_pk_bf16(o[4], o[5]); w.w = cvt_pk_bf16(o[6], o[7]);
                    *(LAS u32x4*)(Kb + (slb + 32 * it) * 136 + dc * 8) = w; }
#pragma unroll
                for (int it = 0; it < 4; ++it) { const int item = tid + NTHR * it, sl = (item >> 2) & 63, ec = (item & 3) + 4 * (item >> 8); const u32x4 v4 = vv[it];
                    LAS bf16_t* vp = VT + (ec * 8) * 72 + sl;
                    vp[0] = (bf16_t)(v4.x & 0xffffu); vp[72] = (bf16_t)(v4.x >> 16); vp[144] = (bf16_t)(v4.y & 0xffffu); vp[216] = (bf16_t)(v4.y >> 16);
                    vp[288] = (bf16_t)(v4.z & 0xffffu); vp[360] = (bf16_t)(v4.z >> 16); vp[432] = (bf16_t)(v4.w & 0xffffu); vp[504] = (bf16_t)(v4.w >> 16); }
            }
            __syncthreads();
            if (sb < 3) ML_LOADKV(sb + 1);
            ML_IDS();
            f32x4v sc[4];
#pragma unroll
            for (int st = 0; st < 4; ++st) sc[st] = (f32x4v){0.f, 0.f, 0.f, 0.f};
#pragma unroll
            for (int ks = 0; ks < 4; ++ks) {
                const bf16x8 qf = *(const LAS bf16x8*)(Q + (wave * 16 + fr) * 136 + ks * 32 + fq * 8);
#pragma unroll
                for (int st = 0; st < 4; ++st) { const bf16x8 kf = *(const LAS bf16x8*)(Kb + (st * 16 + fr) * 136 + ks * 32 + fq * 8);
                    sc[st] = __builtin_amdgcn_mfma_f32_16x16x32_bf16(kf, qf, sc[st], 0, 0, 0); }
            }
#pragma unroll
            for (int dir = 0; dir < 2; ++dir) {
                if (dir == 0 ? !need_f : !need_b) continue;
                const float bt = dir == 0 ? bf[trel] : cbs[trel];
#pragma unroll
                for (int st = 0; st < 4; ++st) { float pv[4];
#pragma unroll
                    for (int r = 0; r < 4; ++r) { const int srel = sb * 64 + st * 16 + fq * 4 + r;
                        const float bs = dir == 0 ? bf[srel] : cbs[srel], gi = dir == 0 ? gif[srel] : gib[srel];
                        const bool ok = dir == 0 ? (srel <= trel) : (srel >= trel);
                        pv[r] = ok ? __expf(bt - bs + gi) * sc[st][r] : 0.f;
                        if (dir == 0) sumf += pv[r]; else sumb += pv[r]; }
                    u32x2 w; w.x = cvt_pk_bf16(pv[0], pv[1]); w.y = cvt_pk_bf16(pv[2], pv[3]);
                    *(LAS u32x2*)(pw + fr * 72 + st * 16 + fq * 4) = w; }
#pragma unroll 1
                for (int ks = 0; ks < 2; ++ks) {
                    const bf16x8 pf = *(const LAS bf16x8*)(pw + fr * 72 + ks * 32 + fq * 8);
#pragma unroll
                    for (int q = 0; q < 16; ++q) { const bf16x8 vf = *(const LAS bf16x8*)(VT + (q * 16 + fr) * 72 + ks * 32 + fq * 8);
                        if (dir == 0) accf[q] = __builtin_amdgcn_mfma_f32_16x16x32_bf16(vf, pf, accf[q], 0, 0, 0);
                        else accb[q] = __builtin_amdgcn_mfma_f32_16x16x32_bf16(vf, pf, accb[q], 0, 0, 0);
                        if ((q & 3) == 3) __builtin_amdgcn_sched_barrier(0); }
                }
            }
        }
        ML_IDS();
        sumf += __shfl_xor(sumf, 16); sumf += __shfl_xor(sumf, 32); sumb += __shfl_xor(sumb, 16); sumb += __shfl_xor(sumb, 32);
        const float invf = 1.f / fmaxf(fabsf(denf + sumf), 1.f), invb = 1.f / fmaxf(fabsf(denb + sumb), 1.f);
        float ss = 0.f;
#pragma unroll
        for (int q = 0; q < 16; ++q) { accf[q] = accf[q] * invf + accb[q] * invb; ss += accf[q][0] * accf[q][0] + accf[q][1] * accf[q][1] + accf[q][2] * accf[q][2] + accf[q][3] * accf[q][3]; }
        ss += __shfl_xor(ss, 16); ss += __shfl_xor(ss, 32);
        const float rn = rsqrtf(ss * (1.f / 256.f) + EPS);
        const size_t tabs = (size_t)t0 + trel;
#pragma unroll
        for (int qb = 0; qb < 16; qb += 8) {
            u32x2 ovv[8]; float4 hgv[8];
#pragma unroll
            for (int qq = 0; qq < 8; ++qq) { const int e = (qb + qq) * 16 + fq * 4; ovv[qq] = *(const u32x2*)(P + tabs * 6144 + 4096 + h * 256 + e); hgv[qq] = *(const float4*)(head_g + h * 256 + e); }
#pragma unroll
            for (int qq = 0; qq < 8; ++qq) { const int q = qb + qq, e = q * 16 + fq * 4; const u32x2 ov = ovv[qq]; const float4 hg = hgv[qq];
                const float o0 = bf_lo(ov.x), o1 = bf_hi(ov.x), o2 = bf_lo(ov.y), o3 = bf_hi(ov.y);
                const float r0 = fdivf(accf[q][0] * rn * hg.x, 1.f + __expf(-o0)), r1 = fdivf(accf[q][1] * rn * hg.y, 1.f + __expf(-o1)), r2 = fdivf(accf[q][2] * rn * hg.z, 1.f + __expf(-o2)), r3 = fdivf(accf[q][3] * rn * hg.w, 1.f + __expf(-o3));
                u32x2 w; w.x = cvt_pk_bf16(r0, r1); w.y = cvt_pk_bf16(r2, r3);
                *(u32x2*)(hs + tabs * D + h * 256 + e) = w; }
            __builtin_amdgcn_sched_barrier(0); }
    }
    __syncthreads();
#undef ML_IDS
}

__device__ __forceinline__ void norm_phase(int bid, int G, const float* x, const float* g, const float* sc, const float* sh, bf16_t* hbuf) {
    const int tid = tid_fresh(), lane = tid & 63, wave = tid >> 6;
    for (int row = bid * 8 + wave; row < T; row += G * 8) {
        float4 v[8];
#pragma unroll
        for (int i = 0; i < 8; ++i) v[i] = *(const float4*)(x + (size_t)row * D + (lane + 64 * i) * 4);
        row_norm_mod(v, lane, g, sc, sh);
#pragma unroll
        for (int i = 0; i < 8; ++i) { u32x2 w; w.x = cvt_pk_bf16(v[i].x, v[i].y); w.y = cvt_pk_bf16(v[i].z, v[i].w); *(u32x2*)(hbuf + (size_t)row * D + (lane + 64 * i) * 4) = w; }
    }
}

template <int L>
__device__ __forceinline__ void moe_layer(LAS unsigned char* lds, const XcdBarrier& bar, int bid, int G, int vcu, const float* xcur, float* xout) {
    {
        KP kp = kparams(); unsigned char* ws = kp->ws; const float* adl = (const float*)(ws + WS_ADA) + L * 12288;
        route_phase(lds, bid, G, xcur, kp->in[5] + L * D, adl + 4 * D, adl + 3 * D, kp->in[25] + (size_t)L * D * NE, kp->in[26] + L * NE,
                    (bf16_t*)(ws + WS_HBUF), (int*)(ws + WS_CTL + CTL_CNT) + L * 64, (int*)(ws + WS_LIST), (u32x2*)(ws + WS_REC));
    }
    xcd_barrier(bar);
    int ntiles;
    { KP kp = kparams(); ntiles = moe_tables(lds, (int*)(kp->ws + WS_CTL + CTL_CNT) + L * 64); }
    {
        KP kp = kparams(); unsigned char* ws = kp->ws;
        MoeGuOrder S{(const bf16_t*)(ws + WS_HBUF), (const bf16_t*)(ws + WS_WGU) + L * WGU_L, (const int*)(ws + WS_LIST), (const LAS int*)(lds + LDS_TSTART), (const LAS int*)(lds + LDS_TILEE), (const LAS int*)(lds + LDS_CNT), ntiles, G, vcu};
        EpiSwiglu E{(bf16_t*)(ws + WS_H)};
        _Pragma("unroll 1") for (int rep_ = 0; rep_ < REP_GEMM; ++rep_) gemm_phase<EpiSwiglu, MoeGuOrder>(lds, D, S, E);
    }
    xcd_barrier(bar);
    {
        KP kp = kparams(); unsigned char* ws = kp->ws;
        MoeDownOrder S{(const bf16_t*)(ws + WS_H), (const bf16_t*)(ws + WS_WD) + L * WD_L, (const LAS int*)(lds + LDS_TSTART), (const LAS int*)(lds + LDS_TILEE), ntiles, G, vcu};
        EpiF8 E{(unsigned char*)(ws + WS_BIG), D, Y8_SCALE};
        _Pragma("unroll 1") for (int rep_ = 0; rep_ < REP_GEMM; ++rep_) gemm_phase<EpiF8, MoeDownOrder>(lds, FF, S, E);
    }
    xcd_barrier(bar);
    {
        KP kp = kparams(); unsigned char* ws = kp->ws; const float* adl = (const float*)(ws + WS_ADA) + L * 12288;
#pragma unroll 1
        for (int rep_ = 0; rep_ < REP_COMB; ++rep_)
        if (L == 0) combine_phase<0>(lds, bid, G, xcur, adl + 5 * D, (const bf16_t*)(ws + WS_BIG), (const u32x2*)(ws + WS_REC), xout, nullptr, nullptr, nullptr, nullptr);
        else combine_phase<1>(lds, bid, G, xcur, adl + 5 * D, (const bf16_t*)(ws + WS_BIG), (const u32x2*)(ws + WS_REC), kp->out, kp->in[33], nullptr, nullptr, nullptr);
    }
}

__device__ __forceinline__ void hyena_layer(LAS unsigned char* lds, const XcdBarrier& bar, int bid, int G, int vcu) {
    { KP kp = kparams(); unsigned char* ws = kp->ws; const float* adl = (const float*)(ws + WS_ADA);
      for (int rep_ = 0; rep_ < REP_HCT; ++rep_) norm_phase(bid, G, kp->in[0], kp->in[4], adl + 1 * D, adl + 0 * D, (bf16_t*)(ws + WS_HBUF)); }
    xcd_barrier(bar);
    { KP kp = kparams(); unsigned char* ws = kp->ws;
      DenseOrder S; S.init((const bf16_t*)(ws + WS_HBUF), (const bf16_t*)(ws + WS_WHYIN), T, 6144, D, G, vcu);
      EpiBf16 E{(bf16_t*)(ws + WS_BIG + BIG_U), 6144};
      _Pragma("unroll 1") for (int rep_ = 0; rep_ < REP_GEMM; ++rep_) gemm_phase<EpiBf16, DenseOrder>(lds, D, S, E); }
    xcd_barrier(bar);
    { KP kp = kparams(); unsigned char* ws = kp->ws;
      for (int rep_ = 0; rep_ < REP_HCT; ++rep_) hy_conv_phase(lds, bid, G, (const bf16_t*)(ws + WS_BIG + BIG_U), kp->in[7], kp->in[8], (bf16_t*)(ws + WS_BIG + BIG_X0C), (bf16_t*)(ws + WS_BIG + BIG_VGT)); }
    xcd_barrier(bar);
#pragma unroll 1
    for (int rep_ = 0; rep_ < REP_HYF; ++rep_)
    { KP kp = kparams(); unsigned char* ws = kp->ws;
      hy_fft_phase(lds, bid, G, (const bf16_t*)(ws + WS_BIG + BIG_VGT), (bf16_t*)(ws + WS_BIG + BIG_U), (const float*)(ws + WS_BIG + BIG_A3), kp->in[16], kp->in[17], (float*)(ws + WS_XB), (float4*)(ws + WS_BIG + BIG_GSPEC)); }
    xcd_barrier(bar);
    { KP kp = kparams(); unsigned char* ws = kp->ws;
      for (int rep_ = 0; rep_ < REP_HCT; ++rep_) hy_tr_phase(lds, bid, G, (const bf16_t*)(ws + WS_BIG + BIG_U), (const bf16_t*)(ws + WS_BIG + BIG_X0C), (bf16_t*)(ws + WS_HBUF)); }
    xcd_barrier(bar);
    { KP kp = kparams(); unsigned char* ws = kp->ws; const float* adl = (const float*)(ws + WS_ADA);
      DenseOrder S; S.init((const bf16_t*)(ws + WS_HBUF), (const bf16_t*)(ws + WS_WHYOUT), T, D, D, G, vcu);
      EpiResid E{kp->in[0], (float*)(ws + WS_XA), adl + 2 * D};
      _Pragma("unroll 1") for (int rep_ = 0; rep_ < REP_GEMM; ++rep_) gemm_phase<EpiResid, DenseOrder>(lds, D, S, E); }
    xcd_barrier(bar);
}

__device__ __forceinline__ void mlstm_layer(LAS unsigned char* lds, const XcdBarrier& bar, int bid, int G, int vcu) {
    { KP kp = kparams(); unsigned char* ws = kp->ws; const float* adl = (const float*)(ws + WS_ADA) + 12288;
      ml_norm_gates_phase(lds, bid, G, (const float*)(ws + WS_XB), kp->in[4] + D, adl + 1 * D, adl + 0 * D, kp->in[19], kp->in[22], (bf16_t*)(ws + WS_HBUF), (float*)(ws + WS_BIG + BIG_GATES)); }
    xcd_barrier(bar);
    { KP kp = kparams(); unsigned char* ws = kp->ws;
      DenseOrder S; S.init((const bf16_t*)(ws + WS_HBUF), (const bf16_t*)(ws + WS_WMLIN), T, 6144, D, G, vcu);
      EpiBf16 E{(bf16_t*)(ws + WS_BIG + BIG_U), 6144};
      _Pragma("unroll 1") for (int rep_ = 0; rep_ < REP_GEMM; ++rep_) gemm_phase<EpiBf16, DenseOrder>(lds, D, S, E); }
    xcd_barrier(bar);
#pragma unroll 1
    for (int rep_ = 0; rep_ < REP_MLS; ++rep_) {
    { KP kp = kparams(); unsigned char* ws = kp->ws;
      ml_state_phase(lds, bid, G, (const bf16_t*)(ws + WS_BIG + BIG_U), (const float*)(ws + WS_BIG + BIG_GATES), kp->in[20], kp->in[21],
                     (bf16_t*)(ws + WS_BIG + BIG_SLOC), (float*)(ws + WS_BIG + BIG_ZLOC), (float*)(ws + WS_BIG + BIG_GTOT)); }
    xcd_barrier(bar);
    { KP kp = kparams(); unsigned char* ws = kp->ws;
      ml_scan_phase(bid, G, (bf16_t*)(ws + WS_BIG + BIG_SLOC), (float*)(ws + WS_BIG + BIG_ZLOC), (const float*)(ws + WS_BIG + BIG_GTOT)); }
    xcd_barrier(bar);
    { KP kp = kparams(); unsigned char* ws = kp->ws;
      ml_out_phase(lds, bid, G, (const bf16_t*)(ws + WS_BIG + BIG_U), (const float*)(ws + WS_BIG + BIG_GATES), kp->in[20], kp->in[21],
                   (const bf16_t*)(ws + WS_BIG + BIG_SLOC), (const float*)(ws + WS_BIG + BIG_ZLOC), kp->in[23], (bf16_t*)(ws + WS_HBUF)); }
    xcd_barrier(bar);
    }
    { KP kp = kparams(); unsigned char* ws = kp->ws; const float* adl = (const float*)(ws + WS_ADA) + 12288;
      DenseOrder S; S.init((const bf16_t*)(ws + WS_HBUF), (const bf16_t*)(ws + WS_WMLOUT), T, D, D, G, vcu);
      EpiResid E{(const float*)(ws + WS_XB), (float*)(ws + WS_XA), adl + 2 * D};
      _Pragma("unroll 1") for (int rep_ = 0; rep_ < REP_GEMM; ++rep_) gemm_phase<EpiResid, DenseOrder>(lds, D, S, E); }
    xcd_barrier(bar);
}

__global__ void __launch_bounds__(NTHR, 2) fwd(Params p_unused) {
    extern __shared__ __attribute__((aligned(16))) unsigned char lds_raw[];
    LAS unsigned char* lds = (LAS unsigned char*)lds_raw;
    const int G = gridDim.x, bid = blockIdx.x;
    const int vcu = (G % 8 == 0) ? (bid % 8) * (G / 8) + bid / 8 : bid;
    if (threadIdx.x < 4) ((LAS unsigned*)(lds + LDS_MISC))[threadIdx.x] = 0u;
    __syncthreads();
    XcdBarrier bar;
    { KP kp = kparams(); bar = xcd_barrier_post((unsigned*)(kp->ws + WS_CTL), (volatile LAS unsigned*)(lds + LDS_MISC)); }

#pragma unroll 1
    for (int repp_ = 0; repp_ < REP_PRO; ++repp_) {
    { KP kp = kparams(); ada_phase((LAS float*)lds, bid, G, kp->in[1], kp->in[2], kp->in[3], (float*)(kp->ws + WS_ADA)); }
    { KP kp = kparams(); hy_filter_mlp((LAS float*)lds, bid, G, kp->in[9], kp->in[10], kp->in[11], kp->in[12], kp->in[13], kp->in[14], kp->in[15], (float*)(kp->ws + WS_BIG + BIG_A3)); }
    {
        LAS float* tile = (LAS float*)lds;
        { KP kp = kparams(); cvt_group(tile, bid, G, kp->in[6], 0, 6144, D, 6144, (bf16_t*)(kp->ws + WS_WHYIN), 0, 0, 1); }
        { KP kp = kparams(); cvt_group(tile, bid, G, kp->in[18], 0, D, D, D, (bf16_t*)(kp->ws + WS_WHYOUT), 0, 0, 1); }
        { KP kp = kparams(); cvt_group(tile, bid, G, kp->in[19], 0, 6176, D, 6144, (bf16_t*)(kp->ws + WS_WMLIN), 0, 0, 1); }
        { KP kp = kparams(); cvt_group(tile, bid, G, kp->in[24], 0, D, D, D, (bf16_t*)(kp->ws + WS_WMLOUT), 0, 0, 1); }
#pragma unroll 1
        for (int l2 = 0; l2 < 2 * REP_CVT; ++l2) { const int l = l2 & 1;
            KP kp = kparams(); bf16_t* Wgu = (bf16_t*)(kp->ws + WS_WGU) + l * WGU_L; bf16_t* Wd = (bf16_t*)(kp->ws + WS_WD) + l * WD_L;
            cvt_group(tile, bid, G, kp->in[30] + (size_t)l * D * FF, 0, FF, D, FF, Wgu + (size_t)NE * 1024 * D, 0, 1, 1, 1024);
            cvt_group(tile, bid, G, kp->in[31] + (size_t)l * D * FF, 0, FF, D, FF, Wgu + (size_t)NE * 1024 * D, 0, 2, 1, 1024);
            cvt_group(tile, bid, G, kp->in[32] + (size_t)l * FF * D, 0, D, FF, D, Wd + (size_t)NE * D * FF, 0, 0, 1, D);
        }
    }
    }
    xcd_barrier(bar);

    hyena_layer(lds, bar, bid, G, vcu);
    { KP kp = kparams(); moe_layer<0>(lds, bar, bid, G, vcu, (const float*)(kp->ws + WS_XA), (float*)(kp->ws + WS_XB)); }
    asm volatile("s_waitcnt vmcnt(0)" ::: "memory"); __syncthreads();
    mlstm_layer(lds, bar, bid, G, vcu);
    { KP kp = kparams(); moe_layer<1>(lds, bar, bid, G, vcu, (const float*)(kp->ws + WS_XA), nullptr); }
}

extern "C" void kernel_launch(void* const* d_in, const int* in_sizes, int n_in, void* d_out, int out_size, void* d_ws, size_t ws_size, hipStream_t stream) {
    static int grid = 0;
    if (grid == 0) {
        if (n_in != 34 || ws_size < WS_END) { fprintf(stderr, "kernel_launch: n_in %d ws %zu need %zu\n", n_in, ws_size, (size_t)WS_END); grid = -1; return; }
        int dev = 0, cus = 0, per_cu = 0;
        hipGetDevice(&dev); hipDeviceGetAttribute(&cus, hipDeviceAttributeMultiprocessorCount, dev);
        hipFuncSetAttribute((const void*)fwd, hipFuncAttributeMaxDynamicSharedMemorySize, LDS_BYTES);
        hipOccupancyMaxActiveBlocksPerMultiprocessor(&per_cu, (const void*)fwd, NTHR, LDS_BYTES);
        (void)hipGetLastError();
        grid = (per_cu >= 1) ? (cus < 256 ? cus : 256) : -1;
        if (grid < 0) fprintf(stderr, "kernel_launch: occupancy query says 0 blocks per CU\n");
    }
    if (grid < 0) return;
    hipMemsetAsync((char*)d_ws + WS_CTL, 0, CTL_BYTES, stream);
    Params p{};
    for (int i = 0; i < 34; ++i) p.in[i] = (const float*)d_in[i];
    p.out = (float*)d_out; p.ws = (unsigned char*)d_ws;
    hipLaunchKernelGGL(fwd, dim3(grid), dim3(NTHR), LDS_BYTES, stream, p);
}
```
